# Optimizing an MI355X kernel written in HIP

```python
import math
import jax, jax.numpy as jnp
from jax import lax
import numpy as np

D_MODEL = 2048
BATCH = 16
SEQ = 256
DEPTH = 4
DEC_BATCH = 2
DEC_SEQ = 1024
PAST_LEN = 256

GRID_W = 64
N_MIXERS = 4
Q_BLOCK = 128
ROPE_BASE = 10000.0
LN_EPS = 1e-5
RMS_EPS = 1e-6
NEG_INF = -1e30
DEEPNORM_ALPHA = (2 * DEPTH) ** 0.25
DEEPNORM_BETA = (8 * DEPTH) ** -0.25

MLA_HEADS = 16
MLA_Q_LORA = 512
MLA_KV_LORA = 512
MLA_NOPE = 128
MLA_ROPE = 64
MLA_V = 128
MLA_SCALE = (MLA_NOPE + MLA_ROPE) ** -0.5

GQA_HEADS = 32
GQA_KV_HEADS = 8
GQA_HEAD_DIM = 64
WINDOW = 128
BAND_BLOCK = 128
GQA_SCALE = GQA_HEAD_DIM ** -0.5

FNET_GROUPS = 4
FNET_GROUP_DIM = D_MODEL // FNET_GROUPS

CONV_WIDTH = 3

PEER_HEADS = 8
PEER_N_KEYS = 128
PEER_N_EXPERTS = PEER_N_KEYS * PEER_N_KEYS
PEER_QUERY_DIM = 256
PEER_HALF = PEER_QUERY_DIM // 2
PEER_TOPK = 16
TOKEN_BLOCK = 128

kernel_name = 'hybrid_diffusion_mla_swa_fnet_conv_peer_step'


def layer_norm(x, g, b):
    xf = x.astype(jnp.float32)
    mu = xf.mean(-1, keepdims=True)
    var = jnp.square(xf - mu).mean(-1, keepdims=True)
    return ((xf - mu) * lax.rsqrt(var + LN_EPS) * g.astype(jnp.float32) + b.astype(jnp.float32)).astype(x.dtype)


def rms_norm(x, g):
    xf = x.astype(jnp.float32)
    return (xf * lax.rsqrt(jnp.square(xf).mean(-1, keepdims=True) + RMS_EPS) * g.astype(jnp.float32)).astype(x.dtype)


def ada_modulation(cond, w, b):
    return jnp.split(jax.nn.silu(cond) @ w + b, 6, axis=-1)


def modulate(x, shift, scale):
    return x * (1 + scale[:, None, :]) + shift[:, None, :]


def post_norm(x, delta, gate, g, b):
    return layer_norm(DEEPNORM_ALPHA * x + gate[:, None, :] * delta, g, b)


def axial_rope(x):
    T, R = x.shape[1], x.shape[-1]
    rows = T // GRID_W
    row_id = jnp.repeat(jnp.arange(rows), GRID_W)
    col_id = jnp.tile(jnp.arange(GRID_W), rows)
    half = R // 2
    quarter = half // 2
    inv_freq = ROPE_BASE ** (-jnp.arange(quarter, dtype=jnp.float32) / quarter)

    def rot(xa, pos):
        ang = pos.astype(jnp.float32)[:, None] * inv_freq[None, :]
        cos = jnp.cos(ang)[None, :, None, :]
        sin = jnp.sin(ang)[None, :, None, :]
        x1, x2 = xa[..., :quarter], xa[..., quarter:]
        return jnp.concatenate([x1 * cos - x2 * sin, x1 * sin + x2 * cos], -1)

    xf = x.astype(jnp.float32)
    return jnp.concatenate([rot(xf[..., :half], row_id), rot(xf[..., half:], col_id)], -1).astype(x.dtype)


def block_attention(q, k, v, scale, sink=None):
    B, T, H, dq = q.shape
    Hk, dv = k.shape[2], v.shape[-1]
    G = H // Hk
    nb = T // Q_BLOCK
    qb = q.reshape(B, nb, Q_BLOCK, Hk, G, dq).transpose(1, 0, 2, 3, 4, 5)

    def one_block(qi):
        s = jnp.einsum('bqkgd,bskd->bkgqs', qi, k, preferred_element_type=jnp.float32) * scale
        if sink is not None:
            s_sink = jnp.broadcast_to(sink.reshape(Hk, G)[None, :, :, None, None].astype(jnp.float32), s.shape[:-1] + (1,))
            p = jax.nn.softmax(jnp.concatenate([s, s_sink], -1), axis=-1)[..., :-1]
        else:
            p = jax.nn.softmax(s, axis=-1)
        return jnp.einsum('bkgqs,bskd->bqkgd', p.astype(v.dtype), v)

    o = lax.map(one_block, qb)
    return o.transpose(1, 0, 2, 3, 4, 5).reshape(B, T, H, dv)


def banded_window_attention(q, k, v, k_ctx, v_ctx, sink, scale):
    B, T, H, d = q.shape
    Hk = k.shape[2]
    G = H // Hk
    bb = BAND_BLOCK
    nb = T // bb
    qb = q.reshape(B, nb, bb, Hk, G, d).transpose(1, 0, 2, 3, 4, 5)
    pad = ((0, 0), (bb, bb), (0, 0), (0, 0))
    kp = jnp.pad(k, pad).reshape(B, nb + 2, bb, Hk, d)
    vp = jnp.pad(v, pad).reshape(B, nb + 2, bb, Hk, d)
    kband = jnp.concatenate([kp[:, :-2], kp[:, 1:-1], kp[:, 2:]], axis=2).transpose(1, 0, 2, 3, 4)
    vband = jnp.concatenate([vp[:, :-2], vp[:, 1:-1], vp[:, 2:]], axis=2).transpose(1, 0, 2, 3, 4)
    blk = jnp.arange(nb)
    q_pos = blk[:, None] * bb + jnp.arange(bb)[None, :]
    k_pos = (blk[:, None] - 1) * bb + jnp.arange(3 * bb)[None, :]
    valid = ((jnp.abs(q_pos[:, :, None] - k_pos[:, None, :]) <= WINDOW)
             & (k_pos[:, None, :] >= 0) & (k_pos[:, None, :] < T))
    sink_l = sink.reshape(Hk, G)[None, :, :, None, None].astype(jnp.float32)
    n_band = 3 * bb

    def one_block(args):
        qi, kb, vb, ok = args
        s_band = jnp.einsum('bqkgd,bskd->bkgqs', qi, kb, preferred_element_type=jnp.float32) * scale
        s_band = jnp.where(ok[None, None, None], s_band, NEG_INF)
        s_ctx = jnp.einsum('bqkgd,bskd->bkgqs', qi, k_ctx, preferred_element_type=jnp.float32) * scale
        s_sink = jnp.broadcast_to(sink_l, s_band.shape[:-1] + (1,))
        p = jax.nn.softmax(jnp.concatenate([s_band, s_ctx, s_sink], -1), axis=-1).astype(v.dtype)
        return (jnp.einsum('bkgqs,bskd->bqkgd', p[..., :n_band], vb)
                + jnp.einsum('bkgqs,bskd->bqkgd', p[..., n_band:-1], v_ctx))

    o = lax.map(one_block, (qb, kband, vband, valid))
    return o.transpose(1, 0, 2, 3, 4, 5).reshape(B, T, H, d)


def mla_queries(u, w_dq, q_norm, w_uq):
    B, T, _ = u.shape
    q = (rms_norm(u @ w_dq, q_norm) @ w_uq).reshape(B, T, MLA_HEADS, MLA_NOPE + MLA_ROPE)
    return q[..., :MLA_NOPE], q[..., MLA_NOPE:]


def mla_compress(u, w_dkv, kv_norm):
    kv = u @ w_dkv
    return rms_norm(kv[..., :MLA_KV_LORA], kv_norm), kv[..., MLA_KV_LORA:]


def mla_attend(q_nope, q_rope, ckv, krope, w_uk, w_uv, w_o):
    B, S, _ = ckv.shape
    T = q_nope.shape[1]
    k_nope = (ckv @ w_uk).reshape(B, S, MLA_HEADS, MLA_NOPE)
    v = (ckv @ w_uv).reshape(B, S, MLA_HEADS, MLA_V)
    k = jnp.concatenate([k_nope, jnp.broadcast_to(krope[:, :, None, :], (B, S, MLA_HEADS, MLA_ROPE))], -1)
    q = jnp.concatenate([q_nope, q_rope], -1)
    o = block_attention(q, k, v, MLA_SCALE)
    return o.reshape(B, T, MLA_HEADS * MLA_V) @ w_o


def gqa_split(u, w_qkv):
    B, T, _ = u.shape
    qkv = u @ w_qkv
    nq = GQA_HEADS * GQA_HEAD_DIM
    nk = GQA_KV_HEADS * GQA_HEAD_DIM
    q = qkv[..., :nq].reshape(B, T, GQA_HEADS, GQA_HEAD_DIM)
    k = qkv[..., nq:nq + nk].reshape(B, T, GQA_KV_HEADS, GQA_HEAD_DIM)
    v = qkv[..., nq + nk:].reshape(B, T, GQA_KV_HEADS, GQA_HEAD_DIM)
    return q, k, v


def fourier_mix(u, w_out):
    B, T, D = u.shape
    ug = u.astype(jnp.float32).reshape(B, T, FNET_GROUPS, FNET_GROUP_DIM)
    f = jnp.fft.fftn(ug, axes=(1, 3), norm='ortho').real
    return f.reshape(B, T, D).astype(u.dtype) @ w_out


def short_conv_mix(u, w_in, conv_w, conv_b, w_out):
    D = u.shape[-1]
    b_gate, c_gate, h = jnp.split(u @ w_in, 3, axis=-1)
    z = c_gate * h
    conv = lax.conv_general_dilated(z, conv_w.reshape(CONV_WIDTH, 1, D).astype(z.dtype), window_strides=(1,),
                                    padding=((CONV_WIDTH // 2, CONV_WIDTH // 2),),
                                    dimension_numbers=('NWC', 'WIO', 'NWC'), feature_group_count=D)
    return (b_gate * (conv + conv_b)) @ w_out


def peer_ffn(u, w_q, sub_keys, exp_u, exp_v):
    B, T, D = u.shape
    N = B * T
    xt = u.reshape(N, D)
    q = (xt @ w_q).reshape(N, PEER_HEADS, 2, PEER_HALF)
    s = jnp.einsum('nhcd,hckd->nhck', q, sub_keys, preferred_element_type=jnp.float32)
    v1, i1 = lax.top_k(s[:, :, 0], PEER_TOPK)
    v2, i2 = lax.top_k(s[:, :, 1], PEER_TOPK)
    cand_s = (v1[..., :, None] + v2[..., None, :]).reshape(N, PEER_HEADS, PEER_TOPK * PEER_TOPK)
    cand_i = (i1[..., :, None] * PEER_N_KEYS + i2[..., None, :]).reshape(N, PEER_HEADS, PEER_TOPK * PEER_TOPK)
    top_s, pos = lax.top_k(cand_s, PEER_TOPK)
    idx = jnp.take_along_axis(cand_i, pos, axis=-1)
    gate = jax.nn.softmax(top_s, axis=-1)
    nb = N // TOKEN_BLOCK
    xb = xt.reshape(nb, TOKEN_BLOCK, D)
    ib = idx.reshape(nb, TOKEN_BLOCK, PEER_HEADS * PEER_TOPK)
    gb = gate.reshape(nb, TOKEN_BLOCK, PEER_HEADS * PEER_TOPK)

    def one_block(args):
        xi, ii, gi = args
        h = jnp.einsum('td,ted->te', xi, exp_u[ii], preferred_element_type=jnp.float32)
        a = (jax.nn.gelu(h, approximate=False) * gi).astype(xi.dtype)
        return jnp.einsum('te,ted->td', a, exp_v[ii])

    return lax.map(one_block, (xb, ib, gb)).reshape(B, T, D)


def setup_inputs(seed: int = 0) -> dict:
    key = jax.random.key(seed)
    ks = iter(jax.random.split(key, 40))
    f32 = jnp.float32
    D = D_MODEL

    def nrm(shape, scale):
        return jax.random.normal(next(ks), shape, f32) * scale

    inp = {}
    inp['x_prompt'] = nrm((BATCH, SEQ, D), 1.0)
    inp['x_sample'] = nrm((DEC_BATCH, DEC_SEQ, D), 1.0)
    inp['cache_l0_ckv'] = nrm((DEC_BATCH, PAST_LEN, MLA_KV_LORA), 1.0)
    inp['cache_l0_krope'] = nrm((DEC_BATCH, PAST_LEN, MLA_ROPE), 1.0)
    inp['cache_l1_k'] = nrm((DEC_BATCH, PAST_LEN, GQA_KV_HEADS, GQA_HEAD_DIM), 1.0)
    inp['cache_l1_v'] = nrm((DEC_BATCH, PAST_LEN, GQA_KV_HEADS, GQA_HEAD_DIM), 1.0)
    inp['c'] = nrm((DEC_BATCH, D), 1.0)
    inp['c_ctx'] = nrm((D,), 1.0)
    inp['ada_w'] = nrm((DEPTH, D, 6 * D), 0.5 * D ** -0.5)
    inp['ada_b'] = nrm((DEPTH, 6 * D), 0.01)
    inp['ln1_g'] = 1.0 + nrm((DEPTH, D), 0.01)
    inp['ln1_b'] = nrm((DEPTH, D), 0.01)
    inp['ln2_g'] = 1.0 + nrm((DEPTH, D), 0.01)
    inp['ln2_b'] = nrm((DEPTH, D), 0.01)
    inp['mla_w_dq'] = nrm((D, MLA_Q_LORA), D ** -0.5)
    inp['mla_q_norm'] = 1.0 + nrm((MLA_Q_LORA,), 0.01)
    inp['mla_w_uq'] = nrm((MLA_Q_LORA, MLA_HEADS * (MLA_NOPE + MLA_ROPE)), MLA_Q_LORA ** -0.5)
    inp['mla_w_dkv'] = nrm((D, MLA_KV_LORA + MLA_ROPE), D ** -0.5)
    inp['mla_kv_norm'] = 1.0 + nrm((MLA_KV_LORA,), 0.01)
    inp['mla_w_uk'] = nrm((MLA_KV_LORA, MLA_HEADS * MLA_NOPE), MLA_KV_LORA ** -0.5)
    inp['mla_w_uv'] = nrm((MLA_KV_LORA, MLA_HEADS * MLA_V), MLA_KV_LORA ** -0.5)
    inp['mla_w_o'] = nrm((MLA_HEADS * MLA_V, D), DEEPNORM_BETA * (MLA_HEADS * MLA_V) ** -0.5)
    inp['gqa_w_qkv'] = nrm((D, (GQA_HEADS + 2 * GQA_KV_HEADS) * GQA_HEAD_DIM), D ** -0.5)
    inp['gqa_sink'] = nrm((GQA_HEADS,), 0.5)
    inp['gqa_w_o'] = nrm((GQA_HEADS * GQA_HEAD_DIM, D), DEEPNORM_BETA * (GQA_HEADS * GQA_HEAD_DIM) ** -0.5)
    inp['fnet_w_out'] = nrm((D, D), DEEPNORM_BETA * D ** -0.5)
    inp['conv_w_in'] = nrm((D, 3 * D), D ** -0.5)
    inp['conv_w'] = nrm((CONV_WIDTH, D), CONV_WIDTH ** -0.5)
    inp['conv_b'] = nrm((D,), 0.01)
    inp['conv_w_out'] = nrm((D, D), DEEPNORM_BETA * D ** -0.5)
    inp['peer_w_q'] = nrm((DEPTH, D, PEER_HEADS * PEER_QUERY_DIM), D ** -0.5)
    inp['peer_sub_keys'] = nrm((DEPTH, PEER_HEADS, 2, PEER_N_KEYS, PEER_HALF), PEER_HALF ** -0.5)
    inp['peer_u'] = nrm((DEPTH, PEER_N_EXPERTS, D), D ** -0.5)
    inp['peer_v'] = nrm((DEPTH, PEER_N_EXPERTS, D), DEEPNORM_BETA)
    return inp


def reference(x_prompt, x_sample, cache_l0_ckv, cache_l0_krope, cache_l1_k, cache_l1_v, c, c_ctx,
              ada_w, ada_b, ln1_g, ln1_b, ln2_g, ln2_b,
              mla_w_dq, mla_q_norm, mla_w_uq, mla_w_dkv, mla_kv_norm, mla_w_uk, mla_w_uv, mla_w_o,
              gqa_w_qkv, gqa_sink, gqa_w_o,
              fnet_w_out,
              conv_w_in, conv_w, conv_b, conv_w_out,
              peer_w_q, peer_sub_keys, peer_u, peer_v):
    xp, xs = x_prompt, x_sample
    new_l0_ckv = new_l0_krope = new_l1_k = new_l1_v = None
    for i in range(DEPTH):
        m = i % N_MIXERS
        mp = ada_modulation(c_ctx[None, :], ada_w[i], ada_b[i])
        ms = ada_modulation(c, ada_w[i], ada_b[i])
        up = modulate(xp, mp[0], mp[1])
        us = modulate(xs, ms[0], ms[1])
        if m == 0:
            qn, qr = mla_queries(up, mla_w_dq, mla_q_norm, mla_w_uq)
            ckv_p, kr_p = mla_compress(up, mla_w_dkv, mla_kv_norm)
            op = mla_attend(qn, qr, ckv_p, kr_p, mla_w_uk, mla_w_uv, mla_w_o)
            new_l0_ckv, new_l0_krope = ckv_p, kr_p
            qn, qr = mla_queries(us, mla_w_dq, mla_q_norm, mla_w_uq)
            qr = axial_rope(qr)
            ckv_s, kr_s = mla_compress(us, mla_w_dkv, mla_kv_norm)
            kr_s = axial_rope(kr_s[:, :, None, :])[:, :, 0, :]
            os_ = mla_attend(qn, qr, jnp.concatenate([ckv_s, cache_l0_ckv], 1),
                             jnp.concatenate([kr_s, cache_l0_krope], 1), mla_w_uk, mla_w_uv, mla_w_o)
        elif m == 1:
            q, k, v = gqa_split(up, gqa_w_qkv)
            op = block_attention(q, k, v, GQA_SCALE, gqa_sink).reshape(xp.shape[0], xp.shape[1], -1) @ gqa_w_o
            new_l1_k, new_l1_v = k, v
            q, k, v = gqa_split(us, gqa_w_qkv)
            o = banded_window_attention(axial_rope(q), axial_rope(k), v, cache_l1_k, cache_l1_v, gqa_sink, GQA_SCALE)
            os_ = o.reshape(xs.shape[0], xs.shape[1], -1) @ gqa_w_o
        elif m == 2:
            op = fourier_mix(up, fnet_w_out)
            os_ = fourier_mix(us, fnet_w_out)
        else:
            op = short_conv_mix(up, conv_w_in, conv_w, conv_b, conv_w_out)
            os_ = short_conv_mix(us, conv_w_in, conv_w, conv_b, conv_w_out)
        xp = post_norm(xp, op, mp[2], ln1_g[i], ln1_b[i])
        xs = post_norm(xs, os_, ms[2], ln1_g[i], ln1_b[i])
        up = modulate(xp, mp[3], mp[4])
        us = modulate(xs, ms[3], ms[4])
        fp = peer_ffn(up, peer_w_q[i], peer_sub_keys[i], peer_u[i], peer_v[i])
        fs = peer_ffn(us, peer_w_q[i], peer_sub_keys[i], peer_u[i], peer_v[i])
        xp = post_norm(xp, fp, mp[5], ln2_g[i], ln2_b[i])
        xs = post_norm(xs, fs, ms[5], ln2_g[i], ln2_b[i])
    return (xp, xs, new_l0_ckv, new_l0_krope, new_l1_k, new_l1_v)
```

```cpp
#include <hip/hip_runtime.h>
#include <cstdio>
#include <cstdint>

#ifndef MK_PER_PHASE
#define MK_PER_PHASE 0
#endif

#define LAS __attribute__((address_space(3)))
typedef unsigned short bf16;
typedef short bf16x8 __attribute__((ext_vector_type(8)));
typedef float f32x4 __attribute__((ext_vector_type(4)));
typedef unsigned u32x4 __attribute__((ext_vector_type(4)));
typedef unsigned u32x2 __attribute__((ext_vector_type(2)));
typedef __bf16 bf16x2_t __attribute__((ext_vector_type(2)));

constexpr int D = 2048, NPR = 4096, MT = 6144, KVR = 6656;
constexpr int NTHR = 512, NWAVE = 8;
constexpr float ALPHA = 1.6817928305074290f;
constexpr float MLA_SCALE = 0.07216878364870322f;
constexpr float GQA_SCALE = 0.125f;
constexpr float LN_EPS = 1e-5f, RMS_EPS = 1e-6f;

constexpr size_t MiB = 1u << 20;
constexpr size_t WS_CTL = 0, CTL_BYTES = 1 * MiB;
constexpr size_t WS_MODS = 1 * MiB;
constexpr size_t WS_W0T = 2 * MiB, WS_WUQT = 7 * MiB, WS_WUKT = 10 * MiB, WS_WUVT = 12 * MiB, WS_WOT0 = 14 * MiB, WS_WQKVT = 22 * MiB,
                 WS_WOT1 = 34 * MiB, WS_WFT = 42 * MiB, WS_WINT = 50 * MiB, WS_WCOT = 74 * MiB, WS_WPQT = 82 * MiB, WS_SK = 114 * MiB,
                 WS_CS512 = 116 * MiB, WS_CT256 = 117 * MiB, WS_CT1024 = 118 * MiB, WS_PU = 122 * MiB, WS_PV = 186 * MiB,
                 WS_X = 250 * MiB, WS_Y = 298 * MiB, WS_U = 346 * MiB, WS_O = 370 * MiB, WS_Q = 394 * MiB, WS_KC = 430 * MiB,
                 WS_VT = 469 * MiB, WS_QN = 495 * MiB, WS_CKV = 501 * MiB, WS_SCR = 508 * MiB, WS_END = 956 * MiB;
constexpr size_t OUT_Y = 0, OUT_CKV = 12582912, OUT_KR = 14680064, OUT_K1 = 14942208, OUT_V1 = 17039360;

constexpr int LDS_BYTES = 147456;
constexpr int LDS_MISC = 140 * 1024;

#define LDS_WAIT() asm volatile("s_waitcnt lgkmcnt(0)" ::: "memory")
__device__ __forceinline__ unsigned f2bf(float f) { unsigned u = __float_as_uint(f); return (u + 0x7fffu + ((u >> 16) & 1u)) >> 16; }
__device__ __forceinline__ unsigned pk2(float lo, float hi) { unsigned r; asm("v_cvt_pk_bf16_f32 %0, %1, %2" : "=v"(r) : "v"(lo), "v"(hi)); return r; }
__device__ __forceinline__ float bflo(unsigned w) { return __uint_as_float(w << 16); }
__device__ __forceinline__ float bfhi(unsigned w) { return __uint_as_float(w & 0xffff0000u); }
__device__ __forceinline__ float wave_sum(float v) {
#pragma unroll
    for (int o = 1; o < 64; o <<= 1) v += __shfl_xor(v, o);
    return v;
}
__device__ __forceinline__ float wave_max(float v) {
#pragma unroll
    for (int o = 1; o < 64; o <<= 1) v = fmaxf(v, __shfl_xor(v, o));
    return v;
}
__device__ __forceinline__ float dot2bf(unsigned w, unsigned x, float acc) {
    return __builtin_amdgcn_fdot2_f32_bf16(__builtin_bit_cast(bf16x2_t, w), __builtin_bit_cast(bf16x2_t, x), acc, false);
}
__device__ __forceinline__ int cond_of(int m) { return m < NPR ? 0 : 1 + ((m - NPR) >> 10); }
__device__ __forceinline__ int kvrow_of(int m) { return m < NPR ? m : NPR + ((m - NPR) >> 10) * 1280 + ((m - NPR) & 1023); }

#define XB_TMO      128
#define XB_XCNT(j)  (256  + 64 * (j))
#define XB_XSUB(j)  (1280 + 64 * (j))
#define XB_XGEN(j)  (2304 + 64 * (j))
#define XB_TOP      3328
#define XB_TOPGEN   3392
#define XCD_BAR_WORDS 3456
#define XB_SPIN_CAP (1u << 22)
__device__ __forceinline__ unsigned xb_ld(unsigned* p)              { return __hip_atomic_load(p, __ATOMIC_RELAXED, __HIP_MEMORY_SCOPE_AGENT); }
__device__ __forceinline__ unsigned xb_add(unsigned* p, unsigned v) { return __hip_atomic_fetch_add(p, v, __ATOMIC_RELAXED, __HIP_MEMORY_SCOPE_AGENT); }
__device__ __forceinline__ unsigned xb_xcc_id() { return (unsigned)__builtin_amdgcn_s_getreg((3 << 11) | 20) & 0xFu; }
#define XB_SPIN(cond, bar) do { unsigned _sp = 0; while (cond) { __builtin_amdgcn_s_sleep(1); \
    if ((++_sp & 255u) == 0u) { if (xb_ld(&(bar)[XB_TMO])) break; if (_sp > XB_SPIN_CAP) { atomicAdd(&(bar)[XB_TMO], 1u); break; } } } } while (0)
struct XcdBarrier { unsigned* bar; unsigned x; volatile LAS unsigned* st; };
__device__ __forceinline__ XcdBarrier xcd_barrier_post(unsigned* bar, volatile LAS unsigned* st) {
    XcdBarrier b; b.bar = bar; b.x = xb_xcc_id(); b.st = st;
    if (threadIdx.x == 0) (void)xb_add(&bar[XB_XCNT(b.x)], 1u);
    return b;
}
__device__ __forceinline__ void xcd_barrier_complete(unsigned* bar, unsigned x, unsigned& nloc, unsigned& nx) {
    const unsigned G = gridDim.x * gridDim.y * gridDim.z;
    unsigned sum, cnt, mine, sp = 0u;
    for (;;) {
        sum = 0u; cnt = 0u; mine = 0u;
#pragma unroll
        for (unsigned j = 0; j < 16; ++j) { const unsigned c = xb_ld(&bar[XB_XCNT(j)]); sum += c; cnt += (c > 0u) ? 1u : 0u; mine = (j == x) ? c : mine; }
        if (sum == G) break;
        __builtin_amdgcn_s_sleep(1);
        if ((++sp & 255u) == 0u) { if (xb_ld(&bar[XB_TMO])) break; if (sp > XB_SPIN_CAP) { atomicAdd(&bar[XB_TMO], 1u); break; } }
    }
    nloc = mine > 0u ? mine : 1u; nx = cnt > 0u ? cnt : 1u;
}
__device__ __forceinline__ void xcd_barrier(const XcdBarrier& b) {
    asm volatile("s_waitcnt vmcnt(0)" ::: "memory");
    __syncthreads();
    if (threadIdx.x == 0) {
        unsigned* bar = b.bar;
        __builtin_amdgcn_s_waitcnt(0);
        unsigned nloc = b.st[0], nx = b.st[1];
        if (nloc == 0u) { xcd_barrier_complete(bar, b.x, nloc, nx); b.st[0] = nloc; b.st[1] = nx; }
        const unsigned old = xb_add(&bar[XB_XSUB(b.x)], 1u);
        const unsigned gen = old / nloc;
        if (old + 1u == (gen + 1u) * nloc) {
            __builtin_amdgcn_fence(__ATOMIC_RELEASE, "agent");
            asm volatile("s_waitcnt vmcnt(0)" ::: "memory");
            const unsigned og = xb_add(&bar[XB_TOP], 1u);
            const unsigned tg = og / nx;
            if (og + 1u == (tg + 1u) * nx) xb_add(&bar[XB_TOPGEN], 1u);
            else XB_SPIN(xb_ld(&bar[XB_TOPGEN]) == tg, bar);
            __builtin_amdgcn_fence(__ATOMIC_ACQUIRE, "agent");
            xb_add(&bar[XB_XGEN(b.x)], 1u);
            asm volatile("s_waitcnt vmcnt(0)" ::: "memory");
        } else {
            XB_SPIN(xb_ld(&bar[XB_XGEN(b.x)]) == gen, bar);
            __builtin_amdgcn_fence(__ATOMIC_ACQUIRE, "agent");
            asm volatile("s_waitcnt vmcnt(0)" ::: "memory");
        }
    }
    __syncthreads();
}

struct TJob { const float* W; unsigned long long dst; int K, N, row_off, first; };
constexpr int NTJOB = 15;
struct Args {
    const float* in[34];
    float* out;
    unsigned char* ws;
    TJob tj[NTJOB];
    int tj_total;
    int ph_lo, ph_hi, pad;
};
enum { I_XP = 0, I_XS, I_C0CKV, I_C0KR, I_C1K, I_C1V, I_C, I_CCTX, I_ADAW, I_ADAB, I_LN1G, I_LN1B, I_LN2G, I_LN2B,
       I_WDQ, I_QNORM, I_WUQ, I_WDKV, I_KVNORM, I_WUK, I_WUV, I_WO0, I_WQKV, I_SINK, I_WO1, I_WF, I_WIN, I_CONVW, I_CONVB, I_WCO,
       I_WPQ, I_SUBK, I_PEERU, I_PEERV };

struct GemmP {
    const bf16* A; const bf16* B;
    long lda, ldb;
    long sA1, sA2, sA3, sB1, sB2, sB3;
    int M, N, K, nb1, nb2, nb3;
};
constexpr int SG_LDT = 72;
constexpr int SG_TILE = 128 * SG_LDT * 2;
template <class Epi>
__device__ __forceinline__ void sg_gemm(LAS unsigned char* lds, const GemmP g, const Epi& E, int bid, int nblk, int& ubase) {
    const int tid = threadIdx.x, lane = tid & 63, wave = __builtin_amdgcn_readfirstlane(tid >> 6);
    const int wm = wave >> 2, wn = wave & 3, fr = lane & 15, fq = lane >> 4;
    const int tiles_m = (g.M + 127) >> 7, tiles_n = (g.N + 127) >> 7;
    const int nbatch = g.nb1 * g.nb2 * g.nb3;
    const int U = nbatch * tiles_m * tiles_n;
    const int nk = g.K >> 6;
    int first = (bid - (ubase % nblk) + nblk) % nblk;
    ubase += U;
    const int lrow0 = tid >> 3, lkc = tid & 7;
    const int aoff = (wm * 64 + fr) * (SG_LDT * 2) + fq * 16;
    const int boff = (wn * 32 + fr) * (SG_LDT * 2) + fq * 16;
    for (int u = first; u < U; u += nblk) {
        const int tn = u % tiles_n; const int r1 = u / tiles_n; const int tm = r1 % tiles_m; const int b = r1 / tiles_m;
        const int b3 = b % g.nb3, b12 = b / g.nb3, b2 = b12 % g.nb2, b1 = b12 / g.nb2;
        const int m0 = tm << 7, n0 = tn << 7;
        const bf16* Ab = g.A + b1 * g.sA1 + b2 * g.sA2 + b3 * g.sA3;
        const bf16* Bb = g.B + b1 * g.sB1 + b2 * g.sB2 + b3 * g.sB3;
        int ar0 = m0 + lrow0, ar1 = ar0 + 64; ar0 = ar0 < g.M ? ar0 : g.M - 1; ar1 = ar1 < g.M ? ar1 : g.M - 1;
        int br0 = n0 + lrow0, br1 = br0 + 64; br0 = br0 < g.N ? br0 : g.N - 1; br1 = br1 < g.N ? br1 : g.N - 1;
        const bf16* pa0 = Ab + (long)ar0 * g.lda + lkc * 8; const bf16* pa1 = Ab + (long)ar1 * g.lda + lkc * 8;
        const bf16* pb0 = Bb + (long)br0 * g.ldb + lkc * 8; const bf16* pb1 = Bb + (long)br1 * g.ldb + lkc * 8;
        f32x4 acc[4][2];
#pragma unroll
        for (int i = 0; i < 4; ++i) { acc[i][0] = (f32x4){0.f, 0.f, 0.f, 0.f}; acc[i][1] = (f32x4){0.f, 0.f, 0.f, 0.f}; }
        u32x4 ra0 = *(const u32x4*)pa0, ra1 = *(const u32x4*)pa1, rb0 = *(const u32x4*)pb0, rb1 = *(const u32x4*)pb1;
        const int wofs = lrow0 * (SG_LDT * 2) + lkc * 16;
        *(LAS u32x4*)(lds + wofs) = ra0; *(LAS u32x4*)(lds + wofs + 64 * SG_LDT * 2) = ra1;
        *(LAS u32x4*)(lds + SG_TILE + wofs) = rb0; *(LAS u32x4*)(lds + SG_TILE + wofs + 64 * SG_LDT * 2) = rb1;
        __syncthreads();
        for (int kt = 0; kt < nk; ++kt) {
            const int cur = (kt & 1) * 2 * SG_TILE, nxt = ((kt + 1) & 1) * 2 * SG_TILE;
            const bool more = (kt + 1 < nk);
            if (more) { const int ko = (kt + 1) << 6; ra0 = *(const u32x4*)(pa0 + ko); ra1 = *(const u32x4*)(pa1 + ko); rb0 = *(const u32x4*)(pb0 + ko); rb1 = *(const u32x4*)(pb1 + ko); }
#pragma unroll
            for (int ks = 0; ks < 2; ++ks) {
                bf16x8 af[4], bfr[2];
#pragma unroll
                for (int i = 0; i < 4; ++i) af[i] = *(const LAS bf16x8*)(lds + cur + aoff + i * 16 * SG_LDT * 2 + ks * 64);
#pragma unroll
                for (int j = 0; j < 2; ++j) bfr[j] = *(const LAS bf16x8*)(lds + cur + SG_TILE + boff + j * 16 * SG_LDT * 2 + ks * 64);
#pragma unroll
                for (int i = 0; i < 4; ++i)
#pragma unroll
                    for (int j = 0; j < 2; ++j) acc[i][j] = __builtin_amdgcn_mfma_f32_16x16x32_bf16(bfr[j], af[i], acc[i][j], 0, 0, 0);
            }
            if (more) {
                *(LAS u32x4*)(lds + nxt + wofs) = ra0; *(LAS u32x4*)(lds + nxt + wofs + 64 * SG_LDT * 2) = ra1;
                *(LAS u32x4*)(lds + nxt + SG_TILE + wofs) = rb0; *(LAS u32x4*)(lds + nxt + SG_TILE + wofs + 64 * SG_LDT * 2) = rb1;
            }
            __syncthreads();
        }
        const int nn = n0 + wn * 32 + 4 * fq;
        if (n0 + wn * 32 < g.N) {
#pragma unroll
            for (int i = 0; i < 4; ++i) { const int m = m0 + wm * 64 + i * 16 + fr; if (m < g.M) E(b1, b2, b3, m, nn, acc[i][0], acc[i][1]); }
        }
    }
}

struct EpiF32 { float* C; long ldc, s1, s2, s3; float scale;
    __device__ __forceinline__ void operator()(int b1, int b2, int b3, int m, int n, f32x4 v0, f32x4 v1) const {
        float* p = C + b1 * s1 + b2 * s2 + b3 * s3 + (long)m * ldc + n; *(f32x4*)p = v0 * scale; *(f32x4*)(p + 16) = v1 * scale; } };
struct EpiBf16 { bf16* C; long ldc, s1, s2, s3; float scale;
    __device__ __forceinline__ void operator()(int b1, int b2, int b3, int m, int n, f32x4 v0, f32x4 v1) const {
        bf16* p = C + b1 * s1 + b2 * s2 + b3 * s3 + (long)m * ldc + n; v0 = v0 * scale; v1 = v1 * scale;
        *(u32x2*)p = (u32x2){pk2(v0[0], v0[1]), pk2(v0[2], v0[3])}; *(u32x2*)(p + 16) = (u32x2){pk2(v1[0], v1[1]), pk2(v1[2], v1[3])}; } };
__device__ __forceinline__ void rope4(f32x4& v0, f32x4& v1, int pos, int j0) {
#pragma unroll
    for (int i = 0; i < 4; ++i) {
        const float inv = exp2f(-(float)(j0 + i) * (13.287712379549449f / 16.0f));
        const float ang = (float)pos * inv; float sn, cs; sincosf(ang, &sn, &cs);
        const float x1 = v0[i], x2 = v1[i]; v0[i] = x1 * cs - x2 * sn; v1[i] = x1 * sn + x2 * cs; }
}
struct EpiQMla { bf16* Q;
    __device__ __forceinline__ void operator()(int, int, int, int m, int n, f32x4 v0, f32x4 v1) const {
        const int d = n % 192, d0 = d & ~31;
        if (m >= NPR && d0 >= 128) { const int t = (m - NPR) & 1023; const int pos = (d0 == 128) ? (t >> 6) : (t & 63); rope4(v0, v1, pos, d & 15); }
        bf16* p = Q + (long)m * 3072 + n;
        *(u32x2*)p = (u32x2){pk2(v0[0], v0[1]), pk2(v0[2], v0[3])}; *(u32x2*)(p + 16) = (u32x2){pk2(v1[0], v1[1]), pk2(v1[2], v1[3])}; } };
struct EpiKn { bf16* KC;
    __device__ __forceinline__ void operator()(int, int, int, int m, int n, f32x4 v0, f32x4 v1) const {
        bf16* p = KC + ((long)m * 16 + (n >> 7)) * 192 + (n & 127);
        *(u32x2*)p = (u32x2){pk2(v0[0], v0[1]), pk2(v0[2], v0[3])}; *(u32x2*)(p + 16) = (u32x2){pk2(v1[0], v1[1]), pk2(v1[2], v1[3])}; } };
struct EpiResid { float* Y; const float* X; const float* gate;
    __device__ __forceinline__ void operator()(int, int, int, int m, int n, f32x4 v0, f32x4 v1) const {
        const float* gp = gate + cond_of(m) * 12288 + n; const float* xp = X + (long)m * D + n; float* yp = Y + (long)m * D + n;
        const f32x4 g0 = *(const f32x4*)gp, g1 = *(const f32x4*)(gp + 16), x0 = *(const f32x4*)xp, x1 = *(const f32x4*)(xp + 16);
        *(f32x4*)yp = x0 * ALPHA + g0 * v0; *(f32x4*)(yp + 16) = x1 * ALPHA + g1 * v1; } };
struct EpiQkv1 { bf16* Q1; bf16* K1; bf16* VT1; float* outk; float* outv;
    __device__ __forceinline__ void operator()(int, int, int, int m, int n, f32x4 v0, f32x4 v1) const {
        const int kvr = kvrow_of(m);
        if (n < 2560) {
            if (n >= 2048 && m < NPR) { float* p = outk + (long)m * 512 + (n - 2048); *(f32x4*)p = v0; *(f32x4*)(p + 16) = v1; }
            if (m >= NPR) { const int t = (m - NPR) & 1023; const int pos = ((n & 32) == 0) ? (t >> 6) : (t & 63); rope4(v0, v1, pos, n & 15); }
            bf16* p = (n < 2048) ? (Q1 + (long)m * 2048 + n) : (K1 + (long)kvr * 512 + (n - 2048));
            *(u32x2*)p = (u32x2){pk2(v0[0], v0[1]), pk2(v0[2], v0[3])}; *(u32x2*)(p + 16) = (u32x2){pk2(v1[0], v1[1]), pk2(v1[2], v1[3])};
        } else {
            const int c = n - 2560;
            if (m < NPR) { float* p = outv + (long)m * 512 + c; *(f32x4*)p = v0; *(f32x4*)(p + 16) = v1; }
#pragma unroll
            for (int i = 0; i < 4; ++i) { VT1[(long)(c + i) * KVR + kvr] = (bf16)f2bf(v0[i]); VT1[(long)(c + 16 + i) * KVR + kvr] = (bf16)f2bf(v1[i]); }
        } } };
struct EpiDft1 { bf16* YTp; bf16* YTs;
    __device__ __forceinline__ void operator()(int g, int, int, int j, int tok, f32x4 v0, f32x4 v1) const {
        const int h = j >> 9, c = j & 511;
#pragma unroll
        for (int q = 0; q < 2; ++q) { const int tk = tok + 16 * q; const f32x4 v = q ? v1 : v0; bf16* p;
            if (tk < NPR) { const int b = tk >> 8, t = tk & 255; p = YTp + ((long)(b * 2048 + g * 512 + c) * 512 + h * 256 + t); }
            else { const int s = tk - NPR, b = s >> 10, t = s & 1023; p = YTs + ((long)(b * 2048 + g * 512 + c) * 2048 + h * 1024 + t); }
            *(u32x2*)p = (u32x2){pk2(v[0], v[1]), pk2(v[2], v[3])}; } } };

template <class T> __device__ __forceinline__ T* opq(T* p) { asm volatile("" : "+s"(p)); return p; }
struct Frame {
    LAS unsigned char* lds;
    unsigned char* ws;
    int tid, lane, wave, bid, nblk, gw, ngw;
};

__device__ __forceinline__ void ln_row(const float* yrow, const float* g, const float* b, float* xrow, bf16* urow, const float* shift, const float* scale, float* orow, int lane) {
    f32x4 v[8]; float s = 0.f;
#pragma unroll
    for (int i = 0; i < 8; ++i) { v[i] = *(const f32x4*)(yrow + i * 256 + lane * 4); s += (v[i][0] + v[i][1]) + (v[i][2] + v[i][3]); }
    const float mean = wave_sum(s) * (1.f / D); float s2 = 0.f;
#pragma unroll
    for (int i = 0; i < 8; ++i) { v[i] = v[i] - mean; s2 += (v[i][0] * v[i][0] + v[i][1] * v[i][1]) + (v[i][2] * v[i][2] + v[i][3] * v[i][3]); }
    const float rstd = rsqrtf(wave_sum(s2) * (1.f / D) + LN_EPS);
#pragma unroll
    for (int i = 0; i < 8; ++i) { const int c = i * 256 + lane * 4;
        const f32x4 o = v[i] * rstd * *(const f32x4*)(g + c) + *(const f32x4*)(b + c);
        *(f32x4*)(xrow + c) = o;
        if (orow) *(f32x4*)(orow + c) = o;
        if (urow) { const f32x4 u = o * (*(const f32x4*)(scale + c) + 1.0f) + *(const f32x4*)(shift + c); *(u32x2*)(urow + c) = (u32x2){pk2(u[0], u[1]), pk2(u[2], u[3])}; } }
}

template <int NV, bool BAND>
__device__ __forceinline__ void softmax_row(float* row, int t, bool has_sink, float sink, int lane) {
    f32x4 v[NV]; float mx = -3.0e38f;
#pragma unroll
    for (int i = 0; i < NV; ++i) { v[i] = *(const f32x4*)(row + i * 256 + lane * 4);
#pragma unroll
        for (int e = 0; e < 4; ++e) { if (BAND) { const int s = i * 256 + lane * 4 + e; const int dlt = t - s; const bool ok = (s >= 1024) || (dlt <= 128 && dlt >= -128); if (!ok) v[i][e] = -3.0e38f; } mx = fmaxf(mx, v[i][e]); } }
    mx = wave_max(mx); if (has_sink) mx = fmaxf(mx, sink);
    float sum = 0.f;
#pragma unroll
    for (int i = 0; i < NV; ++i)
#pragma unroll
        for (int e = 0; e < 4; ++e) { const float p = (v[i][e] < -1.0e38f) ? 0.f : __expf(v[i][e] - mx); v[i][e] = p; sum += p; }
    sum = wave_sum(sum); if (has_sink) sum += __expf(sink - mx);
    const float inv = 1.f / sum;
    bf16* prow = (bf16*)row;
#pragma unroll
    for (int i = 0; i < NV; ++i) *(u32x2*)(prow + i * 256 + lane * 4) = (u32x2){pk2(v[i][0] * inv, v[i][1] * inv), pk2(v[i][2] * inv, v[i][3] * inv)};
}

__device__ __forceinline__ void transpose_item(const float* W, int K, int N, bf16* WT, int row_off, LAS float* scr, int item, int lane) {
    const int nblkn = N / 32, kb = item / nblkn, nb = item % nblkn, k0 = 64 * kb, n0 = 32 * nb;
#pragma unroll 8
    for (int i = 0; i < 32; ++i) { const int kk = 2 * i + (lane >> 5); scr[kk * 33 + (lane & 31)] = W[(size_t)(k0 + kk) * N + n0 + (lane & 31)]; }
    LDS_WAIT();
    const int c = lane & 7;
#pragma unroll
    for (int j = 0; j < 4; ++j) { const int n = (lane >> 3) + 8 * j; const LAS float* s = scr + (8 * c) * 33 + n;
        u32x4 o; o.x = pk2(s[0 * 33], s[1 * 33]); o.y = pk2(s[2 * 33], s[3 * 33]); o.z = pk2(s[4 * 33], s[5 * 33]); o.w = pk2(s[6 * 33], s[7 * 33]);
        *(u32x4*)(WT + (size_t)(row_off + n0 + n) * K + k0 + 8 * c) = o; }
    LDS_WAIT();
}

__device__ __forceinline__ int cflat(int l) {
    int a = 0, base = 0;
    if (l >= 16) { a = 1; base = 16; } if (l >= 24) { a = 2; base = 24; } if (l >= 29) { a = 3; base = 29; } if (l >= 33) { a = 4; base = 33; }
    if (l >= 36) { a = 5; base = 36; } if (l >= 38) { a = 6; base = 38; } if (l >= 40) { a = 7; base = 40; } if (l >= 42) { a = 8 + (l - 42); base = l; }
    return l < 50 ? a * 16 + (l - base) : 9999;
}
#if !MK_PER_PHASE
#define SYNC() xcd_barrier(bar)
#else
#define SYNC() do {} while (0)
#endif
#define PH_BEGIN unsigned char* ws = opq(ws_)
#define IP(i) opq(args.in[i])
#define MODS ((float*)(ws + WS_MODS))
#define X ((float*)(ws + WS_X))
#define Y ((float*)(ws + WS_Y))
#define Ub ((bf16*)(ws + WS_U))
#define Ob ((bf16*)(ws + WS_O))
#define SCR (ws + WS_SCR)
#define IN(k) (lo <= (k) && (k) < hi)
#define ENDPH(k) do { if (hi > (k) + 1) SYNC(); } while (0)
template <int L>
__device__ __forceinline__ void layer_phases(const Args& args, const Frame& F, unsigned char* const ws_, const int lo, const int hi, const XcdBarrier& bar) {
    int ub;
        const int P = 2 + L * 16;
#define modL (MODS + L * 3 * 12288)
        if constexpr (L == 0) {
#define T0 ((float*)SCR)
#define QN ((bf16*)(ws + WS_QN))
#define CKV ((bf16*)(ws + WS_CKV))
#define Qb ((bf16*)(ws + WS_Q))
#define KC ((bf16*)(ws + WS_KC))
#define VT ((bf16*)(ws + WS_VT))
#define SCp ((float*)SCR)
#define SCs ((float*)(SCR + 64 * MiB))
            if (IN(P + 0)) { PH_BEGIN;
                ub = 0; GemmP g{Ub, (const bf16*)(ws + WS_W0T), D, D, 0, 0, 0, 0, 0, 0, MT, 1088, D, 1, 1, 1};
                sg_gemm(F.lds, g, EpiF32{T0, 1088, 0, 0, 0, 1.f}, F.bid, F.nblk, ub);
                ENDPH(P + 0);
            }
            if (IN(P + 1)) { PH_BEGIN;
                const float* qg = IP(I_QNORM); const float* kg = IP(I_KVNORM);
                for (int m = F.gw; m < MT; m += F.ngw) {
                    const float* tr = T0 + (size_t)m * 1088; const int kvr = kvrow_of(m); const int c = F.lane * 8;
                    { f32x4 a = *(const f32x4*)(tr + c), b = *(const f32x4*)(tr + c + 4);
                      float ss = (a[0] * a[0] + a[1] * a[1]) + (a[2] * a[2] + a[3] * a[3]) + (b[0] * b[0] + b[1] * b[1]) + (b[2] * b[2] + b[3] * b[3]);
                      const float r = rsqrtf(wave_sum(ss) * (1.f / 512.f) + RMS_EPS);
                      a = a * r * *(const f32x4*)(qg + c); b = b * r * *(const f32x4*)(qg + c + 4);
                      *(u32x4*)(QN + (size_t)m * 512 + c) = (u32x4){pk2(a[0], a[1]), pk2(a[2], a[3]), pk2(b[0], b[1]), pk2(b[2], b[3])}; }
                    { f32x4 a = *(const f32x4*)(tr + 512 + c), b = *(const f32x4*)(tr + 512 + c + 4);
                      float ss = (a[0] * a[0] + a[1] * a[1]) + (a[2] * a[2] + a[3] * a[3]) + (b[0] * b[0] + b[1] * b[1]) + (b[2] * b[2] + b[3] * b[3]);
                      const float r = rsqrtf(wave_sum(ss) * (1.f / 512.f) + RMS_EPS);
                      a = a * r * *(const f32x4*)(kg + c); b = b * r * *(const f32x4*)(kg + c + 4);
                      *(u32x4*)(CKV + (size_t)kvr * 512 + c) = (u32x4){pk2(a[0], a[1]), pk2(a[2], a[3]), pk2(b[0], b[1]), pk2(b[2], b[3])};
                      if (m < NPR) { float* o = args.out + OUT_CKV + (size_t)m * 512 + c; *(f32x4*)o = a; *(f32x4*)(o + 4) = b; } }
                    { float x = tr[1024 + F.lane];
                      if (m < NPR) args.out[OUT_KR + (size_t)m * 64 + F.lane] = x;
                      else { const int t = (m - NPR) & 1023, e = F.lane, j = e & 15; const int pos = (e < 32) ? (t >> 6) : (t & 63);
                          const float inv = exp2f(-(float)j * (13.287712379549449f / 16.0f)); float sn, cs; sincosf((float)pos * inv, &sn, &cs);
                          const float pr = __shfl_xor(x, 16); x = ((e & 16) == 0) ? (x * cs - pr * sn) : (pr * sn + x * cs); }
                      const bf16 xb = (bf16)f2bf(x);
#pragma unroll
                      for (int h = 0; h < 16; ++h) KC[((size_t)kvr * 16 + h) * 192 + 128 + F.lane] = xb; }
                }
                ENDPH(P + 1);
            }
            if (IN(P + 2)) { PH_BEGIN;
                ub = 0; GemmP g{QN, (const bf16*)(ws + WS_WUQT), 512, 512, 0, 0, 0, 0, 0, 0, MT, 3072, 512, 1, 1, 1};
                sg_gemm(F.lds, g, EpiQMla{Qb}, F.bid, F.nblk, ub);
                GemmP g2{CKV, (const bf16*)(ws + WS_WUKT), 512, 512, 0, 0, 0, 0, 0, 0, KVR, 2048, 512, 1, 1, 1};
                sg_gemm(F.lds, g2, EpiKn{KC}, F.bid, F.nblk, ub);
                GemmP g3{(const bf16*)(ws + WS_WUVT), CKV, 512, 512, 0, 0, 0, 0, 0, 0, 2048, KVR, 512, 1, 1, 1};
                sg_gemm(F.lds, g3, EpiBf16{VT, KVR, 0, 0, 0, 1.f}, F.bid, F.nblk, ub);
                ENDPH(P + 2);
            }
            if (IN(P + 3)) { PH_BEGIN;
                ub = 0;
                GemmP gp{Qb, KC, 3072, 3072, 256L * 3072, 192, 0, 256L * 3072, 192, 0, 256, 256, 192, 16, 16, 1};
                sg_gemm(F.lds, gp, EpiF32{SCp, 256, 16L * 256 * 256, 256L * 256, 0, MLA_SCALE}, F.bid, F.nblk, ub);
                GemmP gs{Qb + (size_t)NPR * 3072, KC + (size_t)NPR * 3072, 3072, 3072, 1024L * 3072, 192, 0, 1280L * 3072, 192, 0, 1024, 1280, 192, 2, 16, 1};
                sg_gemm(F.lds, gs, EpiF32{SCs, 1280, 16L * 1024 * 1280, 1024L * 1280, 0, MLA_SCALE}, F.bid, F.nblk, ub);
                ENDPH(P + 3);
            }
            if (IN(P + 4)) { PH_BEGIN;
                for (int r = F.gw; r < 16 * 16 * 256; r += F.ngw) softmax_row<1, false>(SCp + (size_t)r * 256, 0, false, 0.f, F.lane);
                for (int r = F.gw; r < 2 * 16 * 1024; r += F.ngw) softmax_row<5, false>(SCs + (size_t)r * 1280, 0, false, 0.f, F.lane);
                ENDPH(P + 4);
            }
            if (IN(P + 5)) { PH_BEGIN;
                ub = 0;
                GemmP gp{(const bf16*)SCp, VT, 512, KVR, 16L * 256 * 512, 256L * 512, 0, 256, 128L * KVR, 0, 256, 128, 256, 16, 16, 1};
                sg_gemm(F.lds, gp, EpiBf16{Ob, D, 256L * D, 128, 0, 1.f}, F.bid, F.nblk, ub);
                GemmP gs{(const bf16*)SCs, VT + NPR, 2560, KVR, 16L * 1024 * 2560, 1024L * 2560, 0, 1280, 128L * KVR, 0, 1024, 128, 1280, 2, 16, 1};
                sg_gemm(F.lds, gs, EpiBf16{Ob + (size_t)NPR * D, D, 1024L * D, 128, 0, 1.f}, F.bid, F.nblk, ub);
                ENDPH(P + 5);
            }
        } else if constexpr (L == 1) {
#undef SCs
#define SCs ((float*)(SCR + 128 * MiB))
#define Q1 ((bf16*)(ws + WS_Q))
#define K1 ((bf16*)(ws + WS_KC))
#define VT1 ((bf16*)(ws + WS_VT))
            if (IN(P + 0)) { PH_BEGIN;
                const int gt = F.bid * NTHR + F.tid, ngt = F.nblk * NTHR;
                { const float* c1 = IP(I_C1K);
                  for (int i = gt; i < 2 * 256 * 512; i += ngt) { const int b = i >> 17, r = i & 131071; K1[(size_t)(NPR + b * 1280 + 1024) * 512 + r] = (bf16)f2bf(c1[i]); } }
                { const float* c1 = IP(I_C1V);
                  for (int i = gt; i < 2 * 256 * 512; i += ngt) { const int b = i >> 17, s = (i >> 9) & 255, c = i & 511; VT1[(size_t)c * KVR + NPR + b * 1280 + 1024 + s] = (bf16)f2bf(c1[i]); } }
                ub = 0; GemmP g{Ub, (const bf16*)(ws + WS_WQKVT), D, D, 0, 0, 0, 0, 0, 0, MT, 3072, D, 1, 1, 1};
                sg_gemm(F.lds, g, EpiQkv1{Q1, K1, VT1, args.out + OUT_K1, args.out + OUT_V1}, F.bid, F.nblk, ub);
                ENDPH(P + 0);
            }
            if (IN(P + 3)) { PH_BEGIN;
                ub = 0;
                GemmP gp{Q1, K1, D, 512, 256L * D, 256, 64, 256L * 512, 64, 0, 256, 256, 64, 16, 8, 4};
                sg_gemm(F.lds, gp, EpiF32{SCp, 256, 32L * 256 * 256, 4L * 256 * 256, 256L * 256, GQA_SCALE}, F.bid, F.nblk, ub);
                GemmP gs{Q1 + (size_t)NPR * D, K1 + (size_t)NPR * 512, D, 512, 1024L * D, 256, 64, 1280L * 512, 64, 0, 1024, 1280, 64, 2, 8, 4};
                sg_gemm(F.lds, gs, EpiF32{SCs, 1280, 32L * 1024 * 1280, 4L * 1024 * 1280, 1024L * 1280, GQA_SCALE}, F.bid, F.nblk, ub);
                ENDPH(P + 3);
            }
            if (IN(P + 4)) { PH_BEGIN;
                const float* sink = IP(I_SINK);
                for (int r = F.gw; r < 16 * 32 * 256; r += F.ngw) softmax_row<1, false>(SCp + (size_t)r * 256, 0, true, sink[(r >> 8) & 31], F.lane);
                for (int r = F.gw; r < 2 * 32 * 1024; r += F.ngw) softmax_row<5, true>(SCs + (size_t)r * 1280, r & 1023, true, sink[(r >> 10) & 31], F.lane);
                ENDPH(P + 4);
            }
            if (IN(P + 5)) { PH_BEGIN;
                ub = 0;
                GemmP gp{(const bf16*)SCp, VT1, 512, KVR, 32L * 256 * 512, 4L * 256 * 512, 256L * 512, 256, 64L * KVR, 0, 256, 64, 256, 16, 8, 4};
                sg_gemm(F.lds, gp, EpiBf16{Ob, D, 256L * D, 256, 64, 1.f}, F.bid, F.nblk, ub);
                GemmP gs{(const bf16*)SCs, VT1 + NPR, 2560, KVR, 32L * 1024 * 2560, 4L * 1024 * 2560, 1024L * 2560, 1280, 64L * KVR, 0, 1024, 64, 1280, 2, 8, 4};
                sg_gemm(F.lds, gs, EpiBf16{Ob + (size_t)NPR * D, D, 1024L * D, 256, 64, 1.f}, F.bid, F.nblk, ub);
                ENDPH(P + 5);
            }
        } else if constexpr (L == 2) {
#define YTp ((bf16*)SCR)
#define YTs ((bf16*)(SCR + 32 * MiB))
            if (IN(P + 0)) { PH_BEGIN;
                ub = 0; GemmP g{(const bf16*)(ws + WS_CS512), Ub, 512, D, 0, 0, 0, 512, 0, 0, 1024, MT, 512, 4, 1, 1};
                sg_gemm(F.lds, g, EpiDft1{YTp, YTs}, F.bid, F.nblk, ub);
                ENDPH(P + 0);
            }
            if (IN(P + 5)) { PH_BEGIN;
                ub = 0;
                GemmP gp{(const bf16*)(ws + WS_CT256), YTp, 512, 512, 0, 0, 0, 2048L * 512, 0, 0, 256, 2048, 512, 16, 1, 1};
                sg_gemm(F.lds, gp, EpiBf16{Ob, D, 256L * D, 0, 0, 0.0027621358640099515f}, F.bid, F.nblk, ub);
                GemmP gs{(const bf16*)(ws + WS_CT1024), YTs, 2048, 2048, 0, 0, 0, 2048L * 2048, 0, 0, 1024, 2048, 2048, 2, 1, 1};
                sg_gemm(F.lds, gs, EpiBf16{Ob + (size_t)NPR * D, D, 1024L * D, 0, 0, 0.0013810679320049757f}, F.bid, F.nblk, ub);
                ENDPH(P + 5);
            }
        } else {
#define BCH ((bf16*)SCR)
            if (IN(P + 0)) { PH_BEGIN;
                ub = 0; GemmP g{Ub, (const bf16*)(ws + WS_WINT), D, D, 0, 0, 0, 0, 0, 0, MT, 6144, D, 1, 1, 1};
                sg_gemm(F.lds, g, EpiBf16{BCH, 6144, 0, 0, 0, 1.f}, F.bid, F.nblk, ub);
                ENDPH(P + 0);
            }
            if (IN(P + 5)) { PH_BEGIN;
                const float* cw = IP(I_CONVW); const float* cb = IP(I_CONVB);
                for (int m = F.gw; m < MT; m += F.ngw) {
                    const int t = (m < NPR) ? (m & 255) : ((m - NPR) & 1023); const int T = (m < NPR) ? 256 : 1024;
                    const bool hasp = t > 0, hasn = t < T - 1;
#pragma unroll
                    for (int i = 0; i < 4; ++i) { const int c = i * 512 + F.lane * 8; const bf16* r0 = BCH + (size_t)m * 6144 + c;
                        const u32x4 bb = *(const u32x4*)r0, cc = *(const u32x4*)(r0 + 2048), hh = *(const u32x4*)(r0 + 4096);
                        u32x4 cp = {0u, 0u, 0u, 0u}, hp = cp, cn = cp, hn = cp;
                        if (hasp) { cp = *(const u32x4*)(r0 - 6144 + 2048); hp = *(const u32x4*)(r0 - 6144 + 4096); }
                        if (hasn) { cn = *(const u32x4*)(r0 + 6144 + 2048); hn = *(const u32x4*)(r0 + 6144 + 4096); }
                        unsigned o[4];
#pragma unroll
                        for (int q = 0; q < 4; ++q) { const int d = c + 2 * q;
                            const float z0l = bflo(cp[q]) * bflo(hp[q]), z0h = bfhi(cp[q]) * bfhi(hp[q]);
                            const float z1l = bflo(cc[q]) * bflo(hh[q]), z1h = bfhi(cc[q]) * bfhi(hh[q]);
                            const float z2l = bflo(cn[q]) * bflo(hn[q]), z2h = bfhi(cn[q]) * bfhi(hn[q]);
                            const float yl = bflo(bb[q]) * (cw[d] * z0l + cw[D + d] * z1l + cw[2 * D + d] * z2l + cb[d]);
                            const float yh = bfhi(bb[q]) * (cw[d + 1] * z0h + cw[D + d + 1] * z1h + cw[2 * D + d + 1] * z2h + cb[d + 1]);
                            o[q] = pk2(yl, yh); }
                        *(u32x4*)(Ob + (size_t)m * D + c) = (u32x4){o[0], o[1], o[2], o[3]}; }
                }
                ENDPH(P + 5);
            }
        }
        if (IN(P + 6)) { PH_BEGIN;
            const size_t wofs = (L == 0) ? WS_WOT0 : (L == 1) ? WS_WOT1 : (L == 2) ? WS_WFT : WS_WCOT;
            ub = 0; GemmP g{Ob, (const bf16*)(ws + wofs), D, D, 0, 0, 0, 0, 0, 0, MT, D, D, 1, 1, 1};
            sg_gemm(F.lds, g, EpiResid{Y, X, modL + 2 * D}, F.bid, F.nblk, ub);
            ENDPH(P + 6);
        }
        if (IN(P + 7)) { PH_BEGIN;
            const float* g1 = IP(I_LN1G) + L * D; const float* b1 = IP(I_LN1B) + L * D;
            for (int m = F.gw; m < MT; m += F.ngw) { const float* md = modL + cond_of(m) * 12288;
                ln_row(Y + (size_t)m * D, g1, b1, X + (size_t)m * D, Ub + (size_t)m * D, md + 3 * D, md + 4 * D, nullptr, F.lane); }
            ENDPH(P + 7);
        }
#define PQ ((bf16*)SCR)
#define PS ((float*)(SCR + 24 * MiB))
#define PU ((bf16*)(ws + WS_PU))
#define PVb ((bf16*)(ws + WS_PV))
        if (IN(P + 8)) { PH_BEGIN;
            ub = 0; GemmP g{Ub, (const bf16*)(ws + WS_WPQT) + (size_t)L * D * D, D, D, 0, 0, 0, 0, 0, 0, MT, D, D, 1, 1, 1};
            sg_gemm(F.lds, g, EpiBf16{PQ, D, 0, 0, 0, 1.f}, F.bid, F.nblk, ub);
            const float* pu = IP(I_PEERU) + (size_t)L * 16384 * D; const float* pv = IP(I_PEERV) + (size_t)L * 16384 * D;
            const size_t gt = (size_t)F.bid * NTHR + F.tid, ngt = (size_t)F.nblk * NTHR;
            for (size_t i = gt; i < (size_t)16384 * D / 8; i += ngt) {
                const f32x4 a = *(const f32x4*)(pu + i * 8), b = *(const f32x4*)(pu + i * 8 + 4), c = *(const f32x4*)(pv + i * 8), d = *(const f32x4*)(pv + i * 8 + 4);
                *(u32x4*)(PU + i * 8) = (u32x4){pk2(a[0], a[1]), pk2(a[2], a[3]), pk2(b[0], b[1]), pk2(b[2], b[3])};
                *(u32x4*)(PVb + i * 8) = (u32x4){pk2(c[0], c[1]), pk2(c[2], c[3]), pk2(d[0], d[1]), pk2(d[2], d[3])}; }
            ENDPH(P + 8);
        }
        if (IN(P + 9)) { PH_BEGIN;
            ub = 0; GemmP g{PQ, (const bf16*)(ws + WS_SK) + (size_t)L * 16 * 128 * 128, D, 128, 128, 0, 0, 128L * 128, 0, 0, MT, 128, 128, 16, 1, 1};
            sg_gemm(F.lds, g, EpiF32{PS, D, 128, 0, 0, 1.f}, F.bid, F.nblk, ub);
            ENDPH(P + 9);
        }
        if (IN(P + 10)) { PH_BEGIN;
            LAS float* wl = (LAS float*)(F.lds + F.wave * 12288); LAS float* psl = wl + 1024;
            LAS float* sv = wl; LAS int* si = (LAS int*)(wl + 256); LAS float* ts = wl + 512; LAS int* te = (LAS int*)(wl + 640); LAS float* tg = wl + 768; LAS float* cl = wl + 896;
            const float* g2 = IP(I_LN2G) + L * D; const float* b2 = IP(I_LN2B) + L * D;
            int ca, cbb;
            { const int l = F.lane; int a = 0, base = 0;
              if (l >= 16) { a = 1; base = 16; } if (l >= 24) { a = 2; base = 24; } if (l >= 29) { a = 3; base = 29; } if (l >= 33) { a = 4; base = 33; }
              if (l >= 36) { a = 5; base = 36; } if (l >= 38) { a = 6; base = 38; } if (l >= 40) { a = 7; base = 40; } if (l >= 42) { a = 8 + (l - 42); base = l; }
              ca = a; cbb = l - base; }
            const bool cvalid = F.lane < 50;
            for (int m = F.gw; m < MT; m += F.ngw) {
                const float* ps = PS + (size_t)m * D;
#pragma unroll
                for (int i = 0; i < 8; ++i) *(LAS f32x4*)(psl + i * 256 + F.lane * 4) = *(const f32x4*)(ps + i * 256 + F.lane * 4);
                LDS_WAIT();
                for (int q = 0; q < 16; ++q) {
                    const LAS float* pl = psl + q * 128;
                    const float sa = pl[F.lane], sb = pl[64 + F.lane];
                    int ra = 0, rb = 0;
#pragma unroll 4
                    for (int j4 = 0; j4 < 16; ++j4) {
                        const f32x4 va4 = *(const LAS f32x4*)(pl + j4 * 4), vb4 = *(const LAS f32x4*)(pl + 64 + j4 * 4);
#pragma unroll
                        for (int e = 0; e < 4; ++e) { const int j = j4 * 4 + e; const float va = va4[e], vb = vb4[e];
                            ra += (va > sa || (va == sa && j < F.lane)) ? 1 : 0; ra += (vb > sa) ? 1 : 0;
                            rb += (va >= sb) ? 1 : 0; rb += (vb > sb || (vb == sb && j < F.lane)) ? 1 : 0; } }
                    if (ra < 16) { sv[q * 16 + ra] = sa; si[q * 16 + ra] = F.lane; }
                    if (rb < 16) { sv[q * 16 + rb] = sb; si[q * 16 + rb] = 64 + F.lane; }
                }
                LDS_WAIT();
                for (int h = 0; h < 8; ++h) {
                    float cv = -3.0e38f; int cf = 9999, ce = 0;
                    if (cvalid) { cv = sv[(2 * h) * 16 + ca] + sv[(2 * h + 1) * 16 + cbb]; cf = ca * 16 + cbb; ce = si[(2 * h) * 16 + ca] * 128 + si[(2 * h + 1) * 16 + cbb]; }
                    cl[F.lane] = cv; LDS_WAIT();
                    int rk = 0;
#pragma unroll 4
                    for (int j4 = 0; j4 < 13; ++j4) { const f32x4 v4 = *(const LAS f32x4*)(cl + j4 * 4);
#pragma unroll
                        for (int e = 0; e < 4; ++e) { const int j = j4 * 4 + e; const float vj = v4[e]; const int fj = cflat(j);
                            rk += (vj > cv || (vj == cv && fj < cf)) ? 1 : 0; } }
                    if (cvalid && rk < 16) { ts[h * 16 + rk] = cv; te[h * 16 + rk] = ce; }
                }
                LDS_WAIT();
#pragma unroll
                for (int q = 0; q < 2; ++q) { const int e = q * 64 + F.lane; const float s = ts[e]; float mx = s;
#pragma unroll
                    for (int o = 1; o < 16; o <<= 1) mx = fmaxf(mx, __shfl_xor(mx, o));
                    const float p = __expf(s - mx); float sm = p;
#pragma unroll
                    for (int o = 1; o < 16; o <<= 1) sm += __shfl_xor(sm, o);
                    tg[e] = p / sm; }
                LDS_WAIT();
                u32x4 xr[4];
#pragma unroll
                for (int j = 0; j < 4; ++j) xr[j] = *(const u32x4*)(Ub + (size_t)m * D + j * 512 + F.lane * 8);
                float fa[4][8];
#pragma unroll
                for (int j = 0; j < 4; ++j)
#pragma unroll
                    for (int e = 0; e < 8; ++e) fa[j][e] = 0.f;
                for (int eg = 0; eg < 128; eg += 2) {
                    u32x4 ur[2][4], vr[2][4]; float gte[2];
#pragma unroll
                    for (int q = 0; q < 2; ++q) { const int ex = __builtin_amdgcn_readfirstlane(te[eg + q]); gte[q] = tg[eg + q];
                        const bf16* up = PU + (size_t)ex * D + F.lane * 8; const bf16* vp = PVb + (size_t)ex * D + F.lane * 8;
#pragma unroll
                        for (int j = 0; j < 4; ++j) { ur[q][j] = *(const u32x4*)(up + j * 512); vr[q][j] = *(const u32x4*)(vp + j * 512); } }
#pragma unroll
                    for (int q = 0; q < 2; ++q) {
                        float hh = 0.f;
#pragma unroll
                        for (int j = 0; j < 4; ++j)
#pragma unroll
                            for (int w = 0; w < 4; ++w) hh = dot2bf(ur[q][j][w], xr[j][w], hh);
                        hh = wave_sum(hh);
                        const float a = 0.5f * hh * (1.0f + erff(hh * 0.70710678118654752f)) * gte[q];
#pragma unroll
                        for (int j = 0; j < 4; ++j)
#pragma unroll
                            for (int w = 0; w < 4; ++w) { fa[j][2 * w] += a * bflo(vr[q][j][w]); fa[j][2 * w + 1] += a * bfhi(vr[q][j][w]); }
                    }
                }
                const float* md = modL + cond_of(m) * 12288; float* xrow = X + (size_t)m * D;
                float s = 0.f;
#pragma unroll
                for (int j = 0; j < 4; ++j) { const int c = j * 512 + F.lane * 8;
                    const f32x4 x0 = *(const f32x4*)(xrow + c), x1 = *(const f32x4*)(xrow + c + 4), g0 = *(const f32x4*)(md + 5 * D + c), g1 = *(const f32x4*)(md + 5 * D + c + 4);
#pragma unroll
                    for (int e = 0; e < 4; ++e) { fa[j][e] = ALPHA * x0[e] + g0[e] * fa[j][e]; fa[j][4 + e] = ALPHA * x1[e] + g1[e] * fa[j][4 + e]; s += fa[j][e] + fa[j][4 + e]; } }
                const float mean = wave_sum(s) * (1.f / D); float s2 = 0.f;
#pragma unroll
                for (int j = 0; j < 4; ++j)
#pragma unroll
                    for (int e = 0; e < 8; ++e) { fa[j][e] -= mean; s2 += fa[j][e] * fa[j][e]; }
                const float rstd = rsqrtf(wave_sum(s2) * (1.f / D) + LN_EPS);
                const float* mdn = MODS + ((L < 3 ? L + 1 : L) * 3 + cond_of(m)) * 12288;
#pragma unroll
                for (int j = 0; j < 4; ++j) { const int c = j * 512 + F.lane * 8; float o[8];
#pragma unroll
                    for (int e = 0; e < 8; ++e) o[e] = fa[j][e] * rstd * g2[c + e] + b2[c + e];
                    *(f32x4*)(xrow + c) = (f32x4){o[0], o[1], o[2], o[3]}; *(f32x4*)(xrow + c + 4) = (f32x4){o[4], o[5], o[6], o[7]};
                    if (L == 3) { float* orow = args.out + OUT_Y + (size_t)m * D + c; *(f32x4*)orow = (f32x4){o[0], o[1], o[2], o[3]}; *(f32x4*)(orow + 4) = (f32x4){o[4], o[5], o[6], o[7]}; }
                    else { float u[8];
#pragma unroll
                        for (int e = 0; e < 8; ++e) u[e] = o[e] * (1.0f + mdn[D + c + e]) + mdn[c + e];
                        *(u32x4*)(Ub + (size_t)m * D + c) = (u32x4){pk2(u[0], u[1]), pk2(u[2], u[3]), pk2(u[4], u[5]), pk2(u[6], u[7])}; } }
            }
            ENDPH(P + 10);
        }
}

__global__ void __launch_bounds__(NTHR, 2) fwd(Args args) {
    extern __shared__ __attribute__((aligned(16))) unsigned char lds_raw[];
    Frame F;
    F.lds = (LAS unsigned char*)lds_raw; F.ws = args.ws;
    F.tid = threadIdx.x; F.lane = F.tid & 63; F.wave = __builtin_amdgcn_readfirstlane(F.tid >> 6);
    F.bid = blockIdx.x; F.nblk = gridDim.x; F.gw = F.bid * NWAVE + F.wave; F.ngw = F.nblk * NWAVE;
    unsigned char* const ws_ = args.ws;
    const int lo = args.ph_lo, hi = args.ph_hi;
    volatile LAS unsigned* MISC = (volatile LAS unsigned*)(F.lds + LDS_MISC);
    if (F.tid < 16) MISC[F.tid] = 0u;
    __syncthreads();
    XcdBarrier bar; bar.bar = (unsigned*)(ws_ + WS_CTL) + 4096; bar.x = 0; bar.st = MISC + 8;
#if !MK_PER_PHASE
    bar = xcd_barrier_post((unsigned*)(ws_ + WS_CTL) + 4096, MISC + 8);
#endif
    int ub;

    if (IN(0)) { PH_BEGIN;
        LAS float* sc = (LAS float*)F.lds;
        LAS float* part = (LAS float*)(F.lds + 24576);
        for (int i = F.tid; i < 3 * D; i += NTHR) { const int j = i >> 11, k = i & 2047; const float c = (j == 0) ? IP(I_CCTX)[k] : IP(I_C)[(j - 1) * D + k]; sc[i] = c / (1.f + __expf(-c)); }
        __syncthreads();
        const float* adaw = IP(I_ADAW); const float* adab = IP(I_ADAB);
        for (int u = F.bid; u < 768; u += F.nblk) {
            const int layer = u / 192, n0 = (u % 192) * 64, kr = F.lane >> 4, cq = F.lane & 15;
            f32x4 a0 = {0.f, 0.f, 0.f, 0.f}, a1 = a0, a2 = a0;
            const float* wp = adaw + ((size_t)layer * D + F.wave * 256 + kr) * 12288 + n0 + cq * 4;
#pragma unroll 8
            for (int it = 0; it < 64; ++it) { const f32x4 w = *(const f32x4*)(wp + (size_t)it * 4 * 12288); const int k = F.wave * 256 + it * 4 + kr;
                a0 += w * sc[k]; a1 += w * sc[D + k]; a2 += w * sc[2 * D + k]; }
#pragma unroll
            for (int e = 0; e < 4; ++e) { a0[e] += __shfl_xor(a0[e], 16); a0[e] += __shfl_xor(a0[e], 32); a1[e] += __shfl_xor(a1[e], 16); a1[e] += __shfl_xor(a1[e], 32); a2[e] += __shfl_xor(a2[e], 16); a2[e] += __shfl_xor(a2[e], 32); }
            if (F.lane < 16) {
#pragma unroll
                for (int e = 0; e < 4; ++e) { part[(F.wave * 3 + 0) * 64 + cq * 4 + e] = a0[e]; part[(F.wave * 3 + 1) * 64 + cq * 4 + e] = a1[e]; part[(F.wave * 3 + 2) * 64 + cq * 4 + e] = a2[e]; } }
            __syncthreads();
            if (F.tid < 192) { const int j = F.tid >> 6, c = F.tid & 63; float s = adab[layer * 12288 + n0 + c];
#pragma unroll
                for (int w = 0; w < 8; ++w) s += part[(w * 3 + j) * 64 + c];
                MODS[(layer * 3 + j) * 12288 + n0 + c] = s; }
            __syncthreads();
        }
        {
            LAS float* scr = (LAS float*)(F.lds + F.wave * 8448);
            for (int it = F.gw; it < args.tj_total; it += F.ngw) {
                int j = 0;
#pragma unroll
                for (int q = 1; q < NTJOB; ++q) j = (it >= args.tj[q].first) ? q : j;
                const TJob& J = args.tj[j];
                transpose_item(J.W, J.K, J.N, (bf16*)(ws + J.dst), J.row_off, scr, it - J.first, F.lane);
            }
        }
        const int gt = F.bid * NTHR + F.tid, ngt = F.nblk * NTHR;
        { const float* sk = IP(I_SUBK); bf16* SK = (bf16*)(ws + WS_SK);
          for (int i = gt; i < 4 * 16 * 128 * 128 / 4; i += ngt) { const f32x4 v = *(const f32x4*)(sk + (size_t)i * 4); *(u32x2*)(SK + (size_t)i * 4) = (u32x2){pk2(v[0], v[1]), pk2(v[2], v[3])}; } }
        { bf16* CS = (bf16*)(ws + WS_CS512);
          for (int i = gt; i < 1024 * 512; i += ngt) { const int j = i >> 9, c = i & 511, r = ((j & 511) * c) & 511; const float x = (float)r * (1.f / 256.f); CS[i] = (bf16)f2bf(j < 512 ? cospif(x) : sinpif(x)); } }
        { bf16* CT = (bf16*)(ws + WS_CT256);
          for (int i = gt; i < 256 * 512; i += ngt) { const int t = i >> 9, k = i & 511, r = (t * (k & 255)) & 255; const float x = (float)r * (1.f / 128.f); CT[i] = (bf16)f2bf(k < 256 ? cospif(x) : -sinpif(x)); } }
        { bf16* CT = (bf16*)(ws + WS_CT1024);
          for (int i = gt; i < 1024 * 2048; i += ngt) { const int t = i >> 11, k = i & 2047, r = (t * (k & 1023)) & 1023; const float x = (float)r * (1.f / 512.f); CT[i] = (bf16)f2bf(k < 1024 ? cospif(x) : -sinpif(x)); } }
        { const float* c0 = IP(I_C0CKV); bf16* ckvp = (bf16*)(ws + WS_CKV);
          for (int i = gt; i < 2 * 256 * 512; i += ngt) { const int b = i >> 17, r = i & 131071; ckvp[(size_t)(NPR + b * 1280 + 1024) * 512 + r] = (bf16)f2bf(c0[i]); } }
        { const float* c0 = IP(I_C0KR); bf16* kcp = (bf16*)(ws + WS_KC);
          for (int i = gt; i < 2 * 256 * 64 * 16; i += ngt) { const int h = i & 15, e = i >> 4, j = e & 63, s = (e >> 6) & 255, b = e >> 14;
              kcp[((size_t)(NPR + b * 1280 + 1024 + s) * 16 + h) * 192 + 128 + j] = (bf16)f2bf(c0[e]); } }
        ENDPH(0);
    }
    if (IN(1)) { PH_BEGIN;
        for (int m = F.gw; m < MT; m += F.ngw) {
            const float* xr = (m < NPR) ? IP(I_XP) + (size_t)m * D : IP(I_XS) + (size_t)(m - NPR) * D;
            const float* md = MODS + cond_of(m) * 12288;
#pragma unroll
            for (int i = 0; i < 8; ++i) { const int c = i * 256 + F.lane * 4; const f32x4 v = *(const f32x4*)(xr + c);
                *(f32x4*)(X + (size_t)m * D + c) = v;
                const f32x4 u = v * (*(const f32x4*)(md + D + c) + 1.0f) + *(const f32x4*)(md + c);
                *(u32x2*)(Ub + (size_t)m * D + c) = (u32x2){pk2(u[0], u[1]), pk2(u[2], u[3])}; }
        }
        ENDPH(1);
    }

    layer_phases<0>(args, F, ws_, lo, hi, bar);
    layer_phases<1>(args, F, ws_, lo, hi, bar);
    layer_phases<2>(args, F, ws_, lo, hi, bar);
    layer_phases<3>(args, F, ws_, lo, hi, bar);
}

static const int kPhases[] = {0, 1,
    2, 3, 4, 5, 6, 7, 8, 9, 10, 11, 12,
    18, 21, 22, 23, 24, 25, 26, 27, 28,
    34, 39, 40, 41, 42, 43, 44,
    50, 55, 56, 57, 58, 59, 60};

extern "C" void kernel_launch(void* const* d_in, const int* in_sizes, int n_in, void* d_out, int out_size, void* d_ws, size_t ws_size, hipStream_t stream) {
    static int grid = 0;
    if (grid == 0) {
        if (n_in != 34 || ws_size < WS_END) { fprintf(stderr, "kernel_launch: unexpected n_in %d / ws_size %zu\n", n_in, ws_size); grid = -1; return; }
        int dev = 0, cus = 0;
        if (hipGetDevice(&dev) != hipSuccess || hipDeviceGetAttribute(&cus, hipDeviceAttributeMultiprocessorCount, dev) != hipSuccess) { grid = -1; return; }
        if (hipFuncSetAttribute((const void*)fwd, hipFuncAttributeMaxDynamicSharedMemorySize, LDS_BYTES) != hipSuccess) { fprintf(stderr, "kernel_launch: hipFuncSetAttribute failed\n"); grid = -1; return; }
        int per_cu = 0;
        if (hipOccupancyMaxActiveBlocksPerMultiprocessor(&per_cu, (const void*)fwd, NTHR, LDS_BYTES) != hipSuccess || per_cu < 1) fprintf(stderr, "kernel_launch: occupancy query says %d\n", per_cu);
        (void)hipGetLastError();
        grid = cus;
    }
    if (grid < 0) return;
    (void)hipMemsetAsync((char*)d_ws + WS_CTL, 0, CTL_BYTES, stream);
    Args a{};
    for (int i = 0; i < 34; ++i) a.in[i] = (const float*)d_in[i];
    a.out = (float*)d_out; a.ws = (unsigned char*)d_ws;
    {
        struct J { int idx; size_t sub; size_t dst; int K, N, row_off; };
        const J js[NTJOB] = {
            {I_WDQ, 0, WS_W0T, 2048, 512, 0}, {I_WDKV, 0, WS_W0T, 2048, 576, 512}, {I_WUQ, 0, WS_WUQT, 512, 3072, 0}, {I_WUK, 0, WS_WUKT, 512, 2048, 0},
            {I_WUV, 0, WS_WUVT, 512, 2048, 0}, {I_WO0, 0, WS_WOT0, 2048, 2048, 0}, {I_WQKV, 0, WS_WQKVT, 2048, 3072, 0}, {I_WO1, 0, WS_WOT1, 2048, 2048, 0},
            {I_WF, 0, WS_WFT, 2048, 2048, 0}, {I_WIN, 0, WS_WINT, 2048, 6144, 0}, {I_WCO, 0, WS_WCOT, 2048, 2048, 0},
            {I_WPQ, 0, WS_WPQT, 2048, 2048, 0}, {I_WPQ, (size_t)1 * 2048 * 2048, WS_WPQT + (size_t)1 * 2048 * 2048 * 2, 2048, 2048, 0},
            {I_WPQ, (size_t)2 * 2048 * 2048, WS_WPQT + (size_t)2 * 2048 * 2048 * 2, 2048, 2048, 0}, {I_WPQ, (size_t)3 * 2048 * 2048, WS_WPQT + (size_t)3 * 2048 * 2048 * 2, 2048, 2048, 0}};
        int first = 0;
        for (int j = 0; j < NTJOB; ++j) { a.tj[j].W = (const float*)d_in[js[j].idx] + js[j].sub; a.tj[j].dst = js[j].dst; a.tj[j].K = js[j].K; a.tj[j].N = js[j].N; a.tj[j].row_off = js[j].row_off; a.tj[j].first = first;
            first += (js[j].K / 64) * (js[j].N / 32); }
        a.tj_total = first;
    }
#if MK_PER_PHASE
    for (size_t i = 0; i < sizeof(kPhases) / sizeof(kPhases[0]); ++i) {
        a.ph_lo = kPhases[i]; a.ph_hi = kPhases[i] + 1;
        hipLaunchKernelGGL(fwd, dim3(grid), dim3(NTHR), LDS_BYTES, stream, a);
    }
#else
    a.ph_lo = 0; a.ph_hi = 1 << 20;
    hipLaunchKernelGGL(fwd, dim3(grid), dim3(NTHR), LDS_BYTES, stream, a);
#endif
    const hipError_t le = hipPeekAtLastError();
    if (le != hipSuccess) fprintf(stderr, "kernel_launch: launch failed: %s\n", hipGetErrorName(le));
}
```

```cpp
#include <hip/hip_runtime.h>
#include <cstdio>
#include <cstdint>

#ifndef MK_PER_PHASE
#define MK_PER_PHASE 0
#endif

#define LAS __attribute__((address_space(3)))
typedef unsigned short bf16;
typedef short bf16x8 __attribute__((ext_vector_type(8)));
typedef float f32x4 __attribute__((ext_vector_type(4)));
typedef unsigned u32x4 __attribute__((ext_vector_type(4)));
typedef unsigned u32x2 __attribute__((ext_vector_type(2)));
typedef __bf16 bf16x2_t __attribute__((ext_vector_type(2)));
typedef float f32x2 __attribute__((ext_vector_type(2)));
#define GAS __attribute__((address_space(1)))
__device__ __forceinline__ unsigned pack_fp8x4(f32x4 a) { int w = __builtin_amdgcn_cvt_pk_fp8_f32(a[0], a[1], 0, false); w = __builtin_amdgcn_cvt_pk_fp8_f32(a[2], a[3], w, true); return (unsigned)w; }

constexpr int D = 2048, NPR = 4096, MT = 6144, KVR = 6656;
constexpr int NTHR = 512, NWAVE = 8;
constexpr float ALPHA = 1.6817928305074290f;
constexpr float MLA_SCALE = 0.07216878364870322f;
constexpr float GQA_SCALE = 0.125f;
constexpr float LN_EPS = 1e-5f, RMS_EPS = 1e-6f;

constexpr size_t MiB = 1u << 20;
constexpr size_t WS_CTL = 0, CTL_BYTES = 1 * MiB;
constexpr size_t WS_MODS = 1 * MiB;
constexpr size_t WS_W0T = 2 * MiB, WS_WUQT = 7 * MiB, WS_WUKT = 10 * MiB, WS_WUVT = 12 * MiB, WS_WOT0 = 14 * MiB, WS_WQKVT = 22 * MiB,
                 WS_WOT1 = 34 * MiB, WS_WFT = 42 * MiB, WS_WINT = 50 * MiB, WS_WCOT = 74 * MiB, WS_WPQT = 82 * MiB, WS_SK = 114 * MiB,
                 WS_CS512 = 116 * MiB, WS_CT256 = 117 * MiB, WS_CT1024 = 118 * MiB, WS_PU = 122 * MiB, WS_PV = 186 * MiB,
                 WS_X = 250 * MiB, WS_Y = 298 * MiB, WS_U = 346 * MiB, WS_O = 370 * MiB, WS_Q = 394 * MiB, WS_KC = 430 * MiB,
                 WS_VT = 469 * MiB, WS_QN = 495 * MiB, WS_CKV = 501 * MiB, WS_SCR = 508 * MiB, WS_END = 956 * MiB;
constexpr size_t OUT_Y = 0, OUT_CKV = 12582912, OUT_KR = 14680064, OUT_K1 = 14942208, OUT_V1 = 17039360;

constexpr int LDS_BYTES = 147456;
constexpr int LDS_MISC = 140 * 1024;

#define LDS_WAIT() asm volatile("s_waitcnt lgkmcnt(0)" ::: "memory")
__device__ __forceinline__ unsigned f2bf(float f) { unsigned u = __float_as_uint(f); return (u + 0x7fffu + ((u >> 16) & 1u)) >> 16; }
__device__ __forceinline__ unsigned pk2(float lo, float hi) { unsigned r; asm("v_cvt_pk_bf16_f32 %0, %1, %2" : "=v"(r) : "v"(lo), "v"(hi)); return r; }
__device__ __forceinline__ float bflo(unsigned w) { return __uint_as_float(w << 16); }
__device__ __forceinline__ float bfhi(unsigned w) { return __uint_as_float(w & 0xffff0000u); }
__device__ __forceinline__ float wave_sum(float v) {
#pragma unroll
    for (int o = 1; o < 64; o <<= 1) v += __shfl_xor(v, o);
    return v;
}
__device__ __forceinline__ float wave_max(float v) {
#pragma unroll
    for (int o = 1; o < 64; o <<= 1) v = fmaxf(v, __shfl_xor(v, o));
    return v;
}
__device__ __forceinline__ float dot2bf(unsigned w, unsigned x, float acc) {
    return __builtin_amdgcn_fdot2_f32_bf16(__builtin_bit_cast(bf16x2_t, w), __builtin_bit_cast(bf16x2_t, x), acc, false);
}
__device__ __forceinline__ int cond_of(int m) { return m < NPR ? 0 : 1 + ((m - NPR) >> 10); }
__device__ __forceinline__ int kvrow_of(int m) { return m < NPR ? m : NPR + ((m - NPR) >> 10) * 1280 + ((m - NPR) & 1023); }

#define XB_TMO      128
#define XB_XCNT(j)  (256  + 64 * (j))
#define XB_XSUB(j)  (1280 + 64 * (j))
#define XB_XGEN(j)  (2304 + 64 * (j))
#define XB_TOP      3328
#define XB_TOPGEN   3392
#define XCD_BAR_WORDS 3456
#define XB_SPIN_CAP (1u << 22)
__device__ __forceinline__ unsigned xb_ld(unsigned* p)              { return __hip_atomic_load(p, __ATOMIC_RELAXED, __HIP_MEMORY_SCOPE_AGENT); }
__device__ __forceinline__ unsigned xb_add(unsigned* p, unsigned v) { return __hip_atomic_fetch_add(p, v, __ATOMIC_RELAXED, __HIP_MEMORY_SCOPE_AGENT); }
__device__ __forceinline__ unsigned xb_xcc_id() { return (unsigned)__builtin_amdgcn_s_getreg((3 << 11) | 20) & 0xFu; }
#define XB_SPIN(cond, bar) do { unsigned _sp = 0; while (cond) { __builtin_amdgcn_s_sleep(1); \
    if ((++_sp & 255u) == 0u) { if (xb_ld(&(bar)[XB_TMO])) break; if (_sp > XB_SPIN_CAP) { atomicAdd(&(bar)[XB_TMO], 1u); break; } } } } while (0)
struct XcdBarrier { unsigned* bar; unsigned x; volatile LAS unsigned* st; };
__device__ __forceinline__ XcdBarrier xcd_barrier_post(unsigned* bar, volatile LAS unsigned* st) {
    XcdBarrier b; b.bar = bar; b.x = xb_xcc_id(); b.st = st;
    if (threadIdx.x == 0) (void)xb_add(&bar[XB_XCNT(b.x)], 1u);
    return b;
}
__device__ __forceinline__ void xcd_barrier_complete(unsigned* bar, unsigned x, unsigned& nloc, unsigned& nx) {
    const unsigned G = gridDim.x * gridDim.y * gridDim.z;
    unsigned sum, cnt, mine, sp = 0u;
    for (;;) {
        sum = 0u; cnt = 0u; mine = 0u;
#pragma unroll
        for (unsigned j = 0; j < 16; ++j) { const unsigned c = xb_ld(&bar[XB_XCNT(j)]); sum += c; cnt += (c > 0u) ? 1u : 0u; mine = (j == x) ? c : mine; }
        if (sum == G) break;
        __builtin_amdgcn_s_sleep(1);
        if ((++sp & 255u) == 0u) { if (xb_ld(&bar[XB_TMO])) break; if (sp > XB_SPIN_CAP) { atomicAdd(&bar[XB_TMO], 1u); break; } }
    }
    nloc = mine > 0u ? mine : 1u; nx = cnt > 0u ? cnt : 1u;
}
__device__ __forceinline__ void xcd_barrier(const XcdBarrier& b) {
    asm volatile("s_waitcnt vmcnt(0)" ::: "memory");
    __syncthreads();
    if (threadIdx.x == 0) {
        unsigned* bar = b.bar;
        __builtin_amdgcn_s_waitcnt(0);
        unsigned nloc = b.st[0], nx = b.st[1];
        if (nloc == 0u) { xcd_barrier_complete(bar, b.x, nloc, nx); b.st[0] = nloc; b.st[1] = nx; }
        const unsigned old = xb_add(&bar[XB_XSUB(b.x)], 1u);
        const unsigned gen = old / nloc;
        if (old + 1u == (gen + 1u) * nloc) {
            __builtin_amdgcn_fence(__ATOMIC_RELEASE, "agent");
            asm volatile("s_waitcnt vmcnt(0)" ::: "memory");
            const unsigned og = xb_add(&bar[XB_TOP], 1u);
            const unsigned tg = og / nx;
            if (og + 1u == (tg + 1u) * nx) xb_add(&bar[XB_TOPGEN], 1u);
            else XB_SPIN(xb_ld(&bar[XB_TOPGEN]) == tg, bar);
            __builtin_amdgcn_fence(__ATOMIC_ACQUIRE, "agent");
            xb_add(&bar[XB_XGEN(b.x)], 1u);
            asm volatile("s_waitcnt vmcnt(0)" ::: "memory");
        } else {
            XB_SPIN(xb_ld(&bar[XB_XGEN(b.x)]) == gen, bar);
            __builtin_amdgcn_fence(__ATOMIC_ACQUIRE, "agent");
            asm volatile("s_waitcnt vmcnt(0)" ::: "memory");
        }
    }
    __syncthreads();
}

struct TJob { const float* W; unsigned long long dst; int K, N, row_off, first; };
constexpr int NTJOB = 15;
struct Args {
    const float* in[34];
    float* out;
    unsigned char* ws;
    TJob tj[NTJOB];
    int tj_total;
    int ph_lo, ph_hi, pad;
};
enum { I_XP = 0, I_XS, I_C0CKV, I_C0KR, I_C1K, I_C1V, I_C, I_CCTX, I_ADAW, I_ADAB, I_LN1G, I_LN1B, I_LN2G, I_LN2B,
       I_WDQ, I_QNORM, I_WUQ, I_WDKV, I_KVNORM, I_WUK, I_WUV, I_WO0, I_WQKV, I_SINK, I_WO1, I_WF, I_WIN, I_CONVW, I_CONVB, I_WCO,
       I_WPQ, I_SUBK, I_PEERU, I_PEERV };

struct GemmP {
    const bf16* A; const bf16* B;
    long lda, ldb;
    long sA1, sA2, sA3, sB1, sB2, sB3;
    int M, N, K, nb1, nb2, nb3;
};
constexpr int SG_LDT = 72;
constexpr int SG_TILE = 128 * SG_LDT * 2;
template <class Epi>
__device__ __forceinline__ void sg_gemm(LAS unsigned char* lds, const GemmP g, const Epi& E, int bid, int nblk, int& ubase) {
    const int tid = threadIdx.x, lane = tid & 63, wave = __builtin_amdgcn_readfirstlane(tid >> 6);
    const int wm = wave >> 2, wn = wave & 3, fr = lane & 15, fq = lane >> 4;
    const int tiles_m = (g.M + 127) >> 7, tiles_n = (g.N + 127) >> 7;
    const int nbatch = g.nb1 * g.nb2 * g.nb3;
    const int U = nbatch * tiles_m * tiles_n;
    const int nk = g.K >> 6;
    int first = (bid - (ubase % nblk) + nblk) % nblk;
    ubase += U;
    const int lrow0 = tid >> 3, lkc = tid & 7;
    const int aoff = (wm * 64 + fr) * (SG_LDT * 2) + fq * 16;
    const int boff = (wn * 32 + fr) * (SG_LDT * 2) + fq * 16;
    for (int u = first; u < U; u += nblk) {
        const int tn = u % tiles_n; const int r1 = u / tiles_n; const int tm = r1 % tiles_m; const int b = r1 / tiles_m;
        const int b3 = b % g.nb3, b12 = b / g.nb3, b2 = b12 % g.nb2, b1 = b12 / g.nb2;
        const int m0 = tm << 7, n0 = tn << 7;
        const bf16* Ab = g.A + b1 * g.sA1 + b2 * g.sA2 + b3 * g.sA3;
        const bf16* Bb = g.B + b1 * g.sB1 + b2 * g.sB2 + b3 * g.sB3;
        int ar0 = m0 + lrow0, ar1 = ar0 + 64; ar0 = ar0 < g.M ? ar0 : g.M - 1; ar1 = ar1 < g.M ? ar1 : g.M - 1;
        int br0 = n0 + lrow0, br1 = br0 + 64; br0 = br0 < g.N ? br0 : g.N - 1; br1 = br1 < g.N ? br1 : g.N - 1;
        const bf16* pa0 = Ab + (long)ar0 * g.lda + lkc * 8; const bf16* pa1 = Ab + (long)ar1 * g.lda + lkc * 8;
        const bf16* pb0 = Bb + (long)br0 * g.ldb + lkc * 8; const bf16* pb1 = Bb + (long)br1 * g.ldb + lkc * 8;
        f32x4 acc[4][2];
#pragma unroll
        for (int i = 0; i < 4; ++i) { acc[i][0] = (f32x4){0.f, 0.f, 0.f, 0.f}; acc[i][1] = (f32x4){0.f, 0.f, 0.f, 0.f}; }
        u32x4 ra0 = *(const u32x4*)pa0, ra1 = *(const u32x4*)pa1, rb0 = *(const u32x4*)pb0, rb1 = *(const u32x4*)pb1;
        const int wofs = lrow0 * (SG_LDT * 2) + lkc * 16;
        *(LAS u32x4*)(lds + wofs) = ra0; *(LAS u32x4*)(lds + wofs + 64 * SG_LDT * 2) = ra1;
        *(LAS u32x4*)(lds + SG_TILE + wofs) = rb0; *(LAS u32x4*)(lds + SG_TILE + wofs + 64 * SG_LDT * 2) = rb1;
        __syncthreads();
        for (int kt = 0; kt < nk; ++kt) {
            const int cur = (kt & 1) * 2 * SG_TILE, nxt = ((kt + 1) & 1) * 2 * SG_TILE;
            const bool more = (kt + 1 < nk);
            if (more) { const int ko = (kt + 1) << 6; ra0 = *(const u32x4*)(pa0 + ko); ra1 = *(const u32x4*)(pa1 + ko); rb0 = *(const u32x4*)(pb0 + ko); rb1 = *(const u32x4*)(pb1 + ko); }
#pragma unroll
            for (int ks = 0; ks < 2; ++ks) {
                bf16x8 af[4], bfr[2];
#pragma unroll
                for (int i = 0; i < 4; ++i) af[i] = *(const LAS bf16x8*)(lds + cur + aoff + i * 16 * SG_LDT * 2 + ks * 64);
#pragma unroll
                for (int j = 0; j < 2; ++j) bfr[j] = *(const LAS bf16x8*)(lds + cur + SG_TILE + boff + j * 16 * SG_LDT * 2 + ks * 64);
#pragma unroll
                for (int i = 0; i < 4; ++i)
#pragma unroll
                    for (int j = 0; j < 2; ++j) acc[i][j] = __builtin_amdgcn_mfma_f32_16x16x32_bf16(bfr[j], af[i], acc[i][j], 0, 0, 0);
            }
            if (more) {
                *(LAS u32x4*)(lds + nxt + wofs) = ra0; *(LAS u32x4*)(lds + nxt + wofs + 64 * SG_LDT * 2) = ra1;
                *(LAS u32x4*)(lds + nxt + SG_TILE + wofs) = rb0; *(LAS u32x4*)(lds + nxt + SG_TILE + wofs + 64 * SG_LDT * 2) = rb1;
            }
            __syncthreads();
        }
        const int nn = n0 + wn * 32 + 4 * fq;
        if (n0 + wn * 32 < g.N) {
#pragma unroll
            for (int i = 0; i < 4; ++i) { const int m = m0 + wm * 64 + i * 16 + fr; if (m < g.M) E(b1, b2, b3, m, nn, acc[i][0], acc[i][1]); }
        }
    }
}

struct EpiF32 { float* C; long ldc, s1, s2, s3; float scale;
    __device__ __forceinline__ void operator()(int b1, int b2, int b3, int m, int n, f32x4 v0, f32x4 v1) const {
        float* p = C + b1 * s1 + b2 * s2 + b3 * s3 + (long)m * ldc + n; *(f32x4*)p = v0 * scale; *(f32x4*)(p + 16) = v1 * scale; } };
struct EpiBf16 { bf16* C; long ldc, s1, s2, s3; float scale;
    __device__ __forceinline__ void operator()(int b1, int b2, int b3, int m, int n, f32x4 v0, f32x4 v1) const {
        bf16* p = C + b1 * s1 + b2 * s2 + b3 * s3 + (long)m * ldc + n; v0 = v0 * scale; v1 = v1 * scale;
        *(u32x2*)p = (u32x2){pk2(v0[0], v0[1]), pk2(v0[2], v0[3])}; *(u32x2*)(p + 16) = (u32x2){pk2(v1[0], v1[1]), pk2(v1[2], v1[3])}; } };
__device__ __forceinline__ void rope4(f32x4& v0, f32x4& v1, int pos, int j0) {
#pragma unroll
    for (int i = 0; i < 4; ++i) {
        const float inv = exp2f(-(float)(j0 + i) * (13.287712379549449f / 16.0f));
        const float ang = (float)pos * inv; float sn, cs; sincosf(ang, &sn, &cs);
        const float x1 = v0[i], x2 = v1[i]; v0[i] = x1 * cs - x2 * sn; v1[i] = x1 * sn + x2 * cs; }
}
struct EpiQMla { bf16* Q;
    __device__ __forceinline__ void operator()(int, int, int, int m, int n, f32x4 v0, f32x4 v1) const {
        const int d = n % 192, d0 = d & ~31;
        if (m >= NPR && d0 >= 128) { const int t = (m - NPR) & 1023; const int pos = (d0 == 128) ? (t >> 6) : (t & 63); rope4(v0, v1, pos, d & 15); }
        bf16* p = Q + (long)m * 3072 + n;
        *(u32x2*)p = (u32x2){pk2(v0[0], v0[1]), pk2(v0[2], v0[3])}; *(u32x2*)(p + 16) = (u32x2){pk2(v1[0], v1[1]), pk2(v1[2], v1[3])}; } };
struct EpiKn { bf16* KC;
    __device__ __forceinline__ void operator()(int, int, int, int m, int n, f32x4 v0, f32x4 v1) const {
        bf16* p = KC + ((long)m * 16 + (n >> 7)) * 192 + (n & 127);
        *(u32x2*)p = (u32x2){pk2(v0[0], v0[1]), pk2(v0[2], v0[3])}; *(u32x2*)(p + 16) = (u32x2){pk2(v1[0], v1[1]), pk2(v1[2], v1[3])}; } };
struct EpiResid { float* Y; const float* X; const float* gate;
    __device__ __forceinline__ void operator()(int, int, int, int m, int n, f32x4 v0, f32x4 v1) const {
        const float* gp = gate + cond_of(m) * 12288 + n; const float* xp = X + (long)m * D + n; float* yp = Y + (long)m * D + n;
        const f32x4 g0 = *(const f32x4*)gp, g1 = *(const f32x4*)(gp + 16), x0 = *(const f32x4*)xp, x1 = *(const f32x4*)(xp + 16);
        *(f32x4*)yp = x0 * ALPHA + g0 * v0; *(f32x4*)(yp + 16) = x1 * ALPHA + g1 * v1; } };
struct EpiQkv1 { bf16* Q1; bf16* K1; bf16* VT1; float* outk; float* outv;
    __device__ __forceinline__ void operator()(int, int, int, int m, int n, f32x4 v0, f32x4 v1) const {
        const int kvr = kvrow_of(m);
        if (n < 2560) {
            if (n >= 2048 && m < NPR) { float* p = outk + (long)m * 512 + (n - 2048); *(f32x4*)p = v0; *(f32x4*)(p + 16) = v1; }
            if (m >= NPR) { const int t = (m - NPR) & 1023; const int pos = ((n & 32) == 0) ? (t >> 6) : (t & 63); rope4(v0, v1, pos, n & 15); }
            bf16* p = (n < 2048) ? (Q1 + (long)m * 2048 + n) : (K1 + (long)kvr * 512 + (n - 2048));
            *(u32x2*)p = (u32x2){pk2(v0[0], v0[1]), pk2(v0[2], v0[3])}; *(u32x2*)(p + 16) = (u32x2){pk2(v1[0], v1[1]), pk2(v1[2], v1[3])};
        } else {
            const int c = n - 2560;
            if (m < NPR) { float* p = outv + (long)m * 512 + c; *(f32x4*)p = v0; *(f32x4*)(p + 16) = v1; }
#pragma unroll
            for (int i = 0; i < 4; ++i) { VT1[(long)(c + i) * KVR + kvr] = (bf16)f2bf(v0[i]); VT1[(long)(c + 16 + i) * KVR + kvr] = (bf16)f2bf(v1[i]); }
        } } };
struct EpiDft1 { bf16* YTp; bf16* YTs;
    __device__ __forceinline__ void operator()(int g, int, int, int j, int tok, f32x4 v0, f32x4 v1) const {
        const int h = j >> 9, c = j & 511;
#pragma unroll
        for (int q = 0; q < 2; ++q) { const int tk = tok + 16 * q; const f32x4 v = q ? v1 : v0; bf16* p;
            if (tk < NPR) { const int b = tk >> 8, t = tk & 255; p = YTp + ((long)(b * 2048 + g * 512 + c) * 512 + h * 256 + t); }
            else { const int s = tk - NPR, b = s >> 10, t = s & 1023; p = YTs + ((long)(b * 2048 + g * 512 + c) * 2048 + h * 1024 + t); }
            *(u32x2*)p = (u32x2){pk2(v[0], v[1]), pk2(v[2], v[3])}; } } };

template <class T> __device__ __forceinline__ T* opq(T* p) { asm volatile("" : "+s"(p)); return p; }
struct Frame {
    LAS unsigned char* lds;
    unsigned char* ws;
    int tid, lane, wave, bid, nblk, gw, ngw;
};

__device__ __forceinline__ void ln_row(const float* yrow, const float* g, const float* b, float* xrow, bf16* urow, const float* shift, const float* scale, float* orow, int lane) {
    f32x4 v[8]; float s = 0.f;
#pragma unroll
    for (int i = 0; i < 8; ++i) { v[i] = *(const f32x4*)(yrow + i * 256 + lane * 4); s += (v[i][0] + v[i][1]) + (v[i][2] + v[i][3]); }
    const float mean = wave_sum(s) * (1.f / D); float s2 = 0.f;
#pragma unroll
    for (int i = 0; i < 8; ++i) { v[i] = v[i] - mean; s2 += (v[i][0] * v[i][0] + v[i][1] * v[i][1]) + (v[i][2] * v[i][2] + v[i][3] * v[i][3]); }
    const float rstd = rsqrtf(wave_sum(s2) * (1.f / D) + LN_EPS);
#pragma unroll
    for (int i = 0; i < 8; ++i) { const int c = i * 256 + lane * 4;
        const f32x4 o = v[i] * rstd * *(const f32x4*)(g + c) + *(const f32x4*)(b + c);
        *(f32x4*)(xrow + c) = o;
        if (orow) *(f32x4*)(orow + c) = o;
        if (urow) { const f32x4 u = o * (*(const f32x4*)(scale + c) + 1.0f) + *(const f32x4*)(shift + c); *(u32x2*)(urow + c) = (u32x2){pk2(u[0], u[1]), pk2(u[2], u[3])}; } }
}

template <int NV, bool BAND>
__device__ __forceinline__ void softmax_row(float* row, int t, bool has_sink, float sink, int lane) {
    f32x4 v[NV]; float mx = -3.0e38f;
#pragma unroll
    for (int i = 0; i < NV; ++i) { v[i] = *(const f32x4*)(row + i * 256 + lane * 4);
#pragma unroll
        for (int e = 0; e < 4; ++e) { if (BAND) { const int s = i * 256 + lane * 4 + e; const int dlt = t - s; const bool ok = (s >= 1024) || (dlt <= 128 && dlt >= -128); if (!ok) v[i][e] = -3.0e38f; } mx = fmaxf(mx, v[i][e]); } }
    mx = wave_max(mx); if (has_sink) mx = fmaxf(mx, sink);
    float sum = 0.f;
#pragma unroll
    for (int i = 0; i < NV; ++i)
#pragma unroll
        for (int e = 0; e < 4; ++e) { const float p = (v[i][e] < -1.0e38f) ? 0.f : __expf(v[i][e] - mx); v[i][e] = p; sum += p; }
    sum = wave_sum(sum); if (has_sink) sum += __expf(sink - mx);
    const float inv = 1.f / sum;
    bf16* prow = (bf16*)row;
#pragma unroll
    for (int i = 0; i < NV; ++i) *(u32x2*)(prow + i * 256 + lane * 4) = (u32x2){pk2(v[i][0] * inv, v[i][1] * inv), pk2(v[i][2] * inv, v[i][3] * inv)};
}

__device__ __forceinline__ void transpose_item(const float* W, int K, int N, bf16* WT, int row_off, LAS float* scr, int item, int lane) {
    const int nblkn = N / 32, kb = item / nblkn, nb = item % nblkn, k0 = 64 * kb, n0 = 32 * nb;
#pragma unroll 8
    for (int i = 0; i < 32; ++i) { const int kk = 2 * i + (lane >> 5); scr[kk * 33 + (lane & 31)] = W[(size_t)(k0 + kk) * N + n0 + (lane & 31)]; }
    LDS_WAIT();
    const int c = lane & 7;
#pragma unroll
    for (int j = 0; j < 4; ++j) { const int n = (lane >> 3) + 8 * j; const LAS float* s = scr + (8 * c) * 33 + n;
        u32x4 o; o.x = pk2(s[0 * 33], s[1 * 33]); o.y = pk2(s[2 * 33], s[3 * 33]); o.z = pk2(s[4 * 33], s[5 * 33]); o.w = pk2(s[6 * 33], s[7 * 33]);
        *(u32x4*)(WT + (size_t)(row_off + n0 + n) * K + k0 + 8 * c) = o; }
    LDS_WAIT();
}

__device__ __forceinline__ int cflat(int l) {
    int a = 0, base = 0;
    if (l >= 16) { a = 1; base = 16; } if (l >= 24) { a = 2; base = 24; } if (l >= 29) { a = 3; base = 29; } if (l >= 33) { a = 4; base = 33; }
    if (l >= 36) { a = 5; base = 36; } if (l >= 38) { a = 6; base = 38; } if (l >= 40) { a = 7; base = 40; } if (l >= 42) { a = 8 + (l - 42); base = l; }
    return l < 50 ? a * 16 + (l - base) : 9999;
}
#if !MK_PER_PHASE
#define SYNC() xcd_barrier(bar)
#else
#define SYNC() do {} while (0)
#endif
#define PH_BEGIN unsigned char* ws = opq(ws_)
#define IP(i) opq(args.in[i])
#define MODS ((float*)(ws + WS_MODS))
#define X ((float*)(ws + WS_X))
#define Y ((float*)(ws + WS_Y))
#define Ub ((bf16*)(ws + WS_U))
#define Ob ((bf16*)(ws + WS_O))
#define SCR (ws + WS_SCR)
#define IN(k) (lo <= (k) && (k) < hi)
#define ENDPH(k) do { if (hi > (k) + 1) SYNC(); } while (0)
template <int L>
__device__ __forceinline__ void layer_phases(const Args& args, const Frame& F, unsigned char* const ws_, const int lo, const int hi, const XcdBarrier& bar) {
    int ub;
        const int P = 2 + L * 16;
#define modL (MODS + L * 3 * 12288)
        if constexpr (L == 0) {
#define T0 ((float*)SCR)
#define QN ((bf16*)(ws + WS_QN))
#define CKV ((bf16*)(ws + WS_CKV))
#define Qb ((bf16*)(ws + WS_Q))
#define KC ((bf16*)(ws + WS_KC))
#define VT ((bf16*)(ws + WS_VT))
#define SCp ((float*)SCR)
#define SCs ((float*)(SCR + 64 * MiB))
            if (IN(P + 0)) { PH_BEGIN;
                ub = 0; GemmP g{Ub, (const bf16*)(ws + WS_W0T), D, D, 0, 0, 0, 0, 0, 0, MT, 1088, D, 1, 1, 1};
                sg_gemm(F.lds, g, EpiF32{T0, 1088, 0, 0, 0, 1.f}, F.bid, F.nblk, ub);
                ENDPH(P + 0);
            }
            if (IN(P + 1)) { PH_BEGIN;
                const float* qg = IP(I_QNORM); const float* kg = IP(I_KVNORM);
                for (int m = F.gw; m < MT; m += F.ngw) {
                    const float* tr = T0 + (size_t)m * 1088; const int kvr = kvrow_of(m); const int c = F.lane * 8;
                    { f32x4 a = *(const f32x4*)(tr + c), b = *(const f32x4*)(tr + c + 4);
                      float ss = (a[0] * a[0] + a[1] * a[1]) + (a[2] * a[2] + a[3] * a[3]) + (b[0] * b[0] + b[1] * b[1]) + (b[2] * b[2] + b[3] * b[3]);
                      const float r = rsqrtf(wave_sum(ss) * (1.f / 512.f) + RMS_EPS);
                      a = a * r * *(const f32x4*)(qg + c); b = b * r * *(const f32x4*)(qg + c + 4);
                      *(u32x4*)(QN + (size_t)m * 512 + c) = (u32x4){pk2(a[0], a[1]), pk2(a[2], a[3]), pk2(b[0], b[1]), pk2(b[2], b[3])}; }
                    { f32x4 a = *(const f32x4*)(tr + 512 + c), b = *(const f32x4*)(tr + 512 + c + 4);
                      float ss = (a[0] * a[0] + a[1] * a[1]) + (a[2] * a[2] + a[3] * a[3]) + (b[0] * b[0] + b[1] * b[1]) + (b[2] * b[2] + b[3] * b[3]);
                      const float r = rsqrtf(wave_sum(ss) * (1.f / 512.f) + RMS_EPS);
                      a = a * r * *(const f32x4*)(kg + c); b = b * r * *(const f32x4*)(kg + c + 4);
                      *(u32x4*)(CKV + (size_t)kvr * 512 + c) = (u32x4){pk2(a[0], a[1]), pk2(a[2], a[3]), pk2(b[0], b[1]), pk2(b[2], b[3])};
                      if (m < NPR) { float* o = args.out + OUT_CKV + (size_t)m * 512 + c; *(f32x4*)o = a; *(f32x4*)(o + 4) = b; } }
                    { float x = tr[1024 + F.lane];
                      if (m < NPR) args.out[OUT_KR + (size_t)m * 64 + F.lane] = x;
                      else { const int t = (m - NPR) & 1023, e = F.lane, j = e & 15; const int pos = (e < 32) ? (t >> 6) : (t & 63);
                          const float inv = exp2f(-(float)j * (13.287712379549449f / 16.0f)); float sn, cs; sincosf((float)pos * inv, &sn, &cs);
                          const float pr = __shfl_xor(x, 16); x = ((e & 16) == 0) ? (x * cs - pr * sn) : (pr * sn + x * cs); }
                      const bf16 xb = (bf16)f2bf(x);
#pragma unroll
                      for (int h = 0; h < 16; ++h) KC[((size_t)kvr * 16 + h) * 192 + 128 + F.lane] = xb; }
                }
                ENDPH(P + 1);
            }
            if (IN(P + 2)) { PH_BEGIN;
                ub = 0; GemmP g{QN, (const bf16*)(ws + WS_WUQT), 512, 512, 0, 0, 0, 0, 0, 0, MT, 3072, 512, 1, 1, 1};
                sg_gemm(F.lds, g, EpiQMla{Qb}, F.bid, F.nblk, ub);
                GemmP g2{CKV, (const bf16*)(ws + WS_WUKT), 512, 512, 0, 0, 0, 0, 0, 0, KVR, 2048, 512, 1, 1, 1};
                sg_gemm(F.lds, g2, EpiKn{KC}, F.bid, F.nblk, ub);
                GemmP g3{(const bf16*)(ws + WS_WUVT), CKV, 512, 512, 0, 0, 0, 0, 0, 0, 2048, KVR, 512, 1, 1, 1};
                sg_gemm(F.lds, g3, EpiBf16{VT, KVR, 0, 0, 0, 1.f}, F.bid, F.nblk, ub);
                ENDPH(P + 2);
            }
            if (IN(P + 3)) { PH_BEGIN;
                ub = 0;
                GemmP gp{Qb, KC, 3072, 3072, 256L * 3072, 192, 0, 256L * 3072, 192, 0, 256, 256, 192, 16, 16, 1};
                sg_gemm(F.lds, gp, EpiF32{SCp, 256, 16L * 256 * 256, 256L * 256, 0, MLA_SCALE}, F.bid, F.nblk, ub);
                GemmP gs{Qb + (size_t)NPR * 3072, KC + (size_t)NPR * 3072, 3072, 3072, 1024L * 3072, 192, 0, 1280L * 3072, 192, 0, 1024, 1280, 192, 2, 16, 1};
                sg_gemm(F.lds, gs, EpiF32{SCs, 1280, 16L * 1024 * 1280, 1024L * 1280, 0, MLA_SCALE}, F.bid, F.nblk, ub);
                ENDPH(P + 3);
            }
            if (IN(P + 4)) { PH_BEGIN;
                for (int r = F.gw; r < 16 * 16 * 256; r += F.ngw) softmax_row<1, false>(SCp + (size_t)r * 256, 0, false, 0.f, F.lane);
                for (int r = F.gw; r < 2 * 16 * 1024; r += F.ngw) softmax_row<5, false>(SCs + (size_t)r * 1280, 0, false, 0.f, F.lane);
                ENDPH(P + 4);
            }
            if (IN(P + 5)) { PH_BEGIN;
                ub = 0;
                GemmP gp{(const bf16*)SCp, VT, 512, KVR, 16L * 256 * 512, 256L * 512, 0, 256, 128L * KVR, 0, 256, 128, 256, 16, 16, 1};
                sg_gemm(F.lds, gp, EpiBf16{Ob, D, 256L * D, 128, 0, 1.f}, F.bid, F.nblk, ub);
                GemmP gs{(const bf16*)SCs, VT + NPR, 2560, KVR, 16L * 1024 * 2560, 1024L * 2560, 0, 1280, 128L * KVR, 0, 1024, 128, 1280, 2, 16, 1};
                sg_gemm(F.lds, gs, EpiBf16{Ob + (size_t)NPR * D, D, 1024L * D, 128, 0, 1.f}, F.bid, F.nblk, ub);
                ENDPH(P + 5);
            }
        } else if constexpr (L == 1) {
#undef SCs
#define SCs ((float*)(SCR + 128 * MiB))
#define Q1 ((bf16*)(ws + WS_Q))
#define K1 ((bf16*)(ws + WS_KC))
#define VT1 ((bf16*)(ws + WS_VT))
            if (IN(P + 0)) { PH_BEGIN;
                const int gt = F.bid * NTHR + F.tid, ngt = F.nblk * NTHR;
                { const float* c1 = IP(I_C1K);
                  for (int i = gt; i < 2 * 256 * 512; i += ngt) { const int b = i >> 17, r = i & 131071; K1[(size_t)(NPR + b * 1280 + 1024) * 512 + r] = (bf16)f2bf(c1[i]); } }
                { const float* c1 = IP(I_C1V);
                  for (int i = gt; i < 2 * 256 * 512; i += ngt) { const int b = i >> 17, s = (i >> 9) & 255, c = i & 511; VT1[(size_t)c * KVR + NPR + b * 1280 + 1024 + s] = (bf16)f2bf(c1[i]); } }
                ub = 0; GemmP g{Ub, (const bf16*)(ws + WS_WQKVT), D, D, 0, 0, 0, 0, 0, 0, MT, 3072, D, 1, 1, 1};
                sg_gemm(F.lds, g, EpiQkv1{Q1, K1, VT1, args.out + OUT_K1, args.out + OUT_V1}, F.bid, F.nblk, ub);
                ENDPH(P + 0);
            }
            if (IN(P + 3)) { PH_BEGIN;
                ub = 0;
                GemmP gp{Q1, K1, D, 512, 256L * D, 256, 64, 256L * 512, 64, 0, 256, 256, 64, 16, 8, 4};
                sg_gemm(F.lds, gp, EpiF32{SCp, 256, 32L * 256 * 256, 4L * 256 * 256, 256L * 256, GQA_SCALE}, F.bid, F.nblk, ub);
                GemmP gs{Q1 + (size_t)NPR * D, K1 + (size_t)NPR * 512, D, 512, 1024L * D, 256, 64, 1280L * 512, 64, 0, 1024, 1280, 64, 2, 8, 4};
                sg_gemm(F.lds, gs, EpiF32{SCs, 1280, 32L * 1024 * 1280, 4L * 1024 * 1280, 1024L * 1280, GQA_SCALE}, F.bid, F.nblk, ub);
                ENDPH(P + 3);
            }
            if (IN(P + 4)) { PH_BEGIN;
                const float* sink = IP(I_SINK);
                for (int r = F.gw; r < 16 * 32 * 256; r += F.ngw) softmax_row<1, false>(SCp + (size_t)r * 256, 0, true, sink[(r >> 8) & 31], F.lane);
                for (int r = F.gw; r < 2 * 32 * 1024; r += F.ngw) softmax_row<5, true>(SCs + (size_t)r * 1280, r & 1023, true, sink[(r >> 10) & 31], F.lane);
                ENDPH(P + 4);
            }
            if (IN(P + 5)) { PH_BEGIN;
                ub = 0;
                GemmP gp{(const bf16*)SCp, VT1, 512, KVR, 32L * 256 * 512, 4L * 256 * 512, 256L * 512, 256, 64L * KVR, 0, 256, 64, 256, 16, 8, 4};
                sg_gemm(F.lds, gp, EpiBf16{Ob, D, 256L * D, 256, 64, 1.f}, F.bid, F.nblk, ub);
                GemmP gs{(const bf16*)SCs, VT1 + NPR, 2560, KVR, 32L * 1024 * 2560, 4L * 1024 * 2560, 1024L * 2560, 1280, 64L * KVR, 0, 1024, 64, 1280, 2, 8, 4};
                sg_gemm(F.lds, gs, EpiBf16{Ob + (size_t)NPR * D, D, 1024L * D, 256, 64, 1.f}, F.bid, F.nblk, ub);
                ENDPH(P + 5);
            }
        } else if constexpr (L == 2) {
#define YTp ((bf16*)SCR)
#define YTs ((bf16*)(SCR + 32 * MiB))
            if (IN(P + 0)) { PH_BEGIN;
                ub = 0; GemmP g{(const bf16*)(ws + WS_CS512), Ub, 512, D, 0, 0, 0, 512, 0, 0, 1024, MT, 512, 4, 1, 1};
                sg_gemm(F.lds, g, EpiDft1{YTp, YTs}, F.bid, F.nblk, ub);
                ENDPH(P + 0);
            }
            if (IN(P + 5)) { PH_BEGIN;
                ub = 0;
                GemmP gp{(const bf16*)(ws + WS_CT256), YTp, 512, 512, 0, 0, 0, 2048L * 512, 0, 0, 256, 2048, 512, 16, 1, 1};
                sg_gemm(F.lds, gp, EpiBf16{Ob, D, 256L * D, 0, 0, 0.0027621358640099515f}, F.bid, F.nblk, ub);
                GemmP gs{(const bf16*)(ws + WS_CT1024), YTs, 2048, 2048, 0, 0, 0, 2048L * 2048, 0, 0, 1024, 2048, 2048, 2, 1, 1};
                sg_gemm(F.lds, gs, EpiBf16{Ob + (size_t)NPR * D, D, 1024L * D, 0, 0, 0.0013810679320049757f}, F.bid, F.nblk, ub);
                ENDPH(P + 5);
            }
        } else {
#define BCH ((bf16*)SCR)
            if (IN(P + 0)) { PH_BEGIN;
                ub = 0; GemmP g{Ub, (const bf16*)(ws + WS_WINT), D, D, 0, 0, 0, 0, 0, 0, MT, 6144, D, 1, 1, 1};
                sg_gemm(F.lds, g, EpiBf16{BCH, 6144, 0, 0, 0, 1.f}, F.bid, F.nblk, ub);
                ENDPH(P + 0);
            }
            if (IN(P + 5)) { PH_BEGIN;
                const float* cw = IP(I_CONVW); const float* cb = IP(I_CONVB);
                for (int m = F.gw; m < MT; m += F.ngw) {
                    const int t = (m < NPR) ? (m & 255) : ((m - NPR) & 1023); const int T = (m < NPR) ? 256 : 1024;
                    const bool hasp = t > 0, hasn = t < T - 1;
#pragma unroll
                    for (int i = 0; i < 4; ++i) { const int c = i * 512 + F.lane * 8; const bf16* r0 = BCH + (size_t)m * 6144 + c;
                        const u32x4 bb = *(const u32x4*)r0, cc = *(const u32x4*)(r0 + 2048), hh = *(const u32x4*)(r0 + 4096);
                        u32x4 cp = {0u, 0u, 0u, 0u}, hp = cp, cn = cp, hn = cp;
                        if (hasp) { cp = *(const u32x4*)(r0 - 6144 + 2048); hp = *(const u32x4*)(r0 - 6144 + 4096); }
                        if (hasn) { cn = *(const u32x4*)(r0 + 6144 + 2048); hn = *(const u32x4*)(r0 + 6144 + 4096); }
                        unsigned o[4];
#pragma unroll
                        for (int q = 0; q < 4; ++q) { const int d = c + 2 * q;
                            const float z0l = bflo(cp[q]) * bflo(hp[q]), z0h = bfhi(cp[q]) * bfhi(hp[q]);
                            const float z1l = bflo(cc[q]) * bflo(hh[q]), z1h = bfhi(cc[q]) * bfhi(hh[q]);
                            const float z2l = bflo(cn[q]) * bflo(hn[q]), z2h = bfhi(cn[q]) * bfhi(hn[q]);
                            const float yl = bflo(bb[q]) * (cw[d] * z0l + cw[D + d] * z1l + cw[2 * D + d] * z2l + cb[d]);
                            const float yh = bfhi(bb[q]) * (cw[d + 1] * z0h + cw[D + d + 1] * z1h + cw[2 * D + d + 1] * z2h + cb[d + 1]);
                            o[q] = pk2(yl, yh); }
                        *(u32x4*)(Ob + (size_t)m * D + c) = (u32x4){o[0], o[1], o[2], o[3]}; }
                }
                ENDPH(P + 5);
            }
        }
        if (IN(P + 6)) { PH_BEGIN;
            const size_t wofs = (L == 0) ? WS_WOT0 : (L == 1) ? WS_WOT1 : (L == 2) ? WS_WFT : WS_WCOT;
            ub = 0; GemmP g{Ob, (const bf16*)(ws + wofs), D, D, 0, 0, 0, 0, 0, 0, MT, D, D, 1, 1, 1};
            sg_gemm(F.lds, g, EpiResid{Y, X, modL + 2 * D}, F.bid, F.nblk, ub);
            ENDPH(P + 6);
        }
        if (IN(P + 7)) { PH_BEGIN;
            const float* g1 = IP(I_LN1G) + L * D; const float* b1 = IP(I_LN1B) + L * D;
            for (int m = F.gw; m < MT; m += F.ngw) { const float* md = modL + cond_of(m) * 12288;
                ln_row(Y + (size_t)m * D, g1, b1, X + (size_t)m * D, Ub + (size_t)m * D, md + 3 * D, md + 4 * D, nullptr, F.lane); }
            ENDPH(P + 7);
        }
#define PQ ((bf16*)SCR)
#define PS ((float*)(SCR + 24 * MiB))
#define PU8 ((unsigned char*)(ws + WS_PU))
#define PV8 ((unsigned char*)(ws + WS_PV))
#define SU8 ((float*)(ws + WS_PU + 32 * MiB))
#define SV8 ((float*)(ws + WS_PV + 32 * MiB))
        if (IN(P + 8)) { PH_BEGIN;
            ub = 0; GemmP g{Ub, (const bf16*)(ws + WS_WPQT) + (size_t)L * D * D, D, D, 0, 0, 0, 0, 0, 0, MT, D, D, 1, 1, 1};
            sg_gemm(F.lds, g, EpiBf16{PQ, D, 0, 0, 0, 1.f}, F.bid, F.nblk, ub);
            {
                const float* pu = IP(I_PEERU) + (size_t)L * 16384 * D; const float* pv = IP(I_PEERV) + (size_t)L * 16384 * D;
                for (int r = F.gw; r < 32768; r += F.ngw) {
                    const bool isv = r >= 16384; const int e = r & 16383;
                    const GAS float* src = (const GAS float*)((isv ? pv : pu) + (size_t)e * D) + F.lane * 16;
                    f32x4 v[2][4]; float mx = 0.f;
#pragma unroll
                    for (int j = 0; j < 2; ++j)
#pragma unroll
                        for (int k = 0; k < 4; ++k) { v[j][k] = *(const GAS f32x4*)(src + j * 1024 + k * 4);
                            mx = fmaxf(mx, fmaxf(fmaxf(fabsf(v[j][k][0]), fabsf(v[j][k][1])), fmaxf(fabsf(v[j][k][2]), fabsf(v[j][k][3])))); }
                    mx = wave_max(mx);
                    const float sc = mx > 0.f ? 384.f / mx : 0.f;
                    GAS unsigned char* dst = (GAS unsigned char*)((isv ? PV8 : PU8) + (size_t)e * 2048) + F.lane * 16;
#pragma unroll
                    for (int j = 0; j < 2; ++j) { u32x4 o;
#pragma unroll
                        for (int k = 0; k < 4; ++k) o[k] = pack_fp8x4(v[j][k] * sc);
                        *(GAS u32x4*)(dst + j * 1024) = o; }
                    if (F.lane == 0) (isv ? SV8 : SU8)[e] = mx * (1.f / 384.f);
                }
            }
            ENDPH(P + 8);
        }
        if (IN(P + 9)) { PH_BEGIN;
            ub = 0; GemmP g{PQ, (const bf16*)(ws + WS_SK) + (size_t)L * 16 * 128 * 128, D, 128, 128, 0, 0, 128L * 128, 0, 0, MT, 128, 128, 16, 1, 1};
            sg_gemm(F.lds, g, EpiF32{PS, D, 128, 0, 0, 1.f}, F.bid, F.nblk, ub);
            ENDPH(P + 9);
        }
        if (IN(P + 10)) { PH_BEGIN;
            LAS float* wl = (LAS float*)(F.lds + F.wave * 12288); LAS float* psl = wl + 1024;
            LAS float* sv = wl; LAS int* si = (LAS int*)(wl + 256); LAS float* ts = wl + 512; LAS int* te = (LAS int*)(wl + 640); LAS float* tg = wl + 768; LAS float* cl = wl + 896;
            const float* g2 = IP(I_LN2G) + L * D; const float* b2 = IP(I_LN2B) + L * D;
            int ca, cbb;
            { const int l = F.lane; int a = 0, base = 0;
              if (l >= 16) { a = 1; base = 16; } if (l >= 24) { a = 2; base = 24; } if (l >= 29) { a = 3; base = 29; } if (l >= 33) { a = 4; base = 33; }
              if (l >= 36) { a = 5; base = 36; } if (l >= 38) { a = 6; base = 38; } if (l >= 40) { a = 7; base = 40; } if (l >= 42) { a = 8 + (l - 42); base = l; }
              ca = a; cbb = l - base; }
            const bool cvalid = F.lane < 50;
            for (int m = F.gw; m < MT; m += F.ngw) {
                const float* ps = PS + (size_t)m * D;
#pragma unroll
                for (int i = 0; i < 8; ++i) *(LAS f32x4*)(psl + i * 256 + F.lane * 4) = *(const GAS f32x4*)((const GAS float*)ps + (unsigned)(i * 256 + F.lane * 4));
                LDS_WAIT();
                for (int q = 0; q < 16; ++q) {
                    const LAS float* pl = psl + q * 128;
                    const float sa = pl[F.lane], sb = pl[64 + F.lane];
                    int ra = 0, rb = 0;
#pragma unroll 4
                    for (int j4 = 0; j4 < 16; ++j4) {
                        const f32x4 va4 = *(const LAS f32x4*)(pl + j4 * 4), vb4 = *(const LAS f32x4*)(pl + 64 + j4 * 4);
#pragma unroll
                        for (int e = 0; e < 4; ++e) { const int j = j4 * 4 + e; const float va = va4[e], vb = vb4[e];
                            ra += (va > sa || (va == sa && j < F.lane)) ? 1 : 0; ra += (vb > sa) ? 1 : 0;
                            rb += (va >= sb) ? 1 : 0; rb += (vb > sb || (vb == sb && j < F.lane)) ? 1 : 0; } }
                    if (ra < 16) { sv[q * 16 + ra] = sa; si[q * 16 + ra] = F.lane; }
                    if (rb < 16) { sv[q * 16 + rb] = sb; si[q * 16 + rb] = 64 + F.lane; }
                }
                LDS_WAIT();
                for (int h = 0; h < 8; ++h) {
                    float cv = -3.0e38f; int cf = 9999, ce = 0;
                    if (cvalid) { cv = sv[(2 * h) * 16 + ca] + sv[(2 * h + 1) * 16 + cbb]; cf = ca * 16 + cbb; ce = si[(2 * h) * 16 + ca] * 128 + si[(2 * h + 1) * 16 + cbb]; }
                    cl[F.lane] = cv; LDS_WAIT();
                    int rk = 0;
#pragma unroll 4
                    for (int j4 = 0; j4 < 13; ++j4) { const f32x4 v4 = *(const LAS f32x4*)(cl + j4 * 4);
#pragma unroll
                        for (int e = 0; e < 4; ++e) { const int j = j4 * 4 + e; const float vj = v4[e]; const int fj = cflat(j);
                            rk += (vj > cv || (vj == cv && fj < cf)) ? 1 : 0; } }
                    if (cvalid && rk < 16) { ts[h * 16 + rk] = cv; te[h * 16 + rk] = ce; }
                }
                LDS_WAIT();
#pragma unroll
                for (int q = 0; q < 2; ++q) { const int e = q * 64 + F.lane; const float s = ts[e]; float mx = s;
#pragma unroll
                    for (int o = 1; o < 16; o <<= 1) mx = fmaxf(mx, __shfl_xor(mx, o));
                    const float p = __expf(s - mx); float sm = p;
#pragma unroll
                    for (int o = 1; o < 16; o <<= 1) sm += __shfl_xor(sm, o);
                    tg[e] = p / sm; }
                LDS_WAIT();
                float xf[2][16];
#pragma unroll
                for (int j = 0; j < 2; ++j)
#pragma unroll
                    for (int k = 0; k < 2; ++k) { const u32x4 w = *(const GAS u32x4*)((const GAS bf16*)Ub + (size_t)m * D + j * 1024 + F.lane * 16 + k * 8);
#pragma unroll
                        for (int i = 0; i < 4; ++i) { xf[j][k * 8 + 2 * i] = bflo(w[i]); xf[j][k * 8 + 2 * i + 1] = bfhi(w[i]); } }
                float fa[2][16];
#pragma unroll
                for (int j = 0; j < 2; ++j)
#pragma unroll
                    for (int e = 0; e < 16; ++e) fa[j][e] = 0.f;
                struct GBuf { u32x4 u[2][2], v[2][2]; float su[2], sv[2], g[2]; };
                const GAS unsigned char* pu8 = (const GAS unsigned char*)PU8 + F.lane * 16; const GAS unsigned char* pv8 = (const GAS unsigned char*)PV8 + F.lane * 16;
                const GAS float* su8 = (const GAS float*)SU8; const GAS float* sv8 = (const GAS float*)SV8;
                auto gload = [&](GBuf& B, int eg) {
#pragma unroll
                    for (int q = 0; q < 2; ++q) { const int ex = __builtin_amdgcn_readfirstlane(te[eg + q]); B.g[q] = tg[eg + q];
                        const GAS unsigned char* up = pu8 + (size_t)ex * 2048; const GAS unsigned char* vp = pv8 + (size_t)ex * 2048;
                        B.u[q][0] = *(const GAS u32x4*)up; B.u[q][1] = *(const GAS u32x4*)(up + 1024); B.v[q][0] = *(const GAS u32x4*)vp; B.v[q][1] = *(const GAS u32x4*)(vp + 1024);
                        B.su[q] = su8[ex]; B.sv[q] = sv8[ex]; } };
                auto gcomp = [&](const GBuf& B) {
#pragma unroll
                    for (int q = 0; q < 2; ++q) {
                        float h0 = 0.f, h1 = 0.f, h2 = 0.f, h3 = 0.f;
#pragma unroll
                        for (int j = 0; j < 2; ++j)
#pragma unroll
                            for (int w = 0; w < 4; ++w) { const f32x2 lo = __builtin_amdgcn_cvt_pk_f32_fp8((int)B.u[q][j][w], false), hi = __builtin_amdgcn_cvt_pk_f32_fp8((int)B.u[q][j][w], true);
                                h0 += lo[0] * xf[j][4 * w]; h1 += lo[1] * xf[j][4 * w + 1]; h2 += hi[0] * xf[j][4 * w + 2]; h3 += hi[1] * xf[j][4 * w + 3]; }
                        const float hh = wave_sum((h0 + h1) + (h2 + h3)) * B.su[q];
                        const float a = 0.5f * hh * (1.0f + erff(hh * 0.70710678118654752f)) * B.g[q] * B.sv[q];
#pragma unroll
                        for (int j = 0; j < 2; ++j)
#pragma unroll
                            for (int w = 0; w < 4; ++w) { const f32x2 lo = __builtin_amdgcn_cvt_pk_f32_fp8((int)B.v[q][j][w], false), hi = __builtin_amdgcn_cvt_pk_f32_fp8((int)B.v[q][j][w], true);
                                fa[j][4 * w] += a * lo[0]; fa[j][4 * w + 1] += a * lo[1]; fa[j][4 * w + 2] += a * hi[0]; fa[j][4 * w + 3] += a * hi[1]; }
                    } };
                {
                    GBuf A, B;
                    gload(A, 0);
                    for (int eg = 0; eg < 128; eg += 4) {
                        gload(B, eg + 2);
                        gcomp(A);
                        if (eg + 4 < 128) gload(A, eg + 4);
                        gcomp(B);
                    }
                }
                const int cnd = cond_of(m);
                const GAS float* gt2 = (const GAS float*)(modL + cnd * 12288 + 5 * D); GAS float* xrow = (GAS float*)(X + (size_t)m * D);
                const unsigned lo16 = (unsigned)F.lane * 16u;
                float s = 0.f;
#pragma unroll
                for (int j = 0; j < 2; ++j)
#pragma unroll
                    for (int k = 0; k < 4; ++k) { const unsigned c = lo16 + (unsigned)(j * 1024 + 4 * k);
                        const f32x4 x0 = *(const GAS f32x4*)(xrow + c), g0 = *(const GAS f32x4*)(gt2 + c);
#pragma unroll
                        for (int e = 0; e < 4; ++e) { fa[j][4 * k + e] = ALPHA * x0[e] + g0[e] * fa[j][4 * k + e]; s += fa[j][4 * k + e]; } }
                const float mean = wave_sum(s) * (1.f / D); float s2 = 0.f;
#pragma unroll
                for (int j = 0; j < 2; ++j)
#pragma unroll
                    for (int e = 0; e < 16; ++e) { fa[j][e] -= mean; s2 += fa[j][e] * fa[j][e]; }
                const float rstd = rsqrtf(wave_sum(s2) * (1.f / D) + LN_EPS);
                const GAS float* mdn = (const GAS float*)(MODS + ((L < 3 ? L + 1 : L) * 3 + cnd) * 12288);
                const GAS float* g2g = (const GAS float*)g2; const GAS float* b2g = (const GAS float*)b2;
                GAS float* orow = (GAS float*)(args.out + OUT_Y + (size_t)m * D); GAS bf16* urow = (GAS bf16*)(Ub + (size_t)m * D);
#pragma unroll
                for (int j = 0; j < 2; ++j)
#pragma unroll
                    for (int k = 0; k < 4; ++k) { const unsigned c = lo16 + (unsigned)(j * 1024 + 4 * k);
                        const f32x4 f = {fa[j][4 * k], fa[j][4 * k + 1], fa[j][4 * k + 2], fa[j][4 * k + 3]};
                        const f32x4 o = f * rstd * *(const GAS f32x4*)(g2g + c) + *(const GAS f32x4*)(b2g + c);
                        *(GAS f32x4*)(xrow + c) = o;
                        if (L == 3) *(GAS f32x4*)(orow + c) = o;
                        else { const f32x4 u = o * (*(const GAS f32x4*)(mdn + D + c) + 1.0f) + *(const GAS f32x4*)(mdn + c); *(GAS u32x2*)(urow + c) = (u32x2){pk2(u[0], u[1]), pk2(u[2], u[3])}; } }
            }
            ENDPH(P + 10);
        }
}

__global__ void __launch_bounds__(NTHR, 2) fwd(Args args) {
    extern __shared__ __attribute__((aligned(16))) unsigned char lds_raw[];
    Frame F;
    F.lds = (LAS unsigned char*)lds_raw; F.ws = args.ws;
    F.tid = threadIdx.x; F.lane = F.tid & 63; F.wave = __builtin_amdgcn_readfirstlane(F.tid >> 6);
    F.bid = blockIdx.x; F.nblk = gridDim.x; F.gw = F.bid * NWAVE + F.wave; F.ngw = F.nblk * NWAVE;
    unsigned char* const ws_ = args.ws;
    const int lo = args.ph_lo, hi = args.ph_hi;
    volatile LAS unsigned* MISC = (volatile LAS unsigned*)(F.lds + LDS_MISC);
    if (F.tid < 16) MISC[F.tid] = 0u;
    __syncthreads();
    XcdBarrier bar; bar.bar = (unsigned*)(ws_ + WS_CTL) + 4096; bar.x = 0; bar.st = MISC + 8;
#if !MK_PER_PHASE
    bar = xcd_barrier_post((unsigned*)(ws_ + WS_CTL) + 4096, MISC + 8);
#endif
    int ub;

    if (IN(0)) { PH_BEGIN;
        LAS float* sc = (LAS float*)F.lds;
        LAS float* part = (LAS float*)(F.lds + 24576);
        for (int i = F.tid; i < 3 * D; i += NTHR) { const int j = i >> 11, k = i & 2047; const float c = (j == 0) ? IP(I_CCTX)[k] : IP(I_C)[(j - 1) * D + k]; sc[i] = c / (1.f + __expf(-c)); }
        __syncthreads();
        const float* adaw = IP(I_ADAW); const float* adab = IP(I_ADAB);
        for (int u = F.bid; u < 768; u += F.nblk) {
            const int layer = u / 192, n0 = (u % 192) * 64, kr = F.lane >> 4, cq = F.lane & 15;
            f32x4 a0 = {0.f, 0.f, 0.f, 0.f}, a1 = a0, a2 = a0;
            const float* wp = adaw + ((size_t)layer * D + F.wave * 256 + kr) * 12288 + n0 + cq * 4;
#pragma unroll 8
            for (int it = 0; it < 64; ++it) { const f32x4 w = *(const f32x4*)(wp + (size_t)it * 4 * 12288); const int k = F.wave * 256 + it * 4 + kr;
                a0 += w * sc[k]; a1 += w * sc[D + k]; a2 += w * sc[2 * D + k]; }
#pragma unroll
            for (int e = 0; e < 4; ++e) { a0[e] += __shfl_xor(a0[e], 16); a0[e] += __shfl_xor(a0[e], 32); a1[e] += __shfl_xor(a1[e], 16); a1[e] += __shfl_xor(a1[e], 32); a2[e] += __shfl_xor(a2[e], 16); a2[e] += __shfl_xor(a2[e], 32); }
            if (F.lane < 16) {
#pragma unroll
                for (int e = 0; e < 4; ++e) { part[(F.wave * 3 + 0) * 64 + cq * 4 + e] = a0[e]; part[(F.wave * 3 + 1) * 64 + cq * 4 + e] = a1[e]; part[(F.wave * 3 + 2) * 64 + cq * 4 + e] = a2[e]; } }
            __syncthreads();
            if (F.tid < 192) { const int j = F.tid >> 6, c = F.tid & 63; float s = adab[layer * 12288 + n0 + c];
#pragma unroll
                for (int w = 0; w < 8; ++w) s += part[(w * 3 + j) * 64 + c];
                MODS[(layer * 3 + j) * 12288 + n0 + c] = s; }
            __syncthreads();
        }
        {
            LAS float* scr = (LAS float*)(F.lds + F.wave * 8448);
            for (int it = F.gw; it < args.tj_total; it += F.ngw) {
                int j = 0;
#pragma unroll
                for (int q = 1; q < NTJOB; ++q) j = (it >= args.tj[q].first) ? q : j;
                const TJob& J = args.tj[j];
                transpose_item(J.W, J.K, J.N, (bf16*)(ws + J.dst), J.row_off, scr, it - J.first, F.lane);
            }
        }
        const int gt = F.bid * NTHR + F.tid, ngt = F.nblk * NTHR;
        { const float* sk = IP(I_SUBK); bf16* SK = (bf16*)(ws + WS_SK);
          for (int i = gt; i < 4 * 16 * 128 * 128 / 4; i += ngt) { const f32x4 v = *(const f32x4*)(sk + (size_t)i * 4); *(u32x2*)(SK + (size_t)i * 4) = (u32x2){pk2(v[0], v[1]), pk2(v[2], v[3])}; } }
        { bf16* CS = (bf16*)(ws + WS_CS512);
          for (int i = gt; i < 1024 * 512; i += ngt) { const int j = i >> 9, c = i & 511, r = ((j & 511) * c) & 511; const float x = (float)r * (1.f / 256.f); CS[i] = (bf16)f2bf(j < 512 ? cospif(x) : sinpif(x)); } }
        { bf16* CT = (bf16*)(ws + WS_CT256);
          for (int i = gt; i < 256 * 512; i += ngt) { const int t = i >> 9, k = i & 511, r = (t * (k & 255)) & 255; const float x = (float)r * (1.f / 128.f); CT[i] = (bf16)f2bf(k < 256 ? cospif(x) : -sinpif(x)); } }
        { bf16* CT = (bf16*)(ws + WS_CT1024);
          for (int i = gt; i < 1024 * 2048; i += ngt) { const int t = i >> 11, k = i & 2047, r = (t * (k & 1023)) & 1023; const float x = (float)r * (1.f / 512.f); CT[i] = (bf16)f2bf(k < 1024 ? cospif(x) : -sinpif(x)); } }
        { const float* c0 = IP(I_C0CKV); bf16* ckvp = (bf16*)(ws + WS_CKV);
          for (int i = gt; i < 2 * 256 * 512; i += ngt) { const int b = i >> 17, r = i & 131071; ckvp[(size_t)(NPR + b * 1280 + 1024) * 512 + r] = (bf16)f2bf(c0[i]); } }
        { const float* c0 = IP(I_C0KR); bf16* kcp = (bf16*)(ws + WS_KC);
          for (int i = gt; i < 2 * 256 * 64 * 16; i += ngt) { const int h = i & 15, e = i >> 4, j = e & 63, s = (e >> 6) & 255, b = e >> 14;
              kcp[((size_t)(NPR + b * 1280 + 1024 + s) * 16 + h) * 192 + 128 + j] = (bf16)f2bf(c0[e]); } }
        ENDPH(0);
    }
    if (IN(1)) { PH_BEGIN;
        for (int m = F.gw; m < MT; m += F.ngw) {
            const float* xr = (m < NPR) ? IP(I_XP) + (size_t)m * D : IP(I_XS) + (size_t)(m - NPR) * D;
            const float* md = MODS + cond_of(m) * 12288;
#pragma unroll
            for (int i = 0; i < 8; ++i) { const int c = i * 256 + F.lane * 4; const f32x4 v = *(const f32x4*)(xr + c);
                *(f32x4*)(X + (size_t)m * D + c) = v;
                const f32x4 u = v * (*(const f32x4*)(md + D + c) + 1.0f) + *(const f32x4*)(md + c);
                *(u32x2*)(Ub + (size_t)m * D + c) = (u32x2){pk2(u[0], u[1]), pk2(u[2], u[3])}; }
        }
        ENDPH(1);
    }

    layer_phases<0>(args, F, ws_, lo, hi, bar);
    layer_phases<1>(args, F, ws_, lo, hi, bar);
    layer_phases<2>(args, F, ws_, lo, hi, bar);
    layer_phases<3>(args, F, ws_, lo, hi, bar);
}

static const int kPhases[] = {0, 1,
    2, 3, 4, 5, 6, 7, 8, 9, 10, 11, 12,
    18, 21, 22, 23, 24, 25, 26, 27, 28,
    34, 39, 40, 41, 42, 43, 44,
    50, 55, 56, 57, 58, 59, 60};

extern "C" void kernel_launch(void* const* d_in, const int* in_sizes, int n_in, void* d_out, int out_size, void* d_ws, size_t ws_size, hipStream_t stream) {
    static int grid = 0;
    if (grid == 0) {
        if (n_in != 34 || ws_size < WS_END) { fprintf(stderr, "kernel_launch: unexpected n_in %d / ws_size %zu\n", n_in, ws_size); grid = -1; return; }
        int dev = 0, cus = 0;
        if (hipGetDevice(&dev) != hipSuccess || hipDeviceGetAttribute(&cus, hipDeviceAttributeMultiprocessorCount, dev) != hipSuccess) { grid = -1; return; }
        if (hipFuncSetAttribute((const void*)fwd, hipFuncAttributeMaxDynamicSharedMemorySize, LDS_BYTES) != hipSuccess) { fprintf(stderr, "kernel_launch: hipFuncSetAttribute failed\n"); grid = -1; return; }
        int per_cu = 0;
        if (hipOccupancyMaxActiveBlocksPerMultiprocessor(&per_cu, (const void*)fwd, NTHR, LDS_BYTES) != hipSuccess || per_cu < 1) fprintf(stderr, "kernel_launch: occupancy query says %d\n", per_cu);
        (void)hipGetLastError();
        grid = cus;
    }
    if (grid < 0) return;
    (void)hipMemsetAsync((char*)d_ws + WS_CTL, 0, CTL_BYTES, stream);
    Args a{};
    for (int i = 0; i < 34; ++i) a.in[i] = (const float*)d_in[i];
    a.out = (float*)d_out; a.ws = (unsigned char*)d_ws;
    {
        struct J { int idx; size_t sub; size_t dst; int K, N, row_off; };
        const J js[NTJOB] = {
            {I_WDQ, 0, WS_W0T, 2048, 512, 0}, {I_WDKV, 0, WS_W0T, 2048, 576, 512}, {I_WUQ, 0, WS_WUQT, 512, 3072, 0}, {I_WUK, 0, WS_WUKT, 512, 2048, 0},
            {I_WUV, 0, WS_WUVT, 512, 2048, 0}, {I_WO0, 0, WS_WOT0, 2048, 2048, 0}, {I_WQKV, 0, WS_WQKVT, 2048, 3072, 0}, {I_WO1, 0, WS_WOT1, 2048, 2048, 0},
            {I_WF, 0, WS_WFT, 2048, 2048, 0}, {I_WIN, 0, WS_WINT, 2048, 6144, 0}, {I_WCO, 0, WS_WCOT, 2048, 2048, 0},
            {I_WPQ, 0, WS_WPQT, 2048, 2048, 0}, {I_WPQ, (size_t)1 * 2048 * 2048, WS_WPQT + (size_t)1 * 2048 * 2048 * 2, 2048, 2048, 0},
            {I_WPQ, (size_t)2 * 2048 * 2048, WS_WPQT + (size_t)2 * 2048 * 2048 * 2, 2048, 2048, 0}, {I_WPQ, (size_t)3 * 2048 * 2048, WS_WPQT + (size_t)3 * 2048 * 2048 * 2, 2048, 2048, 0}};
        int first = 0;
        for (int j = 0; j < NTJOB; ++j) { a.tj[j].W = (const float*)d_in[js[j].idx] + js[j].sub; a.tj[j].dst = js[j].dst; a.tj[j].K = js[j].K; a.tj[j].N = js[j].N; a.tj[j].row_off = js[j].row_off; a.tj[j].first = first;
            first += (js[j].K / 64) * (js[j].N / 32); }
        a.tj_total = first;
    }
#if MK_PER_PHASE
    for (size_t i = 0; i < sizeof(kPhases) / sizeof(kPhases[0]); ++i) {
        a.ph_lo = kPhases[i]; a.ph_hi = kPhases[i] + 1;
        hipLaunchKernelGGL(fwd, dim3(grid), dim3(NTHR), LDS_BYTES, stream, a);
    }
#else
    a.ph_lo = 0; a.ph_hi = 1 << 20;
    hipLaunchKernelGGL(fwd, dim3(grid), dim3(NTHR), LDS_BYTES, stream, a);
#endif
    const hipError_t le = hipPeekAtLastError();
    if (le != hipSuccess) fprintf(stderr, "kernel_launch: launch failed: %s\n", hipGetErrorName(le));
}
```

```cpp
#include <hip/hip_runtime.h>
#include <cstdio>
#include <cstdint>

#ifndef MK_PER_PHASE
#define MK_PER_PHASE 0
#endif

#define LAS __attribute__((address_space(3)))
typedef unsigned short bf16;
typedef short bf16x8 __attribute__((ext_vector_type(8)));
typedef float f32x4 __attribute__((ext_vector_type(4)));
typedef unsigned u32x4 __attribute__((ext_vector_type(4)));
typedef unsigned u32x2 __attribute__((ext_vector_type(2)));
typedef __bf16 bf16x2_t __attribute__((ext_vector_type(2)));
typedef float f32x2 __attribute__((ext_vector_type(2)));
#define GAS __attribute__((address_space(1)))
__device__ __forceinline__ unsigned pack_fp8x4(f32x4 a) { int w = __builtin_amdgcn_cvt_pk_fp8_f32(a[0], a[1], 0, false); w = __builtin_amdgcn_cvt_pk_fp8_f32(a[2], a[3], w, true); return (unsigned)w; }

constexpr int D = 2048, NPR = 4096, MT = 6144, KVR = 6656;
constexpr int NTHR = 512, NWAVE = 8;
constexpr float ALPHA = 1.6817928305074290f;
constexpr float MLA_SCALE = 0.07216878364870322f;
constexpr float GQA_SCALE = 0.125f;
constexpr float LN_EPS = 1e-5f, RMS_EPS = 1e-6f;

constexpr size_t MiB = 1u << 20;
constexpr size_t WS_CTL = 0, CTL_BYTES = 1 * MiB;
constexpr size_t WS_MODS = 1 * MiB;
constexpr size_t WS_W0T = 2 * MiB, WS_WUQT = 7 * MiB, WS_WUKT = 10 * MiB, WS_WUVT = 12 * MiB, WS_WOT0 = 14 * MiB, WS_WQKVT = 22 * MiB,
                 WS_WOT1 = 34 * MiB, WS_WFT = 42 * MiB, WS_WINT = 50 * MiB, WS_WCOT = 74 * MiB, WS_WPQT = 82 * MiB, WS_SK = 114 * MiB,
                 WS_CS512 = 116 * MiB, WS_CT256 = 117 * MiB, WS_CT1024 = 118 * MiB, WS_PU = 122 * MiB, WS_PV = 186 * MiB,
                 WS_X = 250 * MiB, WS_Y = 298 * MiB, WS_U = 346 * MiB, WS_O = 370 * MiB, WS_Q = 394 * MiB, WS_KC = 430 * MiB,
                 WS_VT = 469 * MiB, WS_QN = 495 * MiB, WS_CKV = 501 * MiB, WS_SCR = 508 * MiB, WS_END = 956 * MiB;
constexpr size_t OUT_Y = 0, OUT_CKV = 12582912, OUT_KR = 14680064, OUT_K1 = 14942208, OUT_V1 = 17039360;

constexpr int LDS_BYTES = 147456;
constexpr int LDS_MISC = 140 * 1024;

#define LDS_WAIT() asm volatile("s_waitcnt lgkmcnt(0)" ::: "memory")
__device__ __forceinline__ unsigned f2bf(float f) { unsigned u = __float_as_uint(f); return (u + 0x7fffu + ((u >> 16) & 1u)) >> 16; }
__device__ __forceinline__ unsigned pk2(float lo, float hi) { unsigned r; asm("v_cvt_pk_bf16_f32 %0, %1, %2" : "=v"(r) : "v"(lo), "v"(hi)); return r; }
__device__ __forceinline__ float bflo(unsigned w) { return __uint_as_float(w << 16); }
__device__ __forceinline__ float bfhi(unsigned w) { return __uint_as_float(w & 0xffff0000u); }
__device__ __forceinline__ float wave_sum(float v) {
#pragma unroll
    for (int o = 1; o < 64; o <<= 1) v += __shfl_xor(v, o);
    return v;
}
__device__ __forceinline__ float wave_max(float v) {
#pragma unroll
    for (int o = 1; o < 64; o <<= 1) v = fmaxf(v, __shfl_xor(v, o));
    return v;
}
__device__ __forceinline__ float dot2bf(unsigned w, unsigned x, float acc) {
    return __builtin_amdgcn_fdot2_f32_bf16(__builtin_bit_cast(bf16x2_t, w), __builtin_bit_cast(bf16x2_t, x), acc, false);
}
__device__ __forceinline__ int cond_of(int m) { return m < NPR ? 0 : 1 + ((m - NPR) >> 10); }
__device__ __forceinline__ int kvrow_of(int m) { return m < NPR ? m : NPR + ((m - NPR) >> 10) * 1280 + ((m - NPR) & 1023); }

#define XB_TMO      128
#define XB_XCNT(j)  (256  + 64 * (j))
#define XB_XSUB(j)  (1280 + 64 * (j))
#define XB_XGEN(j)  (2304 + 64 * (j))
#define XB_TOP      3328
#define XB_TOPGEN   3392
#define XCD_BAR_WORDS 3456
#define XB_SPIN_CAP (1u << 22)
__device__ __forceinline__ unsigned xb_ld(unsigned* p)              { return __hip_atomic_load(p, __ATOMIC_RELAXED, __HIP_MEMORY_SCOPE_AGENT); }
__device__ __forceinline__ unsigned xb_add(unsigned* p, unsigned v) { return __hip_atomic_fetch_add(p, v, __ATOMIC_RELAXED, __HIP_MEMORY_SCOPE_AGENT); }
__device__ __forceinline__ unsigned xb_xcc_id() { return (unsigned)__builtin_amdgcn_s_getreg((3 << 11) | 20) & 0xFu; }
#define XB_SPIN(cond, bar) do { unsigned _sp = 0; while (cond) { __builtin_amdgcn_s_sleep(1); \
    if ((++_sp & 255u) == 0u) { if (xb_ld(&(bar)[XB_TMO])) break; if (_sp > XB_SPIN_CAP) { atomicAdd(&(bar)[XB_TMO], 1u); break; } } } } while (0)
struct XcdBarrier { unsigned* bar; unsigned x; volatile LAS unsigned* st; };
__device__ __forceinline__ XcdBarrier xcd_barrier_post(unsigned* bar, volatile LAS unsigned* st) {
    XcdBarrier b; b.bar = bar; b.x = xb_xcc_id(); b.st = st;
    if (threadIdx.x == 0) (void)xb_add(&bar[XB_XCNT(b.x)], 1u);
    return b;
}
__device__ __forceinline__ void xcd_barrier_complete(unsigned* bar, unsigned x, unsigned& nloc, unsigned& nx) {
    const unsigned G = gridDim.x * gridDim.y * gridDim.z;
    unsigned sum, cnt, mine, sp = 0u;
    for (;;) {
        sum = 0u; cnt = 0u; mine = 0u;
#pragma unroll
        for (unsigned j = 0; j < 16; ++j) { const unsigned c = xb_ld(&bar[XB_XCNT(j)]); sum += c; cnt += (c > 0u) ? 1u : 0u; mine = (j == x) ? c : mine; }
        if (sum == G) break;
        __builtin_amdgcn_s_sleep(1);
        if ((++sp & 255u) == 0u) { if (xb_ld(&bar[XB_TMO])) break; if (sp > XB_SPIN_CAP) { atomicAdd(&bar[XB_TMO], 1u); break; } }
    }
    nloc = mine > 0u ? mine : 1u; nx = cnt > 0u ? cnt : 1u;
}
__device__ __forceinline__ void xcd_barrier(const XcdBarrier& b) {
    asm volatile("s_waitcnt vmcnt(0)" ::: "memory");
    __syncthreads();
    if (threadIdx.x == 0) {
        unsigned* bar = b.bar;
        __builtin_amdgcn_s_waitcnt(0);
        unsigned nloc = b.st[0], nx = b.st[1];
        if (nloc == 0u) { xcd_barrier_complete(bar, b.x, nloc, nx); b.st[0] = nloc; b.st[1] = nx; }
        const unsigned old = xb_add(&bar[XB_XSUB(b.x)], 1u);
        const unsigned gen = old / nloc;
        if (old + 1u == (gen + 1u) * nloc) {
            __builtin_amdgcn_fence(__ATOMIC_RELEASE, "agent");
            asm volatile("s_waitcnt vmcnt(0)" ::: "memory");
            const unsigned og = xb_add(&bar[XB_TOP], 1u);
            const unsigned tg = og / nx;
            if (og + 1u == (tg + 1u) * nx) xb_add(&bar[XB_TOPGEN], 1u);
            else XB_SPIN(xb_ld(&bar[XB_TOPGEN]) == tg, bar);
            __builtin_amdgcn_fence(__ATOMIC_ACQUIRE, "agent");
            xb_add(&bar[XB_XGEN(b.x)], 1u);
            asm volatile("s_waitcnt vmcnt(0)" ::: "memory");
        } else {
            XB_SPIN(xb_ld(&bar[XB_XGEN(b.x)]) == gen, bar);
            __builtin_amdgcn_fence(__ATOMIC_ACQUIRE, "agent");
            asm volatile("s_waitcnt vmcnt(0)" ::: "memory");
        }
    }
    __syncthreads();
}

struct TJob { const float* W; unsigned long long dst; int K, N, row_off, first; };
constexpr int NTJOB = 15;
struct Args {
    const float* in[34];
    float* out;
    unsigned char* ws;
    TJob tj[NTJOB];
    int tj_total;
    int ph_lo, ph_hi, pad;
};
enum { I_XP = 0, I_XS, I_C0CKV, I_C0KR, I_C1K, I_C1V, I_C, I_CCTX, I_ADAW, I_ADAB, I_LN1G, I_LN1B, I_LN2G, I_LN2B,
       I_WDQ, I_QNORM, I_WUQ, I_WDKV, I_KVNORM, I_WUK, I_WUV, I_WO0, I_WQKV, I_SINK, I_WO1, I_WF, I_WIN, I_CONVW, I_CONVB, I_WCO,
       I_WPQ, I_SUBK, I_PEERU, I_PEERV };

struct GemmP {
    const bf16* A; const bf16* B;
    long lda, ldb;
    long sA1, sA2, sA3, sB1, sB2, sB3;
    int M, N, K, nb1, nb2, nb3;
};
constexpr int SG_LDT = 72;
constexpr int SG_TILE = 128 * SG_LDT * 2;
template <class Epi>
__device__ __forceinline__ void sg_gemm(LAS unsigned char* lds, const GemmP g, const Epi& E, int bid, int nblk, int& ubase) {
    const int tid = threadIdx.x, lane = tid & 63, wave = __builtin_amdgcn_readfirstlane(tid >> 6);
    const int wm = wave >> 2, wn = wave & 3, fr = lane & 15, fq = lane >> 4;
    const int tiles_m = (g.M + 127) >> 7, tiles_n = (g.N + 127) >> 7;
    const int nbatch = g.nb1 * g.nb2 * g.nb3;
    const int U = nbatch * tiles_m * tiles_n;
    const int nk = g.K >> 6;
    int first = (bid - (ubase % nblk) + nblk) % nblk;
    ubase += U;
    const int lrow0 = tid >> 3, lkc = tid & 7;
    const int aoff = (wm * 64 + fr) * (SG_LDT * 2) + fq * 16;
    const int boff = (wn * 32 + fr) * (SG_LDT * 2) + fq * 16;
    for (int u = first; u < U; u += nblk) {
        const int tn = u % tiles_n; const int r1 = u / tiles_n; const int tm = r1 % tiles_m; const int b = r1 / tiles_m;
        const int b3 = b % g.nb3, b12 = b / g.nb3, b2 = b12 % g.nb2, b1 = b12 / g.nb2;
        const int m0 = tm << 7, n0 = tn << 7;
        const bf16* Ab = g.A + b1 * g.sA1 + b2 * g.sA2 + b3 * g.sA3;
        const bf16* Bb = g.B + b1 * g.sB1 + b2 * g.sB2 + b3 * g.sB3;
        int ar0 = m0 + lrow0, ar1 = ar0 + 64; ar0 = ar0 < g.M ? ar0 : g.M - 1; ar1 = ar1 < g.M ? ar1 : g.M - 1;
        int br0 = n0 + lrow0, br1 = br0 + 64; br0 = br0 < g.N ? br0 : g.N - 1; br1 = br1 < g.N ? br1 : g.N - 1;
        const bf16* pa0 = Ab + (long)ar0 * g.lda + lkc * 8; const bf16* pa1 = Ab + (long)ar1 * g.lda + lkc * 8;
        const bf16* pb0 = Bb + (long)br0 * g.ldb + lkc * 8; const bf16* pb1 = Bb + (long)br1 * g.ldb + lkc * 8;
        f32x4 acc[4][2];
#pragma unroll
        for (int i = 0; i < 4; ++i) { acc[i][0] = (f32x4){0.f, 0.f, 0.f, 0.f}; acc[i][1] = (f32x4){0.f, 0.f, 0.f, 0.f}; }
        u32x4 ra0 = *(const u32x4*)pa0, ra1 = *(const u32x4*)pa1, rb0 = *(const u32x4*)pb0, rb1 = *(const u32x4*)pb1;
        const int wofs = lrow0 * (SG_LDT * 2) + lkc * 16;
        *(LAS u32x4*)(lds + wofs) = ra0; *(LAS u32x4*)(lds + wofs + 64 * SG_LDT * 2) = ra1;
        *(LAS u32x4*)(lds + SG_TILE + wofs) = rb0; *(LAS u32x4*)(lds + SG_TILE + wofs + 64 * SG_LDT * 2) = rb1;
        __syncthreads();
        for (int kt = 0; kt < nk; ++kt) {
            const int cur = (kt & 1) * 2 * SG_TILE, nxt = ((kt + 1) & 1) * 2 * SG_TILE;
            const bool more = (kt + 1 < nk);
            if (more) { const int ko = (kt + 1) << 6; ra0 = *(const u32x4*)(pa0 + ko); ra1 = *(const u32x4*)(pa1 + ko); rb0 = *(const u32x4*)(pb0 + ko); rb1 = *(const u32x4*)(pb1 + ko); }
#pragma unroll
            for (int ks = 0; ks < 2; ++ks) {
                bf16x8 af[4], bfr[2];
#pragma unroll
                for (int i = 0; i < 4; ++i) af[i] = *(const LAS bf16x8*)(lds + cur + aoff + i * 16 * SG_LDT * 2 + ks * 64);
#pragma unroll
                for (int j = 0; j < 2; ++j) bfr[j] = *(const LAS bf16x8*)(lds + cur + SG_TILE + boff + j * 16 * SG_LDT * 2 + ks * 64);
#pragma unroll
                for (int i = 0; i < 4; ++i)
#pragma unroll
                    for (int j = 0; j < 2; ++j) acc[i][j] = __builtin_amdgcn_mfma_f32_16x16x32_bf16(bfr[j], af[i], acc[i][j], 0, 0, 0);
            }
            if (more) {
                *(LAS u32x4*)(lds + nxt + wofs) = ra0; *(LAS u32x4*)(lds + nxt + wofs + 64 * SG_LDT * 2) = ra1;
                *(LAS u32x4*)(lds + nxt + SG_TILE + wofs) = rb0; *(LAS u32x4*)(lds + nxt + SG_TILE + wofs + 64 * SG_LDT * 2) = rb1;
            }
            __syncthreads();
        }
        const int nn = n0 + wn * 32 + 4 * fq;
        if (n0 + wn * 32 < g.N) {
#pragma unroll
            for (int i = 0; i < 4; ++i) { const int m = m0 + wm * 64 + i * 16 + fr; if (m < g.M) E(b1, b2, b3, m, nn, acc[i][0], acc[i][1]); }
        }
    }
}

namespace pg8 {
constexpr int BM = 256, BK = 64, HALF = 128, HTB = HALF * BK * 2, STAGE_BYTES = 8 * HTB, WGM = 8;
__device__ __forceinline__ int lds_byte(int r, int c) { const int st = (r >> 4) * 2 + (c >> 5), rr = r & 15, cc = c & 31, ob = rr * 64 + cc * 2; return st * 1024 + (ob ^ (((ob >> 9) & 1) << 5)); }
__device__ __forceinline__ void stage_rc(int b, int& R, int& C) { const int st = b / 1024, sb = b % 1024, swz = sb ^ (((sb >> 9) & 1) << 5); R = (st >> 1) * 16 + swz / 64; C = (st & 1) * 32 + (swz % 64) / 2; }
struct Unit { const char* a; const char* b; int pm, pn, b1, b2, b3; };
template <class Epi>
__device__ __forceinline__ void gemm_phase(LAS unsigned char* lds, const GemmP g, const Epi& E, int bid, int nblk, int& ubase) {
    const int tid = threadIdx.x, wid = __builtin_amdgcn_readfirstlane(tid >> 6), lane = tid & 63, wr = wid >> 2, wc = wid & 3, fr = lane & 15, fq = lane >> 4;
    const int nt = g.K / BK;
    const int nM = g.M / BM, nN = g.N / BM, nwg = nM * nN, U = g.nb1 * g.nb2 * g.nb3 * nwg;
    const int cidx = (bid - (ubase % nblk) + nblk) % nblk; ubase += U;
    auto next = [&](int i, Unit& u) -> bool {
        const long Lq = (long)i * nblk + cidx; if (Lq >= U) return false;
        const int b = (int)(Lq / nwg), w = (int)(Lq % nwg);
        const int nig = WGM * nN, gid = w / nig, fm = gid * WGM, gsz = (nM - fm) < WGM ? (nM - fm) : WGM;
        u.pm = fm + ((w % nig) % gsz); u.pn = (w % nig) / gsz;
        u.b3 = b % g.nb3; const int b12 = b / g.nb3; u.b2 = b12 % g.nb2; u.b1 = b12 / g.nb2;
        u.a = (const char*)(g.A + u.b1 * g.sA1 + u.b2 * g.sA2 + u.b3 * g.sA3 + (long)u.pm * BM * g.lda);
        u.b = (const char*)(g.B + u.b1 * g.sB1 + u.b2 * g.sB2 + u.b3 * g.sB3 + (long)u.pn * BM * g.ldb);
        return true; };
    unsigned voffA[2], voffB[2];
#pragma unroll
    for (int i = 0; i < 2; ++i) { int R, C; stage_rc(tid * 16 + i * 8192, R, C); voffA[i] = (unsigned)(R * (int)g.lda + C) * 2u; voffB[i] = (unsigned)(R * (int)g.ldb + C) * 2u; }
    const size_t kstep = (size_t)(BK * 2);
    const size_t hstepA = (size_t)HALF * g.lda * 2, hstepB = (size_t)HALF * g.ldb * 2;
    const unsigned ldsw = (unsigned)wid * 1024u;
    const int aoff = lds_byte(wr * 64 + fr, fq * 8), boff = lds_byte(wc * 32 + fr, fq * 8);
#define PG8_SA(b, h) (((b) * 2 + (h)) * HTB)
#define PG8_SB(b, h) ((4 + (b) * 2 + (h)) * HTB)
#define PG8_STAGE(bufoff, gbase, voff) do { _Pragma("unroll") for (int _i = 0; _i < 2; ++_i) \
        __builtin_amdgcn_global_load_lds((const unsigned*)((const char*)(gbase) + (voff)[_i]), (LAS unsigned*)(lds + (bufoff) + ldsw + _i * 8192), 16, 0, 0); } while (0)
#define PG8_LDA(dst, b, h) do { _Pragma("unroll") for (int m = 0; m < 4; ++m) _Pragma("unroll") for (int k = 0; k < 2; ++k) dst[m][k] = *(const LAS bf16x8*)(lds + PG8_SA(b, h) + aoff + m * 2048 + k * 1024); } while (0)
#define PG8_LDB(dst, b, h) do { _Pragma("unroll") for (int n = 0; n < 2; ++n) _Pragma("unroll") for (int k = 0; k < 2; ++k) dst[n][k] = *(const LAS bf16x8*)(lds + PG8_SB(b, h) + boff + n * 2048 + k * 1024); } while (0)
#define PG8_MMA(ai, bj, At, Bt) do { __builtin_amdgcn_s_setprio(1); _Pragma("unroll") for (int m = 0; m < 4; ++m) _Pragma("unroll") for (int n = 0; n < 2; ++n) _Pragma("unroll") for (int k = 0; k < 2; ++k) \
        acc[ai][bj][m][n] = __builtin_amdgcn_mfma_f32_16x16x32_bf16(Bt[n][k], At[m][k], acc[ai][bj][m][n], 0, 0, 0); __builtin_amdgcn_s_setprio(0); } while (0)
#define PG8_WAIT_V(n) asm volatile("s_waitcnt vmcnt(" #n ")" ::: "memory")
#define PG8_WAIT_L(n) asm volatile("s_waitcnt lgkmcnt(" #n ")" ::: "memory")
#define PG8_BAR __builtin_amdgcn_s_barrier()
#define PG8_SCHED __builtin_amdgcn_sched_barrier(0)
    Unit cur, nxt; int ui = 0;
    if (!next(0, cur)) return;
    f32x4 acc[2][2][4][2];
#pragma unroll
    for (int a = 0; a < 2; ++a)
#pragma unroll
        for (int b = 0; b < 2; ++b)
#pragma unroll
            for (int m = 0; m < 4; ++m)
#pragma unroll
                for (int n = 0; n < 2; ++n) acc[a][b][m][n] = (f32x4){0.f, 0.f, 0.f, 0.f};
    bf16x8 At[4][2], B0[2][2], B1[2][2];
    const char* cA = cur.a; const char* cB = cur.b;
    PG8_STAGE(PG8_SB(0, 0), cB, voffB); PG8_STAGE(PG8_SA(0, 0), cA, voffA); PG8_STAGE(PG8_SB(0, 1), cB + hstepB, voffB); PG8_STAGE(PG8_SA(0, 1), cA + hstepA, voffA);
    if (wr == 1) PG8_BAR;
    PG8_WAIT_V(4); PG8_BAR;
    PG8_STAGE(PG8_SB(1, 0), cB + kstep, voffB); PG8_STAGE(PG8_SA(1, 0), cA + kstep, voffA); PG8_STAGE(PG8_SB(1, 1), cB + hstepB + kstep, voffB);
    PG8_WAIT_V(6); PG8_BAR;
    for (;;) {
        const bool has_next = next(ui + 1, nxt);
        const char* nA = has_next ? nxt.a : cA; const char* nB = has_next ? nxt.b : cB;
        for (int t = 0; t < nt; t += 2) {
            const bool last = (t == nt - 2);
            const char* a1 = cA + (size_t)(t + 1) * kstep;
            const char* a2 = last ? nA : cA + (size_t)(t + 2) * kstep; const char* b2 = last ? nB : cB + (size_t)(t + 2) * kstep;
            const char* a3 = a2 + kstep; const char* b3 = b2 + kstep;
            PG8_LDB(B0, 0, 0); PG8_SCHED; PG8_LDA(At, 0, 0); PG8_STAGE(PG8_SA(1, 1), a1 + hstepA, voffA);
            PG8_WAIT_L(8); PG8_BAR; PG8_WAIT_L(0); PG8_MMA(0, 0, At, B0); PG8_BAR; PG8_SCHED;
            PG8_LDB(B1, 0, 1); PG8_STAGE(PG8_SB(0, 0), b2, voffB);
            PG8_BAR; PG8_WAIT_L(0); PG8_MMA(0, 1, At, B1); PG8_BAR;
            PG8_LDA(At, 0, 1); PG8_STAGE(PG8_SA(0, 0), a2, voffA);
            PG8_BAR; PG8_WAIT_L(0); PG8_MMA(1, 0, At, B0); PG8_BAR; PG8_SCHED;
            PG8_STAGE(PG8_SB(0, 1), b2 + hstepB, voffB);
            PG8_WAIT_V(6); PG8_BAR; PG8_MMA(1, 1, At, B1); PG8_BAR;
            PG8_LDB(B0, 1, 0); PG8_SCHED; PG8_LDA(At, 1, 0); PG8_STAGE(PG8_SA(0, 1), a2 + hstepA, voffA);
            PG8_WAIT_L(8); PG8_BAR; PG8_WAIT_L(0); PG8_MMA(0, 0, At, B0); PG8_BAR; PG8_SCHED;
            PG8_LDB(B1, 1, 1); PG8_STAGE(PG8_SB(1, 0), b3, voffB);
            PG8_BAR; PG8_WAIT_L(0); PG8_MMA(0, 1, At, B1); PG8_BAR;
            PG8_LDA(At, 1, 1); PG8_STAGE(PG8_SA(1, 0), a3, voffA);
            PG8_BAR; PG8_WAIT_L(0); PG8_MMA(1, 0, At, B0); PG8_BAR; PG8_SCHED;
            PG8_STAGE(PG8_SB(1, 1), b3 + hstepB, voffB);
            PG8_WAIT_V(6); PG8_BAR; PG8_MMA(1, 1, At, B1); PG8_BAR;
        }
#pragma unroll
        for (int ai = 0; ai < 2; ++ai)
#pragma unroll
            for (int mm = 0; mm < 4; ++mm) { const int row = cur.pm * BM + ai * HALF + wr * 64 + mm * 16 + fr;
#pragma unroll
                for (int bj = 0; bj < 2; ++bj) E(cur.b1, cur.b2, cur.b3, row, cur.pn * BM + bj * HALF + wc * 32 + 4 * fq, acc[ai][bj][mm][0], acc[ai][bj][mm][1]); }
        if (!has_next) break;
#pragma unroll
        for (int a = 0; a < 2; ++a)
#pragma unroll
            for (int b = 0; b < 2; ++b)
#pragma unroll
                for (int m = 0; m < 4; ++m)
#pragma unroll
                    for (int n = 0; n < 2; ++n) acc[a][b][m][n] = (f32x4){0.f, 0.f, 0.f, 0.f};
        cur = nxt; cA = nA; cB = nB; ++ui;
    }
    PG8_WAIT_V(0);
    if (wr == 0) PG8_BAR;
    PG8_BAR;
#undef PG8_SA
#undef PG8_SB
#undef PG8_STAGE
#undef PG8_LDA
#undef PG8_LDB
#undef PG8_MMA
#undef PG8_WAIT_V
#undef PG8_WAIT_L
#undef PG8_BAR
#undef PG8_SCHED
}
}

struct EpiF32 { float* C; long ldc, s1, s2, s3; float scale;
    __device__ __forceinline__ void operator()(int b1, int b2, int b3, int m, int n, f32x4 v0, f32x4 v1) const {
        float* p = C + b1 * s1 + b2 * s2 + b3 * s3 + (long)m * ldc + n; *(f32x4*)p = v0 * scale; *(f32x4*)(p + 16) = v1 * scale; } };
struct EpiF32N { float* C; long ldc; int nvalid;
    __device__ __forceinline__ void operator()(int, int, int, int m, int n, f32x4 v0, f32x4 v1) const {
        if (n < nvalid) { float* p = C + (long)m * ldc + n; *(f32x4*)p = v0; *(f32x4*)(p + 16) = v1; } } };
struct EpiBf16 { bf16* C; long ldc, s1, s2, s3; float scale;
    __device__ __forceinline__ void operator()(int b1, int b2, int b3, int m, int n, f32x4 v0, f32x4 v1) const {
        bf16* p = C + b1 * s1 + b2 * s2 + b3 * s3 + (long)m * ldc + n; v0 = v0 * scale; v1 = v1 * scale;
        *(u32x2*)p = (u32x2){pk2(v0[0], v0[1]), pk2(v0[2], v0[3])}; *(u32x2*)(p + 16) = (u32x2){pk2(v1[0], v1[1]), pk2(v1[2], v1[3])}; } };
__device__ __forceinline__ void rope4(f32x4& v0, f32x4& v1, int pos, int j0, const float* tab) {
    const f32x4 cs = *(const f32x4*)(tab + pos * 16 + j0), sn = *(const f32x4*)(tab + 1024 + pos * 16 + j0);
    const f32x4 x1 = v0, x2 = v1; v0 = x1 * cs - x2 * sn; v1 = x1 * sn + x2 * cs;
}
struct EpiQMla { bf16* Q; const float* rtab;
    __device__ __forceinline__ void operator()(int, int, int, int m, int n, f32x4 v0, f32x4 v1) const {
        const int d = n % 192, d0 = d & ~31;
        if (m >= NPR && d0 >= 128) { const int t = (m - NPR) & 1023; const int pos = (d0 == 128) ? (t >> 6) : (t & 63); rope4(v0, v1, pos, d & 15, rtab); }
        bf16* p = Q + (long)m * 3072 + n;
        *(u32x2*)p = (u32x2){pk2(v0[0], v0[1]), pk2(v0[2], v0[3])}; *(u32x2*)(p + 16) = (u32x2){pk2(v1[0], v1[1]), pk2(v1[2], v1[3])}; } };
struct EpiKn { bf16* KC;
    __device__ __forceinline__ void operator()(int, int, int, int m, int n, f32x4 v0, f32x4 v1) const {
        bf16* p = KC + ((long)m * 16 + (n >> 7)) * 192 + (n & 127);
        *(u32x2*)p = (u32x2){pk2(v0[0], v0[1]), pk2(v0[2], v0[3])}; *(u32x2*)(p + 16) = (u32x2){pk2(v1[0], v1[1]), pk2(v1[2], v1[3])}; } };
struct EpiResid { float* Y; const float* X; const float* gate;
    __device__ __forceinline__ void operator()(int, int, int, int m, int n, f32x4 v0, f32x4 v1) const {
        const float* gp = gate + cond_of(m) * 12288 + n; const float* xp = X + (long)m * D + n; float* yp = Y + (long)m * D + n;
        const f32x4 g0 = *(const f32x4*)gp, g1 = *(const f32x4*)(gp + 16), x0 = *(const f32x4*)xp, x1 = *(const f32x4*)(xp + 16);
        *(f32x4*)yp = x0 * ALPHA + g0 * v0; *(f32x4*)(yp + 16) = x1 * ALPHA + g1 * v1; } };
struct EpiQkv1 { bf16* Q1; bf16* K1; bf16* VT1; float* outk; float* outv; const float* rtab;
    __device__ __forceinline__ void operator()(int, int, int, int m, int n, f32x4 v0, f32x4 v1) const {
        const int kvr = kvrow_of(m);
        if (n < 2560) {
            if (n >= 2048 && m < NPR) { float* p = outk + (long)m * 512 + (n - 2048); *(f32x4*)p = v0; *(f32x4*)(p + 16) = v1; }
            if (m >= NPR) { const int t = (m - NPR) & 1023; const int pos = ((n & 32) == 0) ? (t >> 6) : (t & 63); rope4(v0, v1, pos, n & 15, rtab); }
            bf16* p = (n < 2048) ? (Q1 + (long)m * 2048 + n) : (K1 + (long)kvr * 512 + (n - 2048));
            *(u32x2*)p = (u32x2){pk2(v0[0], v0[1]), pk2(v0[2], v0[3])}; *(u32x2*)(p + 16) = (u32x2){pk2(v1[0], v1[1]), pk2(v1[2], v1[3])};
        } else {
            const int c = n - 2560;
            if (m < NPR) { float* p = outv + (long)m * 512 + c; *(f32x4*)p = v0; *(f32x4*)(p + 16) = v1; }
#pragma unroll
            for (int i = 0; i < 4; ++i) { VT1[(long)(c + i) * KVR + kvr] = (bf16)f2bf(v0[i]); VT1[(long)(c + 16 + i) * KVR + kvr] = (bf16)f2bf(v1[i]); }
        } } };
struct EpiDft1 { bf16* YTp; bf16* YTs;
    __device__ __forceinline__ void operator()(int g, int, int, int j, int tok, f32x4 v0, f32x4 v1) const {
        const int h = j >> 9, c = j & 511;
#pragma unroll
        for (int q = 0; q < 2; ++q) { const int tk = tok + 16 * q; const f32x4 v = q ? v1 : v0; bf16* p;
            if (tk < NPR) { const int b = tk >> 8, t = tk & 255; p = YTp + ((long)(b * 2048 + g * 512 + c) * 512 + h * 256 + t); }
            else { const int s = tk - NPR, b = s >> 10, t = s & 1023; p = YTs + ((long)(b * 2048 + g * 512 + c) * 2048 + h * 1024 + t); }
            *(u32x2*)p = (u32x2){pk2(v[0], v[1]), pk2(v[2], v[3])}; } } };

template <class T> __device__ __forceinline__ T* opq(T* p) { asm volatile("" : "+s"(p)); return p; }
struct Frame {
    LAS unsigned char* lds;
    unsigned char* ws;
    int tid, lane, wave, bid, nblk, gw, ngw;
};

__device__ __forceinline__ void ln_row(const float* yrow, const float* g, const float* b, float* xrow, bf16* urow, const float* shift, const float* scale, float* orow, int lane) {
    f32x4 v[8]; float s = 0.f;
#pragma unroll
    for (int i = 0; i < 8; ++i) { v[i] = *(const f32x4*)(yrow + i * 256 + lane * 4); s += (v[i][0] + v[i][1]) + (v[i][2] + v[i][3]); }
    const float mean = wave_sum(s) * (1.f / D); float s2 = 0.f;
#pragma unroll
    for (int i = 0; i < 8; ++i) { v[i] = v[i] - mean; s2 += (v[i][0] * v[i][0] + v[i][1] * v[i][1]) + (v[i][2] * v[i][2] + v[i][3] * v[i][3]); }
    const float rstd = rsqrtf(wave_sum(s2) * (1.f / D) + LN_EPS);
#pragma unroll
    for (int i = 0; i < 8; ++i) { const int c = i * 256 + lane * 4;
        const f32x4 o = v[i] * rstd * *(const f32x4*)(g + c) + *(const f32x4*)(b + c);
        *(f32x4*)(xrow + c) = o;
        if (orow) *(f32x4*)(orow + c) = o;
        if (urow) { const f32x4 u = o * (*(const f32x4*)(scale + c) + 1.0f) + *(const f32x4*)(shift + c); *(u32x2*)(urow + c) = (u32x2){pk2(u[0], u[1]), pk2(u[2], u[3])}; } }
}

template <int NV, bool BAND>
__device__ __forceinline__ void softmax_row(float* row, int t, bool has_sink, float sink, int lane) {
    f32x4 v[NV]; float mx = -3.0e38f;
#pragma unroll
    for (int i = 0; i < NV; ++i) { v[i] = *(const f32x4*)(row + i * 256 + lane * 4);
#pragma unroll
        for (int e = 0; e < 4; ++e) { if (BAND) { const int s = i * 256 + lane * 4 + e; const int dlt = t - s; const bool ok = (s >= 1024) || (dlt <= 128 && dlt >= -128); if (!ok) v[i][e] = -3.0e38f; } mx = fmaxf(mx, v[i][e]); } }
    mx = wave_max(mx); if (has_sink) mx = fmaxf(mx, sink);
    float sum = 0.f;
#pragma unroll
    for (int i = 0; i < NV; ++i)
#pragma unroll
        for (int e = 0; e < 4; ++e) { const float p = (v[i][e] < -1.0e38f) ? 0.f : __expf(v[i][e] - mx); v[i][e] = p; sum += p; }
    sum = wave_sum(sum); if (has_sink) sum += __expf(sink - mx);
    const float inv = 1.f / sum;
    bf16* prow = (bf16*)row;
#pragma unroll
    for (int i = 0; i < NV; ++i) *(u32x2*)(prow + i * 256 + lane * 4) = (u32x2){pk2(v[i][0] * inv, v[i][1] * inv), pk2(v[i][2] * inv, v[i][3] * inv)};
}

__device__ __forceinline__ void transpose_item(const float* W, int K, int N, bf16* WT, int row_off, LAS float* scr, int item, int lane) {
    const int nblkn = N / 32, kb = item / nblkn, nb = item % nblkn, k0 = 64 * kb, n0 = 32 * nb;
#pragma unroll 8
    for (int i = 0; i < 32; ++i) { const int kk = 2 * i + (lane >> 5); scr[kk * 33 + (lane & 31)] = W[(size_t)(k0 + kk) * N + n0 + (lane & 31)]; }
    LDS_WAIT();
    const int c = lane & 7;
#pragma unroll
    for (int j = 0; j < 4; ++j) { const int n = (lane >> 3) + 8 * j; const LAS float* s = scr + (8 * c) * 33 + n;
        u32x4 o; o.x = pk2(s[0 * 33], s[1 * 33]); o.y = pk2(s[2 * 33], s[3 * 33]); o.z = pk2(s[4 * 33], s[5 * 33]); o.w = pk2(s[6 * 33], s[7 * 33]);
        *(u32x4*)(WT + (size_t)(row_off + n0 + n) * K + k0 + 8 * c) = o; }
    LDS_WAIT();
}

__device__ __forceinline__ int cflat(int l) {
    int a = 0, base = 0;
    if (l >= 16) { a = 1; base = 16; } if (l >= 24) { a = 2; base = 24; } if (l >= 29) { a = 3; base = 29; } if (l >= 33) { a = 4; base = 33; }
    if (l >= 36) { a = 5; base = 36; } if (l >= 38) { a = 6; base = 38; } if (l >= 40) { a = 7; base = 40; } if (l >= 42) { a = 8 + (l - 42); base = l; }
    return l < 50 ? a * 16 + (l - base) : 9999;
}
#if !MK_PER_PHASE
#define SYNC() xcd_barrier(bar)
#else
#define SYNC() do {} while (0)
#endif
#define PH_BEGIN unsigned char* ws = opq(ws_)
#define IP(i) opq(args.in[i])
#define MODS ((float*)(ws + WS_MODS))
#define ROPET ((float*)(ws + WS_MODS + 640 * 1024))
#define X ((float*)(ws + WS_X))
#define Y ((float*)(ws + WS_Y))
#define Ub ((bf16*)(ws + WS_U))
#define Ob ((bf16*)(ws + WS_O))
#define SCR (ws + WS_SCR)
#define IN(k) (lo <= (k) && (k) < hi)
#define ENDPH(k) do { if (hi > (k) + 1) SYNC(); } while (0)
template <int L>
__device__ __forceinline__ void layer_phases(const Args& args, const Frame& F, unsigned char* const ws_, const int lo, const int hi, const XcdBarrier& bar) {
    int ub;
        const int P = 2 + L * 16;
#define modL (MODS + L * 3 * 12288)
        if constexpr (L == 0) {
#define T0 ((float*)SCR)
#define QN ((bf16*)(ws + WS_QN))
#define CKV ((bf16*)(ws + WS_CKV))
#define Qb ((bf16*)(ws + WS_Q))
#define KC ((bf16*)(ws + WS_KC))
#define VT ((bf16*)(ws + WS_VT))
#define SCp ((float*)SCR)
#define SCs ((float*)(SCR + 64 * MiB))
            if (IN(P + 0)) { PH_BEGIN;
                ub = 0; GemmP g{Ub, (const bf16*)(ws + WS_W0T), D, D, 0, 0, 0, 0, 0, 0, MT, 1280, D, 1, 1, 1};
                pg8::gemm_phase(F.lds, g, EpiF32N{T0, 1088, 1088}, F.bid, F.nblk, ub);
                ENDPH(P + 0);
            }
            if (IN(P + 1)) { PH_BEGIN;
                const float* qg = IP(I_QNORM); const float* kg = IP(I_KVNORM);
                for (int m = F.gw; m < MT; m += F.ngw) {
                    const float* tr = T0 + (size_t)m * 1088; const int kvr = kvrow_of(m); const int c = F.lane * 8;
                    { f32x4 a = *(const f32x4*)(tr + c), b = *(const f32x4*)(tr + c + 4);
                      float ss = (a[0] * a[0] + a[1] * a[1]) + (a[2] * a[2] + a[3] * a[3]) + (b[0] * b[0] + b[1] * b[1]) + (b[2] * b[2] + b[3] * b[3]);
                      const float r = rsqrtf(wave_sum(ss) * (1.f / 512.f) + RMS_EPS);
                      a = a * r * *(const f32x4*)(qg + c); b = b * r * *(const f32x4*)(qg + c + 4);
                      *(u32x4*)(QN + (size_t)m * 512 + c) = (u32x4){pk2(a[0], a[1]), pk2(a[2], a[3]), pk2(b[0], b[1]), pk2(b[2], b[3])}; }
                    { f32x4 a = *(const f32x4*)(tr + 512 + c), b = *(const f32x4*)(tr + 512 + c + 4);
                      float ss = (a[0] * a[0] + a[1] * a[1]) + (a[2] * a[2] + a[3] * a[3]) + (b[0] * b[0] + b[1] * b[1]) + (b[2] * b[2] + b[3] * b[3]);
                      const float r = rsqrtf(wave_sum(ss) * (1.f / 512.f) + RMS_EPS);
                      a = a * r * *(const f32x4*)(kg + c); b = b * r * *(const f32x4*)(kg + c + 4);
                      *(u32x4*)(CKV + (size_t)kvr * 512 + c) = (u32x4){pk2(a[0], a[1]), pk2(a[2], a[3]), pk2(b[0], b[1]), pk2(b[2], b[3])};
                      if (m < NPR) { float* o = args.out + OUT_CKV + (size_t)m * 512 + c; *(f32x4*)o = a; *(f32x4*)(o + 4) = b; } }
                    { float x = tr[1024 + F.lane];
                      if (m < NPR) args.out[OUT_KR + (size_t)m * 64 + F.lane] = x;
                      else { const int t = (m - NPR) & 1023, e = F.lane, j = e & 15; const int pos = (e < 32) ? (t >> 6) : (t & 63);
                          const float cs = ROPET[pos * 16 + j], sn = ROPET[1024 + pos * 16 + j];
                          const float pr = __shfl_xor(x, 16); x = ((e & 16) == 0) ? (x * cs - pr * sn) : (pr * sn + x * cs); }
                      const bf16 xb = (bf16)f2bf(x);
#pragma unroll
                      for (int h = 0; h < 16; ++h) KC[((size_t)kvr * 16 + h) * 192 + 128 + F.lane] = xb; }
                }
                ENDPH(P + 1);
            }
            if (IN(P + 2)) { PH_BEGIN;
                ub = 0; GemmP g{QN, (const bf16*)(ws + WS_WUQT), 512, 512, 0, 0, 0, 0, 0, 0, MT, 3072, 512, 1, 1, 1};
                pg8::gemm_phase(F.lds, g, EpiQMla{Qb, ROPET}, F.bid, F.nblk, ub);
                GemmP g2{CKV, (const bf16*)(ws + WS_WUKT), 512, 512, 0, 0, 0, 0, 0, 0, KVR, 2048, 512, 1, 1, 1};
                pg8::gemm_phase(F.lds, g2, EpiKn{KC}, F.bid, F.nblk, ub);
                GemmP g3{(const bf16*)(ws + WS_WUVT), CKV, 512, 512, 0, 0, 0, 0, 0, 0, 2048, KVR, 512, 1, 1, 1};
                pg8::gemm_phase(F.lds, g3, EpiBf16{VT, KVR, 0, 0, 0, 1.f}, F.bid, F.nblk, ub);
                ENDPH(P + 2);
            }
            if (IN(P + 3)) { PH_BEGIN;
                ub = 0;
                GemmP gp{Qb, KC, 3072, 3072, 256L * 3072, 192, 0, 256L * 3072, 192, 0, 256, 256, 192, 16, 16, 1};
                sg_gemm(F.lds, gp, EpiF32{SCp, 256, 16L * 256 * 256, 256L * 256, 0, MLA_SCALE}, F.bid, F.nblk, ub);
                GemmP gs{Qb + (size_t)NPR * 3072, KC + (size_t)NPR * 3072, 3072, 3072, 1024L * 3072, 192, 0, 1280L * 3072, 192, 0, 1024, 1280, 192, 2, 16, 1};
                sg_gemm(F.lds, gs, EpiF32{SCs, 1280, 16L * 1024 * 1280, 1024L * 1280, 0, MLA_SCALE}, F.bid, F.nblk, ub);
                ENDPH(P + 3);
            }
            if (IN(P + 4)) { PH_BEGIN;
                for (int r = F.gw; r < 16 * 16 * 256; r += F.ngw) softmax_row<1, false>(SCp + (size_t)r * 256, 0, false, 0.f, F.lane);
                for (int r = F.gw; r < 2 * 16 * 1024; r += F.ngw) softmax_row<5, false>(SCs + (size_t)r * 1280, 0, false, 0.f, F.lane);
                ENDPH(P + 4);
            }
            if (IN(P + 5)) { PH_BEGIN;
                ub = 0;
                GemmP gp{(const bf16*)SCp, VT, 512, KVR, 16L * 256 * 512, 256L * 512, 0, 256, 128L * KVR, 0, 256, 128, 256, 16, 16, 1};
                sg_gemm(F.lds, gp, EpiBf16{Ob, D, 256L * D, 128, 0, 1.f}, F.bid, F.nblk, ub);
                GemmP gs{(const bf16*)SCs, VT + NPR, 2560, KVR, 16L * 1024 * 2560, 1024L * 2560, 0, 1280, 128L * KVR, 0, 1024, 128, 1280, 2, 16, 1};
                sg_gemm(F.lds, gs, EpiBf16{Ob + (size_t)NPR * D, D, 1024L * D, 128, 0, 1.f}, F.bid, F.nblk, ub);
                ENDPH(P + 5);
            }
        } else if constexpr (L == 1) {
#undef SCs
#define SCs ((float*)(SCR + 128 * MiB))
#define Q1 ((bf16*)(ws + WS_Q))
#define K1 ((bf16*)(ws + WS_KC))
#define VT1 ((bf16*)(ws + WS_VT))
            if (IN(P + 0)) { PH_BEGIN;
                const int gt = F.bid * NTHR + F.tid, ngt = F.nblk * NTHR;
                { const float* c1 = IP(I_C1K);
                  for (int i = gt; i < 2 * 256 * 512; i += ngt) { const int b = i >> 17, r = i & 131071; K1[(size_t)(NPR + b * 1280 + 1024) * 512 + r] = (bf16)f2bf(c1[i]); } }
                { const float* c1 = IP(I_C1V);
                  for (int i = gt; i < 2 * 256 * 512; i += ngt) { const int b = i >> 17, s = (i >> 9) & 255, c = i & 511; VT1[(size_t)c * KVR + NPR + b * 1280 + 1024 + s] = (bf16)f2bf(c1[i]); } }
                ub = 0; GemmP g{Ub, (const bf16*)(ws + WS_WQKVT), D, D, 0, 0, 0, 0, 0, 0, MT, 3072, D, 1, 1, 1};
                pg8::gemm_phase(F.lds, g, EpiQkv1{Q1, K1, VT1, args.out + OUT_K1, args.out + OUT_V1, ROPET}, F.bid, F.nblk, ub);
                ENDPH(P + 0);
            }
            if (IN(P + 3)) { PH_BEGIN;
                ub = 0;
                GemmP gp{Q1, K1, D, 512, 256L * D, 256, 64, 256L * 512, 64, 0, 256, 256, 64, 16, 8, 4};
                sg_gemm(F.lds, gp, EpiF32{SCp, 256, 32L * 256 * 256, 4L * 256 * 256, 256L * 256, GQA_SCALE}, F.bid, F.nblk, ub);
                GemmP gs{Q1 + (size_t)NPR * D, K1 + (size_t)NPR * 512, D, 512, 1024L * D, 256, 64, 1280L * 512, 64, 0, 1024, 1280, 64, 2, 8, 4};
                sg_gemm(F.lds, gs, EpiF32{SCs, 1280, 32L * 1024 * 1280, 4L * 1024 * 1280, 1024L * 1280, GQA_SCALE}, F.bid, F.nblk, ub);
                ENDPH(P + 3);
            }
            if (IN(P + 4)) { PH_BEGIN;
                const float* sink = IP(I_SINK);
                for (int r = F.gw; r < 16 * 32 * 256; r += F.ngw) softmax_row<1, false>(SCp + (size_t)r * 256, 0, true, sink[(r >> 8) & 31], F.lane);
                for (int r = F.gw; r < 2 * 32 * 1024; r += F.ngw) softmax_row<5, true>(SCs + (size_t)r * 1280, r & 1023, true, sink[(r >> 10) & 31], F.lane);
                ENDPH(P + 4);
            }
            if (IN(P + 5)) { PH_BEGIN;
                ub = 0;
                GemmP gp{(const bf16*)SCp, VT1, 512, KVR, 32L * 256 * 512, 4L * 256 * 512, 256L * 512, 256, 64L * KVR, 0, 256, 64, 256, 16, 8, 4};
                sg_gemm(F.lds, gp, EpiBf16{Ob, D, 256L * D, 256, 64, 1.f}, F.bid, F.nblk, ub);
                GemmP gs{(const bf16*)SCs, VT1 + NPR, 2560, KVR, 32L * 1024 * 2560, 4L * 1024 * 2560, 1024L * 2560, 1280, 64L * KVR, 0, 1024, 64, 1280, 2, 8, 4};
                sg_gemm(F.lds, gs, EpiBf16{Ob + (size_t)NPR * D, D, 1024L * D, 256, 64, 1.f}, F.bid, F.nblk, ub);
                ENDPH(P + 5);
            }
        } else if constexpr (L == 2) {
#define YTp ((bf16*)SCR)
#define YTs ((bf16*)(SCR + 32 * MiB))
            if (IN(P + 0)) { PH_BEGIN;
                ub = 0; GemmP g{(const bf16*)(ws + WS_CS512), Ub, 512, D, 0, 0, 0, 512, 0, 0, 1024, MT, 512, 4, 1, 1};
                pg8::gemm_phase(F.lds, g, EpiDft1{YTp, YTs}, F.bid, F.nblk, ub);
                ENDPH(P + 0);
            }
            if (IN(P + 5)) { PH_BEGIN;
                ub = 0;
                GemmP gp{(const bf16*)(ws + WS_CT256), YTp, 512, 512, 0, 0, 0, 2048L * 512, 0, 0, 256, 2048, 512, 16, 1, 1};
                pg8::gemm_phase(F.lds, gp, EpiBf16{Ob, D, 256L * D, 0, 0, 0.0027621358640099515f}, F.bid, F.nblk, ub);
                GemmP gs{(const bf16*)(ws + WS_CT1024), YTs, 2048, 2048, 0, 0, 0, 2048L * 2048, 0, 0, 1024, 2048, 2048, 2, 1, 1};
                pg8::gemm_phase(F.lds, gs, EpiBf16{Ob + (size_t)NPR * D, D, 1024L * D, 0, 0, 0.0013810679320049757f}, F.bid, F.nblk, ub);
                ENDPH(P + 5);
            }
        } else {
#define BCH ((bf16*)SCR)
            if (IN(P + 0)) { PH_BEGIN;
                ub = 0; GemmP g{Ub, (const bf16*)(ws + WS_WINT), D, D, 0, 0, 0, 0, 0, 0, MT, 6144, D, 1, 1, 1};
                pg8::gemm_phase(F.lds, g, EpiBf16{BCH, 6144, 0, 0, 0, 1.f}, F.bid, F.nblk, ub);
                ENDPH(P + 0);
            }
            if (IN(P + 5)) { PH_BEGIN;
                const float* cw = IP(I_CONVW); const float* cb = IP(I_CONVB);
                for (int m = F.gw; m < MT; m += F.ngw) {
                    const int t = (m < NPR) ? (m & 255) : ((m - NPR) & 1023); const int T = (m < NPR) ? 256 : 1024;
                    const bool hasp = t > 0, hasn = t < T - 1;
#pragma unroll
                    for (int i = 0; i < 4; ++i) { const int c = i * 512 + F.lane * 8; const bf16* r0 = BCH + (size_t)m * 6144 + c;
                        const u32x4 bb = *(const u32x4*)r0, cc = *(const u32x4*)(r0 + 2048), hh = *(const u32x4*)(r0 + 4096);
                        u32x4 cp = {0u, 0u, 0u, 0u}, hp = cp, cn = cp, hn = cp;
                        if (hasp) { cp = *(const u32x4*)(r0 - 6144 + 2048); hp = *(const u32x4*)(r0 - 6144 + 4096); }
                        if (hasn) { cn = *(const u32x4*)(r0 + 6144 + 2048); hn = *(const u32x4*)(r0 + 6144 + 4096); }
                        unsigned o[4];
#pragma unroll
                        for (int q = 0; q < 4; ++q) { const int d = c + 2 * q;
                            const float z0l = bflo(cp[q]) * bflo(hp[q]), z0h = bfhi(cp[q]) * bfhi(hp[q]);
                            const float z1l = bflo(cc[q]) * bflo(hh[q]), z1h = bfhi(cc[q]) * bfhi(hh[q]);
                            const float z2l = bflo(cn[q]) * bflo(hn[q]), z2h = bfhi(cn[q]) * bfhi(hn[q]);
                            const float yl = bflo(bb[q]) * (cw[d] * z0l + cw[D + d] * z1l + cw[2 * D + d] * z2l + cb[d]);
                            const float yh = bfhi(bb[q]) * (cw[d + 1] * z0h + cw[D + d + 1] * z1h + cw[2 * D + d + 1] * z2h + cb[d + 1]);
                            o[q] = pk2(yl, yh); }
                        *(u32x4*)(Ob + (size_t)m * D + c) = (u32x4){o[0], o[1], o[2], o[3]}; }
                }
                ENDPH(P + 5);
            }
        }
        if (IN(P + 6)) { PH_BEGIN;
            const size_t wofs = (L == 0) ? WS_WOT0 : (L == 1) ? WS_WOT1 : (L == 2) ? WS_WFT : WS_WCOT;
            ub = 0; GemmP g{Ob, (const bf16*)(ws + wofs), D, D, 0, 0, 0, 0, 0, 0, MT, D, D, 1, 1, 1};
            pg8::gemm_phase(F.lds, g, EpiResid{Y, X, modL + 2 * D}, F.bid, F.nblk, ub);
            ENDPH(P + 6);
        }
        if (IN(P + 7)) { PH_BEGIN;
            const float* g1 = IP(I_LN1G) + L * D; const float* b1 = IP(I_LN1B) + L * D;
            for (int m = F.gw; m < MT; m += F.ngw) { const float* md = modL + cond_of(m) * 12288;
                ln_row(Y + (size_t)m * D, g1, b1, X + (size_t)m * D, Ub + (size_t)m * D, md + 3 * D, md + 4 * D, nullptr, F.lane); }
            ENDPH(P + 7);
        }
#define PQ ((bf16*)SCR)
#define PS ((float*)(SCR + 24 * MiB))
#define PU8 ((unsigned char*)(ws + WS_PU))
#define PV8 ((unsigned char*)(ws + WS_PV))
#define SU8 ((float*)(ws + WS_PU + 32 * MiB))
#define SV8 ((float*)(ws + WS_PV + 32 * MiB))
        if (IN(P + 8)) { PH_BEGIN;
            ub = 0; GemmP g{Ub, (const bf16*)(ws + WS_WPQT) + (size_t)L * D * D, D, D, 0, 0, 0, 0, 0, 0, MT, D, D, 1, 1, 1};
            pg8::gemm_phase(F.lds, g, EpiBf16{PQ, D, 0, 0, 0, 1.f}, F.bid, F.nblk, ub);
            {
                const float* pu = IP(I_PEERU) + (size_t)L * 16384 * D; const float* pv = IP(I_PEERV) + (size_t)L * 16384 * D;
                for (int r = F.gw; r < 32768; r += F.ngw) {
                    const bool isv = r >= 16384; const int e = r & 16383;
                    const GAS float* src = (const GAS float*)((isv ? pv : pu) + (size_t)e * D) + F.lane * 16;
                    f32x4 v[2][4]; float mx = 0.f;
#pragma unroll
                    for (int j = 0; j < 2; ++j)
#pragma unroll
                        for (int k = 0; k < 4; ++k) { v[j][k] = *(const GAS f32x4*)(src + j * 1024 + k * 4);
                            mx = fmaxf(mx, fmaxf(fmaxf(fabsf(v[j][k][0]), fabsf(v[j][k][1])), fmaxf(fabsf(v[j][k][2]), fabsf(v[j][k][3])))); }
                    mx = wave_max(mx);
                    const float sc = mx > 0.f ? 384.f / mx : 0.f;
                    GAS unsigned char* dst = (GAS unsigned char*)((isv ? PV8 : PU8) + (size_t)e * 2048) + F.lane * 16;
#pragma unroll
                    for (int j = 0; j < 2; ++j) { u32x4 o;
#pragma unroll
                        for (int k = 0; k < 4; ++k) o[k] = pack_fp8x4(v[j][k] * sc);
                        *(GAS u32x4*)(dst + j * 1024) = o; }
                    if (F.lane == 0) (isv ? SV8 : SU8)[e] = mx * (1.f / 384.f);
                }
            }
            ENDPH(P + 8);
        }
        if (IN(P + 9)) { PH_BEGIN;
            ub = 0; GemmP g{PQ, (const bf16*)(ws + WS_SK) + (size_t)L * 16 * 128 * 128, D, 128, 128, 0, 0, 128L * 128, 0, 0, MT, 128, 128, 16, 1, 1};
            sg_gemm(F.lds, g, EpiF32{PS, D, 128, 0, 0, 1.f}, F.bid, F.nblk, ub);
            ENDPH(P + 9);
        }
        if (IN(P + 10)) { PH_BEGIN;
            LAS float* wl = (LAS float*)(F.lds + F.wave * 12288); LAS float* psl = wl + 1024;
            LAS float* sv = wl; LAS int* si = (LAS int*)(wl + 256); LAS float* ts = wl + 512; LAS int* te = (LAS int*)(wl + 640); LAS float* tg = wl + 768; LAS float* cl = wl + 896;
            const float* g2 = IP(I_LN2G) + L * D; const float* b2 = IP(I_LN2B) + L * D;
            int ca, cbb;
            { const int l = F.lane; int a = 0, base = 0;
              if (l >= 16) { a = 1; base = 16; } if (l >= 24) { a = 2; base = 24; } if (l >= 29) { a = 3; base = 29; } if (l >= 33) { a = 4; base = 33; }
              if (l >= 36) { a = 5; base = 36; } if (l >= 38) { a = 6; base = 38; } if (l >= 40) { a = 7; base = 40; } if (l >= 42) { a = 8 + (l - 42); base = l; }
              ca = a; cbb = l - base; }
            const bool cvalid = F.lane < 50;
            for (int m = F.gw; m < MT; m += F.ngw) {
                const float* ps = PS + (size_t)m * D;
#pragma unroll
                for (int i = 0; i < 8; ++i) *(LAS f32x4*)(psl + i * 256 + F.lane * 4) = *(const GAS f32x4*)((const GAS float*)ps + (unsigned)(i * 256 + F.lane * 4));
                LDS_WAIT();
                for (int q = 0; q < 16; ++q) {
                    const LAS float* pl = psl + q * 128;
                    const float sa = pl[F.lane], sb = pl[64 + F.lane];
                    int ra = 0, rb = 0;
#pragma unroll 4
                    for (int j4 = 0; j4 < 16; ++j4) {
                        const f32x4 va4 = *(const LAS f32x4*)(pl + j4 * 4), vb4 = *(const LAS f32x4*)(pl + 64 + j4 * 4);
#pragma unroll
                        for (int e = 0; e < 4; ++e) { const int j = j4 * 4 + e; const float va = va4[e], vb = vb4[e];
                            ra += (va > sa || (va == sa && j < F.lane)) ? 1 : 0; ra += (vb > sa) ? 1 : 0;
                            rb += (va >= sb) ? 1 : 0; rb += (vb > sb || (vb == sb && j < F.lane)) ? 1 : 0; } }
                    if (ra < 16) { sv[q * 16 + ra] = sa; si[q * 16 + ra] = F.lane; }
                    if (rb < 16) { sv[q * 16 + rb] = sb; si[q * 16 + rb] = 64 + F.lane; }
                }
                LDS_WAIT();
                for (int h = 0; h < 8; ++h) {
                    float cv = -3.0e38f; int cf = 9999, ce = 0;
                    if (cvalid) { cv = sv[(2 * h) * 16 + ca] + sv[(2 * h + 1) * 16 + cbb]; cf = ca * 16 + cbb; ce = si[(2 * h) * 16 + ca] * 128 + si[(2 * h + 1) * 16 + cbb]; }
                    cl[F.lane] = cv; LDS_WAIT();
                    int rk = 0;
#pragma unroll 4
                    for (int j4 = 0; j4 < 13; ++j4) { const f32x4 v4 = *(const LAS f32x4*)(cl + j4 * 4);
#pragma unroll
                        for (int e = 0; e < 4; ++e) { const int j = j4 * 4 + e; const float vj = v4[e]; const int fj = cflat(j);
                            rk += (vj > cv || (vj == cv && fj < cf)) ? 1 : 0; } }
                    if (cvalid && rk < 16) { ts[h * 16 + rk] = cv; te[h * 16 + rk] = ce; }
                }
                LDS_WAIT();
#pragma unroll
                for (int q = 0; q < 2; ++q) { const int e = q * 64 + F.lane; const float s = ts[e]; float mx = s;
#pragma unroll
                    for (int o = 1; o < 16; o <<= 1) mx = fmaxf(mx, __shfl_xor(mx, o));
                    const float p = __expf(s - mx); float sm = p;
#pragma unroll
                    for (int o = 1; o < 16; o <<= 1) sm += __shfl_xor(sm, o);
                    tg[e] = p / sm; }
                LDS_WAIT();
                float xf[2][16];
#pragma unroll
                for (int j = 0; j < 2; ++j)
#pragma unroll
                    for (int k = 0; k < 2; ++k) { const u32x4 w = *(const GAS u32x4*)((const GAS bf16*)Ub + (size_t)m * D + j * 1024 + F.lane * 16 + k * 8);
#pragma unroll
                        for (int i = 0; i < 4; ++i) { xf[j][k * 8 + 2 * i] = bflo(w[i]); xf[j][k * 8 + 2 * i + 1] = bfhi(w[i]); } }
                float fa[2][16];
#pragma unroll
                for (int j = 0; j < 2; ++j)
#pragma unroll
                    for (int e = 0; e < 16; ++e) fa[j][e] = 0.f;
                struct GBuf { u32x4 u[2][2], v[2][2]; float su[2], sv[2], g[2]; };
                const GAS unsigned char* pu8 = (const GAS unsigned char*)PU8 + F.lane * 16; const GAS unsigned char* pv8 = (const GAS unsigned char*)PV8 + F.lane * 16;
                const GAS float* su8 = (const GAS float*)SU8; const GAS float* sv8 = (const GAS float*)SV8;
                auto gload = [&](GBuf& B, int eg) {
#pragma unroll
                    for (int q = 0; q < 2; ++q) { const int ex = __builtin_amdgcn_readfirstlane(te[eg + q]); B.g[q] = tg[eg + q];
                        const GAS unsigned char* up = pu8 + (size_t)ex * 2048; const GAS unsigned char* vp = pv8 + (size_t)ex * 2048;
                        B.u[q][0] = *(const GAS u32x4*)up; B.u[q][1] = *(const GAS u32x4*)(up + 1024); B.v[q][0] = *(const GAS u32x4*)vp; B.v[q][1] = *(const GAS u32x4*)(vp + 1024);
                        B.su[q] = su8[ex]; B.sv[q] = sv8[ex]; } };
                auto gcomp = [&](const GBuf& B) {
#pragma unroll
                    for (int q = 0; q < 2; ++q) {
                        float h0 = 0.f, h1 = 0.f, h2 = 0.f, h3 = 0.f;
#pragma unroll
                        for (int j = 0; j < 2; ++j)
#pragma unroll
                            for (int w = 0; w < 4; ++w) { const f32x2 lo = __builtin_amdgcn_cvt_pk_f32_fp8((int)B.u[q][j][w], false), hi = __builtin_amdgcn_cvt_pk_f32_fp8((int)B.u[q][j][w], true);
                                h0 += lo[0] * xf[j][4 * w]; h1 += lo[1] * xf[j][4 * w + 1]; h2 += hi[0] * xf[j][4 * w + 2]; h3 += hi[1] * xf[j][4 * w + 3]; }
                        const float hh = wave_sum((h0 + h1) + (h2 + h3)) * B.su[q];
                        const float a = 0.5f * hh * (1.0f + erff(hh * 0.70710678118654752f)) * B.g[q] * B.sv[q];
#pragma unroll
                        for (int j = 0; j < 2; ++j)
#pragma unroll
                            for (int w = 0; w < 4; ++w) { const f32x2 lo = __builtin_amdgcn_cvt_pk_f32_fp8((int)B.v[q][j][w], false), hi = __builtin_amdgcn_cvt_pk_f32_fp8((int)B.v[q][j][w], true);
                                fa[j][4 * w] += a * lo[0]; fa[j][4 * w + 1] += a * lo[1]; fa[j][4 * w + 2] += a * hi[0]; fa[j][4 * w + 3] += a * hi[1]; }
                    } };
                {
                    GBuf A, B;
                    gload(A, 0);
                    for (int eg = 0; eg < 128; eg += 4) {
                        gload(B, eg + 2);
                        gcomp(A);
                        if (eg + 4 < 128) gload(A, eg + 4);
                        gcomp(B);
                    }
                }
                const int cnd = cond_of(m);
                const GAS float* gt2 = (const GAS float*)(modL + cnd * 12288 + 5 * D); GAS float* xrow = (GAS float*)(X + (size_t)m * D);
                const unsigned lo16 = (unsigned)F.lane * 16u;
                float s = 0.f;
#pragma unroll
                for (int j = 0; j < 2; ++j)
#pragma unroll
                    for (int k = 0; k < 4; ++k) { const unsigned c = lo16 + (unsigned)(j * 1024 + 4 * k);
                        const f32x4 x0 = *(const GAS f32x4*)(xrow + c), g0 = *(const GAS f32x4*)(gt2 + c);
#pragma unroll
                        for (int e = 0; e < 4; ++e) { fa[j][4 * k + e] = ALPHA * x0[e] + g0[e] * fa[j][4 * k + e]; s += fa[j][4 * k + e]; } }
                const float mean = wave_sum(s) * (1.f / D); float s2 = 0.f;
#pragma unroll
                for (int j = 0; j < 2; ++j)
#pragma unroll
                    for (int e = 0; e < 16; ++e) { fa[j][e] -= mean; s2 += fa[j][e] * fa[j][e]; }
                const float rstd = rsqrtf(wave_sum(s2) * (1.f / D) + LN_EPS);
                const GAS float* mdn = (const GAS float*)(MODS + ((L < 3 ? L + 1 : L) * 3 + cnd) * 12288);
                const GAS float* g2g = (const GAS float*)g2; const GAS float* b2g = (const GAS float*)b2;
                GAS float* orow = (GAS float*)(args.out + OUT_Y + (size_t)m * D); GAS bf16* urow = (GAS bf16*)(Ub + (size_t)m * D);
#pragma unroll
                for (int j = 0; j < 2; ++j)
#pragma unroll
                    for (int k = 0; k < 4; ++k) { const unsigned c = lo16 + (unsigned)(j * 1024 + 4 * k);
                        const f32x4 f = {fa[j][4 * k], fa[j][4 * k + 1], fa[j][4 * k + 2], fa[j][4 * k + 3]};
                        const f32x4 o = f * rstd * *(const GAS f32x4*)(g2g + c) + *(const GAS f32x4*)(b2g + c);
                        *(GAS f32x4*)(xrow + c) = o;
                        if (L == 3) *(GAS f32x4*)(orow + c) = o;
                        else { const f32x4 u = o * (*(const GAS f32x4*)(mdn + D + c) + 1.0f) + *(const GAS f32x4*)(mdn + c); *(GAS u32x2*)(urow + c) = (u32x2){pk2(u[0], u[1]), pk2(u[2], u[3])}; } }
            }
            ENDPH(P + 10);
        }
}

__global__ void __launch_bounds__(NTHR, 2) fwd(Args args) {
    extern __shared__ __attribute__((aligned(16))) unsigned char lds_raw[];
    Frame F;
    F.lds = (LAS unsigned char*)lds_raw; F.ws = args.ws;
    F.tid = threadIdx.x; F.lane = F.tid & 63; F.wave = __builtin_amdgcn_readfirstlane(F.tid >> 6);
    F.bid = blockIdx.x; F.nblk = gridDim.x; F.gw = F.bid * NWAVE + F.wave; F.ngw = F.nblk * NWAVE;
    unsigned char* const ws_ = args.ws;
    const int lo = args.ph_lo, hi = args.ph_hi;
    volatile LAS unsigned* MISC = (volatile LAS unsigned*)(F.lds + LDS_MISC);
    if (F.tid < 16) MISC[F.tid] = 0u;
    __syncthreads();
    XcdBarrier bar; bar.bar = (unsigned*)(ws_ + WS_CTL) + 4096; bar.x = 0; bar.st = MISC + 8;
#if !MK_PER_PHASE
    bar = xcd_barrier_post((unsigned*)(ws_ + WS_CTL) + 4096, MISC + 8);
#endif
    int ub;

    if (IN(0)) { PH_BEGIN;
        LAS float* sc = (LAS float*)F.lds;
        LAS float* part = (LAS float*)(F.lds + 24576);
        for (int i = F.tid; i < 3 * D; i += NTHR) { const int j = i >> 11, k = i & 2047; const float c = (j == 0) ? IP(I_CCTX)[k] : IP(I_C)[(j - 1) * D + k]; sc[i] = c / (1.f + __expf(-c)); }
        __syncthreads();
        const float* adaw = IP(I_ADAW); const float* adab = IP(I_ADAB);
        for (int u = F.bid; u < 768; u += F.nblk) {
            const int layer = u / 192, n0 = (u % 192) * 64, kr = F.lane >> 4, cq = F.lane & 15;
            f32x4 a0 = {0.f, 0.f, 0.f, 0.f}, a1 = a0, a2 = a0;
            const float* wp = adaw + ((size_t)layer * D + F.wave * 256 + kr) * 12288 + n0 + cq * 4;
#pragma unroll 8
            for (int it = 0; it < 64; ++it) { const f32x4 w = *(const f32x4*)(wp + (size_t)it * 4 * 12288); const int k = F.wave * 256 + it * 4 + kr;
                a0 += w * sc[k]; a1 += w * sc[D + k]; a2 += w * sc[2 * D + k]; }
#pragma unroll
            for (int e = 0; e < 4; ++e) { a0[e] += __shfl_xor(a0[e], 16); a0[e] += __shfl_xor(a0[e], 32); a1[e] += __shfl_xor(a1[e], 16); a1[e] += __shfl_xor(a1[e], 32); a2[e] += __shfl_xor(a2[e], 16); a2[e] += __shfl_xor(a2[e], 32); }
            if (F.lane < 16) {
#pragma unroll
                for (int e = 0; e < 4; ++e) { part[(F.wave * 3 + 0) * 64 + cq * 4 + e] = a0[e]; part[(F.wave * 3 + 1) * 64 + cq * 4 + e] = a1[e]; part[(F.wave * 3 + 2) * 64 + cq * 4 + e] = a2[e]; } }
            __syncthreads();
            if (F.tid < 192) { const int j = F.tid >> 6, c = F.tid & 63; float s = adab[layer * 12288 + n0 + c];
#pragma unroll
                for (int w = 0; w < 8; ++w) s += part[(w * 3 + j) * 64 + c];
                MODS[(layer * 3 + j) * 12288 + n0 + c] = s; }
            __syncthreads();
        }
        {
            LAS float* scr = (LAS float*)(F.lds + F.wave * 8448);
            for (int it = F.gw; it < args.tj_total; it += F.ngw) {
                int j = 0;
#pragma unroll
                for (int q = 1; q < NTJOB; ++q) j = (it >= args.tj[q].first) ? q : j;
                const TJob& J = args.tj[j];
                transpose_item(J.W, J.K, J.N, (bf16*)(ws + J.dst), J.row_off, scr, it - J.first, F.lane);
            }
        }
        const int gt = F.bid * NTHR + F.tid, ngt = F.nblk * NTHR;
        if (gt < 1024) { const int pos = gt >> 4, j = gt & 15; const float inv = exp2f(-(float)j * (13.287712379549449f / 16.0f)); float sn, cs; sincosf((float)pos * inv, &sn, &cs);
            ROPET[gt] = cs; ROPET[1024 + gt] = sn; }
        { const float* sk = IP(I_SUBK); bf16* SK = (bf16*)(ws + WS_SK);
          for (int i = gt; i < 4 * 16 * 128 * 128 / 4; i += ngt) { const f32x4 v = *(const f32x4*)(sk + (size_t)i * 4); *(u32x2*)(SK + (size_t)i * 4) = (u32x2){pk2(v[0], v[1]), pk2(v[2], v[3])}; } }
        { bf16* CS = (bf16*)(ws + WS_CS512);
          for (int i = gt; i < 1024 * 512; i += ngt) { const int j = i >> 9, c = i & 511, r = ((j & 511) * c) & 511; const float x = (float)r * (1.f / 256.f); CS[i] = (bf16)f2bf(j < 512 ? cospif(x) : sinpif(x)); } }
        { bf16* CT = (bf16*)(ws + WS_CT256);
          for (int i = gt; i < 256 * 512; i += ngt) { const int t = i >> 9, k = i & 511, r = (t * (k & 255)) & 255; const float x = (float)r * (1.f / 128.f); CT[i] = (bf16)f2bf(k < 256 ? cospif(x) : -sinpif(x)); } }
        { bf16* CT = (bf16*)(ws + WS_CT1024);
          for (int i = gt; i < 1024 * 2048; i += ngt) { const int t = i >> 11, k = i & 2047, r = (t * (k & 1023)) & 1023; const float x = (float)r * (1.f / 512.f); CT[i] = (bf16)f2bf(k < 1024 ? cospif(x) : -sinpif(x)); } }
        { const float* c0 = IP(I_C0CKV); bf16* ckvp = (bf16*)(ws + WS_CKV);
          for (int i = gt; i < 2 * 256 * 512; i += ngt) { const int b = i >> 17, r = i & 131071; ckvp[(size_t)(NPR + b * 1280 + 1024) * 512 + r] = (bf16)f2bf(c0[i]); } }
        { const float* c0 = IP(I_C0KR); bf16* kcp = (bf16*)(ws + WS_KC);
          for (int i = gt; i < 2 * 256 * 64 * 16; i += ngt) { const int h = i & 15, e = i >> 4, j = e & 63, s = (e >> 6) & 255, b = e >> 14;
              kcp[((size_t)(NPR + b * 1280 + 1024 + s) * 16 + h) * 192 + 128 + j] = (bf16)f2bf(c0[e]); } }
        ENDPH(0);
    }
    if (IN(1)) { PH_BEGIN;
        for (int m = F.gw; m < MT; m += F.ngw) {
            const float* xr = (m < NPR) ? IP(I_XP) + (size_t)m * D : IP(I_XS) + (size_t)(m - NPR) * D;
            const float* md = MODS + cond_of(m) * 12288;
#pragma unroll
            for (int i = 0; i < 8; ++i) { const int c = i * 256 + F.lane * 4; const f32x4 v = *(const f32x4*)(xr + c);
                *(f32x4*)(X + (size_t)m * D + c) = v;
                const f32x4 u = v * (*(const f32x4*)(md + D + c) + 1.0f) + *(const f32x4*)(md + c);
                *(u32x2*)(Ub + (size_t)m * D + c) = (u32x2){pk2(u[0], u[1]), pk2(u[2], u[3])}; }
        }
        ENDPH(1);
    }

    layer_phases<0>(args, F, ws_, lo, hi, bar);
    layer_phases<1>(args, F, ws_, lo, hi, bar);
    layer_phases<2>(args, F, ws_, lo, hi, bar);
    layer_phases<3>(args, F, ws_, lo, hi, bar);
}

static const int kPhases[] = {0, 1,
    2, 3, 4, 5, 6, 7, 8, 9, 10, 11, 12,
    18, 21, 22, 23, 24, 25, 26, 27, 28,
    34, 39, 40, 41, 42, 43, 44,
    50, 55, 56, 57, 58, 59, 60};

extern "C" void kernel_launch(void* const* d_in, const int* in_sizes, int n_in, void* d_out, int out_size, void* d_ws, size_t ws_size, hipStream_t stream) {
    static int grid = 0;
    if (grid == 0) {
        if (n_in != 34 || ws_size < WS_END) { fprintf(stderr, "kernel_launch: unexpected n_in %d / ws_size %zu\n", n_in, ws_size); grid = -1; return; }
        int dev = 0, cus = 0;
        if (hipGetDevice(&dev) != hipSuccess || hipDeviceGetAttribute(&cus, hipDeviceAttributeMultiprocessorCount, dev) != hipSuccess) { grid = -1; return; }
        if (hipFuncSetAttribute((const void*)fwd, hipFuncAttributeMaxDynamicSharedMemorySize, LDS_BYTES) != hipSuccess) { fprintf(stderr, "kernel_launch: hipFuncSetAttribute failed\n"); grid = -1; return; }
        int per_cu = 0;
        if (hipOccupancyMaxActiveBlocksPerMultiprocessor(&per_cu, (const void*)fwd, NTHR, LDS_BYTES) != hipSuccess || per_cu < 1) fprintf(stderr, "kernel_launch: occupancy query says %d\n", per_cu);
        (void)hipGetLastError();
        grid = cus;
    }
    if (grid < 0) return;
    (void)hipMemsetAsync((char*)d_ws + WS_CTL, 0, CTL_BYTES, stream);
    Args a{};
    for (int i = 0; i < 34; ++i) a.in[i] = (const float*)d_in[i];
    a.out = (float*)d_out; a.ws = (unsigned char*)d_ws;
    {
        struct J { int idx; size_t sub; size_t dst; int K, N, row_off; };
        const J js[NTJOB] = {
            {I_WDQ, 0, WS_W0T, 2048, 512, 0}, {I_WDKV, 0, WS_W0T, 2048, 576, 512}, {I_WUQ, 0, WS_WUQT, 512, 3072, 0}, {I_WUK, 0, WS_WUKT, 512, 2048, 0},
            {I_WUV, 0, WS_WUVT, 512, 2048, 0}, {I_WO0, 0, WS_WOT0, 2048, 2048, 0}, {I_WQKV, 0, WS_WQKVT, 2048, 3072, 0}, {I_WO1, 0, WS_WOT1, 2048, 2048, 0},
            {I_WF, 0, WS_WFT, 2048, 2048, 0}, {I_WIN, 0, WS_WINT, 2048, 6144, 0}, {I_WCO, 0, WS_WCOT, 2048, 2048, 0},
            {I_WPQ, 0, WS_WPQT, 2048, 2048, 0}, {I_WPQ, (size_t)1 * 2048 * 2048, WS_WPQT + (size_t)1 * 2048 * 2048 * 2, 2048, 2048, 0},
            {I_WPQ, (size_t)2 * 2048 * 2048, WS_WPQT + (size_t)2 * 2048 * 2048 * 2, 2048, 2048, 0}, {I_WPQ, (size_t)3 * 2048 * 2048, WS_WPQT + (size_t)3 * 2048 * 2048 * 2, 2048, 2048, 0}};
        int first = 0;
        for (int j = 0; j < NTJOB; ++j) { a.tj[j].W = (const float*)d_in[js[j].idx] + js[j].sub; a.tj[j].dst = js[j].dst; a.tj[j].K = js[j].K; a.tj[j].N = js[j].N; a.tj[j].row_off = js[j].row_off; a.tj[j].first = first;
            first += (js[j].K / 64) * (js[j].N / 32); }
        a.tj_total = first;
    }
#if MK_PER_PHASE
    for (size_t i = 0; i < sizeof(kPhases) / sizeof(kPhases[0]); ++i) {
        a.ph_lo = kPhases[i]; a.ph_hi = kPhases[i] + 1;
        hipLaunchKernelGGL(fwd, dim3(grid), dim3(NTHR), LDS_BYTES, stream, a);
    }
#else
    a.ph_lo = 0; a.ph_hi = 1 << 20;
    hipLaunchKernelGGL(fwd, dim3(grid), dim3(NTHR), LDS_BYTES, stream, a);
#endif
    const hipError_t le = hipPeekAtLastError();
    if (le != hipSuccess) fprintf(stderr, "kernel_launch: launch failed: %s\n", hipGetErrorName(le));
}
```

```cpp
#include <hip/hip_runtime.h>
#include <cstdio>
#include <cstdint>

#ifndef MK_PER_PHASE
#define MK_PER_PHASE 0
#endif

#define LAS __attribute__((address_space(3)))
typedef unsigned short bf16;
typedef short bf16x8 __attribute__((ext_vector_type(8)));
typedef float f32x4 __attribute__((ext_vector_type(4)));
typedef unsigned u32x4 __attribute__((ext_vector_type(4)));
typedef unsigned u32x2 __attribute__((ext_vector_type(2)));
typedef __bf16 bf16x2_t __attribute__((ext_vector_type(2)));
typedef float f32x2 __attribute__((ext_vector_type(2)));
#define GAS __attribute__((address_space(1)))
__device__ __forceinline__ unsigned pack_fp8x4(f32x4 a) { int w = __builtin_amdgcn_cvt_pk_fp8_f32(a[0], a[1], 0, false); w = __builtin_amdgcn_cvt_pk_fp8_f32(a[2], a[3], w, true); return (unsigned)w; }

constexpr int D = 2048, NPR = 4096, MT = 6144, KVR = 6656;
constexpr int NTHR = 512, NWAVE = 8;
constexpr float ALPHA = 1.6817928305074290f;
constexpr float MLA_SCALE = 0.07216878364870322f;
constexpr float GQA_SCALE = 0.125f;
constexpr float LN_EPS = 1e-5f, RMS_EPS = 1e-6f;

constexpr size_t MiB = 1u << 20;
constexpr size_t WS_CTL = 0, CTL_BYTES = 1 * MiB;
constexpr size_t WS_MODS = 1 * MiB;
constexpr size_t WS_W0T = 2 * MiB, WS_WUQT = 7 * MiB, WS_WUKT = 10 * MiB, WS_WUVT = 12 * MiB, WS_WOT0 = 14 * MiB, WS_WQKVT = 22 * MiB,
                 WS_WOT1 = 34 * MiB, WS_WFT = 42 * MiB, WS_WINT = 50 * MiB, WS_WCOT = 74 * MiB, WS_WPQT = 82 * MiB, WS_SK = 114 * MiB,
                 WS_CS512 = 116 * MiB, WS_CT256 = 117 * MiB, WS_CT1024 = 118 * MiB, WS_PU = 122 * MiB, WS_PV = 186 * MiB,
                 WS_X = 250 * MiB, WS_Y = 298 * MiB, WS_U = 346 * MiB, WS_O = 370 * MiB, WS_Q = 394 * MiB, WS_KC = 430 * MiB,
                 WS_VT = 469 * MiB, WS_QN = 495 * MiB, WS_CKV = 501 * MiB, WS_SCR = 508 * MiB, WS_END = 956 * MiB;
constexpr size_t OUT_Y = 0, OUT_CKV = 12582912, OUT_KR = 14680064, OUT_K1 = 14942208, OUT_V1 = 17039360;

constexpr int LDS_BYTES = 147456;
constexpr int LDS_MISC = 140 * 1024;

#define LDS_WAIT() asm volatile("s_waitcnt lgkmcnt(0)" ::: "memory")
__device__ __forceinline__ unsigned f2bf(float f) { unsigned u = __float_as_uint(f); return (u + 0x7fffu + ((u >> 16) & 1u)) >> 16; }
__device__ __forceinline__ unsigned pk2(float lo, float hi) { unsigned r; asm("v_cvt_pk_bf16_f32 %0, %1, %2" : "=v"(r) : "v"(lo), "v"(hi)); return r; }
__device__ __forceinline__ float bflo(unsigned w) { return __uint_as_float(w << 16); }
__device__ __forceinline__ float bfhi(unsigned w) { return __uint_as_float(w & 0xffff0000u); }
__device__ __forceinline__ float wave_sum(float v) {
#pragma unroll
    for (int o = 1; o < 64; o <<= 1) v += __shfl_xor(v, o);
    return v;
}
__device__ __forceinline__ float wave_max(float v) {
#pragma unroll
    for (int o = 1; o < 64; o <<= 1) v = fmaxf(v, __shfl_xor(v, o));
    return v;
}
__device__ __forceinline__ float dot2bf(unsigned w, unsigned x, float acc) {
    return __builtin_amdgcn_fdot2_f32_bf16(__builtin_bit_cast(bf16x2_t, w), __builtin_bit_cast(bf16x2_t, x), acc, false);
}
__device__ __forceinline__ int cond_of(int m) { return m < NPR ? 0 : 1 + ((m - NPR) >> 10); }
__device__ __forceinline__ int kvrow_of(int m) { return m < NPR ? m : NPR + ((m - NPR) >> 10) * 1280 + ((m - NPR) & 1023); }

#define XB_TMO      128
#define XB_XCNT(j)  (256  + 64 * (j))
#define XB_XSUB(j)  (1280 + 64 * (j))
#define XB_XGEN(j)  (2304 + 64 * (j))
#define XB_TOP      3328
#define XB_TOPGEN   3392
#define XCD_BAR_WORDS 3456
#define XB_SPIN_CAP (1u << 22)
__device__ __forceinline__ unsigned xb_ld(unsigned* p)              { return __hip_atomic_load(p, __ATOMIC_RELAXED, __HIP_MEMORY_SCOPE_AGENT); }
__device__ __forceinline__ unsigned xb_add(unsigned* p, unsigned v) { return __hip_atomic_fetch_add(p, v, __ATOMIC_RELAXED, __HIP_MEMORY_SCOPE_AGENT); }
__device__ __forceinline__ unsigned xb_xcc_id() { return (unsigned)__builtin_amdgcn_s_getreg((3 << 11) | 20) & 0xFu; }
#define XB_SPIN(cond, bar) do { unsigned _sp = 0; while (cond) { __builtin_amdgcn_s_sleep(1); \
    if ((++_sp & 255u) == 0u) { if (xb_ld(&(bar)[XB_TMO])) break; if (_sp > XB_SPIN_CAP) { atomicAdd(&(bar)[XB_TMO], 1u); break; } } } } while (0)
struct XcdBarrier { unsigned* bar; unsigned x; volatile LAS unsigned* st; };
__device__ __forceinline__ XcdBarrier xcd_barrier_post(unsigned* bar, volatile LAS unsigned* st) {
    XcdBarrier b; b.bar = bar; b.x = xb_xcc_id(); b.st = st;
    if (threadIdx.x == 0) (void)xb_add(&bar[XB_XCNT(b.x)], 1u);
    return b;
}
__device__ __forceinline__ void xcd_barrier_complete(unsigned* bar, unsigned x, unsigned& nloc, unsigned& nx) {
    const unsigned G = gridDim.x * gridDim.y * gridDim.z;
    unsigned sum, cnt, mine, sp = 0u;
    for (;;) {
        sum = 0u; cnt = 0u; mine = 0u;
#pragma unroll
        for (unsigned j = 0; j < 16; ++j) { const unsigned c = xb_ld(&bar[XB_XCNT(j)]); sum += c; cnt += (c > 0u) ? 1u : 0u; mine = (j == x) ? c : mine; }
        if (sum == G) break;
        __builtin_amdgcn_s_sleep(1);
        if ((++sp & 255u) == 0u) { if (xb_ld(&bar[XB_TMO])) break; if (sp > XB_SPIN_CAP) { atomicAdd(&bar[XB_TMO], 1u); break; } }
    }
    nloc = mine > 0u ? mine : 1u; nx = cnt > 0u ? cnt : 1u;
}
__device__ __forceinline__ void xcd_barrier(const XcdBarrier& b) {
    asm volatile("s_waitcnt vmcnt(0)" ::: "memory");
    __syncthreads();
    if (threadIdx.x == 0) {
        unsigned* bar = b.bar;
        __builtin_amdgcn_s_waitcnt(0);
        unsigned nloc = b.st[0], nx = b.st[1];
        if (nloc == 0u) { xcd_barrier_complete(bar, b.x, nloc, nx); b.st[0] = nloc; b.st[1] = nx; }
        const unsigned old = xb_add(&bar[XB_XSUB(b.x)], 1u);
        const unsigned gen = old / nloc;
        if (old + 1u == (gen + 1u) * nloc) {
            __builtin_amdgcn_fence(__ATOMIC_RELEASE, "agent");
            asm volatile("s_waitcnt vmcnt(0)" ::: "memory");
            const unsigned og = xb_add(&bar[XB_TOP], 1u);
            const unsigned tg = og / nx;
            if (og + 1u == (tg + 1u) * nx) xb_add(&bar[XB_TOPGEN], 1u);
            else XB_SPIN(xb_ld(&bar[XB_TOPGEN]) == tg, bar);
            __builtin_amdgcn_fence(__ATOMIC_ACQUIRE, "agent");
            xb_add(&bar[XB_XGEN(b.x)], 1u);
            asm volatile("s_waitcnt vmcnt(0)" ::: "memory");
        } else {
            XB_SPIN(xb_ld(&bar[XB_XGEN(b.x)]) == gen, bar);
            __builtin_amdgcn_fence(__ATOMIC_ACQUIRE, "agent");
            asm volatile("s_waitcnt vmcnt(0)" ::: "memory");
        }
    }
    __syncthreads();
}

struct TJob { const float* W; unsigned long long dst; int K, N, row_off, first; };
constexpr int NTJOB = 11;
struct Args {
    const float* in[34];
    float* out;
    unsigned char* ws;
    TJob tj[NTJOB];
    int tj_total;
    int ph_lo, ph_hi, pad;
};
enum { I_XP = 0, I_XS, I_C0CKV, I_C0KR, I_C1K, I_C1V, I_C, I_CCTX, I_ADAW, I_ADAB, I_LN1G, I_LN1B, I_LN2G, I_LN2B,
       I_WDQ, I_QNORM, I_WUQ, I_WDKV, I_KVNORM, I_WUK, I_WUV, I_WO0, I_WQKV, I_SINK, I_WO1, I_WF, I_WIN, I_CONVW, I_CONVB, I_WCO,
       I_WPQ, I_SUBK, I_PEERU, I_PEERV };

struct GemmP {
    const bf16* A; const bf16* B;
    long lda, ldb;
    long sA1, sA2, sA3, sB1, sB2, sB3;
    int M, N, K, nb1, nb2, nb3;
};
constexpr int SG_LDT = 72;
constexpr int SG_TILE = 128 * SG_LDT * 2;
template <class Epi>
__device__ __forceinline__ void sg_gemm(LAS unsigned char* lds, const GemmP g, const Epi& E, int bid, int nblk, int& ubase) {
    const int tid = threadIdx.x, lane = tid & 63, wave = __builtin_amdgcn_readfirstlane(tid >> 6);
    const int wm = wave >> 2, wn = wave & 3, fr = lane & 15, fq = lane >> 4;
    const int tiles_m = (g.M + 127) >> 7, tiles_n = (g.N + 127) >> 7;
    const int nbatch = g.nb1 * g.nb2 * g.nb3;
    const int U = nbatch * tiles_m * tiles_n;
    const int nk = g.K >> 6;
    int first = (bid - (ubase % nblk) + nblk) % nblk;
    ubase += U;
    const int lrow0 = tid >> 3, lkc = tid & 7;
    const int aoff = (wm * 64 + fr) * (SG_LDT * 2) + fq * 16;
    const int boff = (wn * 32 + fr) * (SG_LDT * 2) + fq * 16;
    for (int u = first; u < U; u += nblk) {
        const int tn = u % tiles_n; const int r1 = u / tiles_n; const int tm = r1 % tiles_m; const int b = r1 / tiles_m;
        const int b3 = b % g.nb3, b12 = b / g.nb3, b2 = b12 % g.nb2, b1 = b12 / g.nb2;
        const int m0 = tm << 7, n0 = tn << 7;
        const bf16* Ab = g.A + b1 * g.sA1 + b2 * g.sA2 + b3 * g.sA3;
        const bf16* Bb = g.B + b1 * g.sB1 + b2 * g.sB2 + b3 * g.sB3;
        int ar0 = m0 + lrow0, ar1 = ar0 + 64; ar0 = ar0 < g.M ? ar0 : g.M - 1; ar1 = ar1 < g.M ? ar1 : g.M - 1;
        int br0 = n0 + lrow0, br1 = br0 + 64; br0 = br0 < g.N ? br0 : g.N - 1; br1 = br1 < g.N ? br1 : g.N - 1;
        const bf16* pa0 = Ab + (long)ar0 * g.lda + lkc * 8; const bf16* pa1 = Ab + (long)ar1 * g.lda + lkc * 8;
        const bf16* pb0 = Bb + (long)br0 * g.ldb + lkc * 8; const bf16* pb1 = Bb + (long)br1 * g.ldb + lkc * 8;
        f32x4 acc[4][2];
#pragma unroll
        for (int i = 0; i < 4; ++i) { acc[i][0] = (f32x4){0.f, 0.f, 0.f, 0.f}; acc[i][1] = (f32x4){0.f, 0.f, 0.f, 0.f}; }
        u32x4 ra0 = *(const u32x4*)pa0, ra1 = *(const u32x4*)pa1, rb0 = *(const u32x4*)pb0, rb1 = *(const u32x4*)pb1;
        const int wofs = lrow0 * (SG_LDT * 2) + lkc * 16;
        *(LAS u32x4*)(lds + wofs) = ra0; *(LAS u32x4*)(lds + wofs + 64 * SG_LDT * 2) = ra1;
        *(LAS u32x4*)(lds + SG_TILE + wofs) = rb0; *(LAS u32x4*)(lds + SG_TILE + wofs + 64 * SG_LDT * 2) = rb1;
        __syncthreads();
        for (int kt = 0; kt < nk; ++kt) {
            const int cur = (kt & 1) * 2 * SG_TILE, nxt = ((kt + 1) & 1) * 2 * SG_TILE;
            const bool more = (kt + 1 < nk);
            if (more) { const int ko = (kt + 1) << 6; ra0 = *(const u32x4*)(pa0 + ko); ra1 = *(const u32x4*)(pa1 + ko); rb0 = *(const u32x4*)(pb0 + ko); rb1 = *(const u32x4*)(pb1 + ko); }
#pragma unroll
            for (int ks = 0; ks < 2; ++ks) {
                bf16x8 af[4], bfr[2];
#pragma unroll
                for (int i = 0; i < 4; ++i) af[i] = *(const LAS bf16x8*)(lds + cur + aoff + i * 16 * SG_LDT * 2 + ks * 64);
#pragma unroll
                for (int j = 0; j < 2; ++j) bfr[j] = *(const LAS bf16x8*)(lds + cur + SG_TILE + boff + j * 16 * SG_LDT * 2 + ks * 64);
#pragma unroll
                for (int i = 0; i < 4; ++i)
#pragma unroll
                    for (int j = 0; j < 2; ++j) acc[i][j] = __builtin_amdgcn_mfma_f32_16x16x32_bf16(bfr[j], af[i], acc[i][j], 0, 0, 0);
            }
            if (more) {
                *(LAS u32x4*)(lds + nxt + wofs) = ra0; *(LAS u32x4*)(lds + nxt + wofs + 64 * SG_LDT * 2) = ra1;
                *(LAS u32x4*)(lds + nxt + SG_TILE + wofs) = rb0; *(LAS u32x4*)(lds + nxt + SG_TILE + wofs + 64 * SG_LDT * 2) = rb1;
            }
            __syncthreads();
        }
        const int nn = n0 + wn * 32 + 4 * fq;
        if (n0 + wn * 32 < g.N) {
#pragma unroll
            for (int i = 0; i < 4; ++i) { const int m = m0 + wm * 64 + i * 16 + fr; if (m < g.M) E(b1, b2, b3, m, nn, acc[i][0], acc[i][1]); }
        }
    }
}

namespace pg8 {
constexpr int BM = 256, BK = 64, HALF = 128, HTB = HALF * BK * 2, STAGE_BYTES = 8 * HTB, WGM = 8;
__device__ __forceinline__ int lds_byte(int r, int c) { const int st = (r >> 4) * 2 + (c >> 5), rr = r & 15, cc = c & 31, ob = rr * 64 + cc * 2; return st * 1024 + (ob ^ (((ob >> 9) & 1) << 5)); }
__device__ __forceinline__ void stage_rc(int b, int& R, int& C) { const int st = b / 1024, sb = b % 1024, swz = sb ^ (((sb >> 9) & 1) << 5); R = (st >> 1) * 16 + swz / 64; C = (st & 1) * 32 + (swz % 64) / 2; }
struct Unit { const char* a; const char* b; int pm, pn, b1, b2, b3; };
template <class Epi>
__device__ __forceinline__ void gemm_phase(LAS unsigned char* lds, const GemmP g, const Epi& E, int bid, int nblk, int& ubase) {
    const int tid = threadIdx.x, wid = __builtin_amdgcn_readfirstlane(tid >> 6), lane = tid & 63, wr = wid >> 2, wc = wid & 3, fr = lane & 15, fq = lane >> 4;
    const int nt = g.K / BK;
    const int nM = g.M / BM, nN = g.N / BM, nwg = nM * nN, U = g.nb1 * g.nb2 * g.nb3 * nwg;
    const int cidx = (bid - (ubase % nblk) + nblk) % nblk; ubase += U;
    auto next = [&](int i, Unit& u) -> bool {
        const long Lq = (long)i * nblk + cidx; if (Lq >= U) return false;
        const int b = (int)(Lq / nwg), w = (int)(Lq % nwg);
        const int nig = WGM * nN, gid = w / nig, fm = gid * WGM, gsz = (nM - fm) < WGM ? (nM - fm) : WGM;
        u.pm = fm + ((w % nig) % gsz); u.pn = (w % nig) / gsz;
        u.b3 = b % g.nb3; const int b12 = b / g.nb3; u.b2 = b12 % g.nb2; u.b1 = b12 / g.nb2;
        u.a = (const char*)(g.A + u.b1 * g.sA1 + u.b2 * g.sA2 + u.b3 * g.sA3 + (long)u.pm * BM * g.lda);
        u.b = (const char*)(g.B + u.b1 * g.sB1 + u.b2 * g.sB2 + u.b3 * g.sB3 + (long)u.pn * BM * g.ldb);
        return true; };
    unsigned voffA[2], voffB[2];
#pragma unroll
    for (int i = 0; i < 2; ++i) { int R, C; stage_rc(tid * 16 + i * 8192, R, C); voffA[i] = (unsigned)(R * (int)g.lda + C) * 2u; voffB[i] = (unsigned)(R * (int)g.ldb + C) * 2u; }
    const size_t kstep = (size_t)(BK * 2);
    const size_t hstepA = (size_t)HALF * g.lda * 2, hstepB = (size_t)HALF * g.ldb * 2;
    const unsigned ldsw = (unsigned)wid * 1024u;
    const int aoff = lds_byte(wr * 64 + fr, fq * 8), boff = lds_byte(wc * 32 + fr, fq * 8);
#define PG8_SA(b, h) (((b) * 2 + (h)) * HTB)
#define PG8_SB(b, h) ((4 + (b) * 2 + (h)) * HTB)
#define PG8_STAGE(bufoff, gbase, voff) do { _Pragma("unroll") for (int _i = 0; _i < 2; ++_i) \
        __builtin_amdgcn_global_load_lds((const unsigned*)((const char*)(gbase) + (voff)[_i]), (LAS unsigned*)(lds + (bufoff) + ldsw + _i * 8192), 16, 0, 0); } while (0)
#define PG8_LDA(dst, b, h) do { _Pragma("unroll") for (int m = 0; m < 4; ++m) _Pragma("unroll") for (int k = 0; k < 2; ++k) dst[m][k] = *(const LAS bf16x8*)(lds + PG8_SA(b, h) + aoff + m * 2048 + k * 1024); } while (0)
#define PG8_LDB(dst, b, h) do { _Pragma("unroll") for (int n = 0; n < 2; ++n) _Pragma("unroll") for (int k = 0; k < 2; ++k) dst[n][k] = *(const LAS bf16x8*)(lds + PG8_SB(b, h) + boff + n * 2048 + k * 1024); } while (0)
#define PG8_MMA(ai, bj, At, Bt) do { __builtin_amdgcn_s_setprio(1); _Pragma("unroll") for (int m = 0; m < 4; ++m) _Pragma("unroll") for (int n = 0; n < 2; ++n) _Pragma("unroll") for (int k = 0; k < 2; ++k) \
        acc[ai][bj][m][n] = __builtin_amdgcn_mfma_f32_16x16x32_bf16(Bt[n][k], At[m][k], acc[ai][bj][m][n], 0, 0, 0); __builtin_amdgcn_s_setprio(0); } while (0)
#define PG8_WAIT_V(n) asm volatile("s_waitcnt vmcnt(" #n ")" ::: "memory")
#define PG8_WAIT_L(n) asm volatile("s_waitcnt lgkmcnt(" #n ")" ::: "memory")
#define PG8_BAR __builtin_amdgcn_s_barrier()
#define PG8_SCHED __builtin_amdgcn_sched_barrier(0)
    Unit cur, nxt; int ui = 0;
    if (!next(0, cur)) return;
    f32x4 acc[2][2][4][2];
#pragma unroll
    for (int a = 0; a < 2; ++a)
#pragma unroll
        for (int b = 0; b < 2; ++b)
#pragma unroll
            for (int m = 0; m < 4; ++m)
#pragma unroll
                for (int n = 0; n < 2; ++n) acc[a][b][m][n] = (f32x4){0.f, 0.f, 0.f, 0.f};
    bf16x8 At[4][2], B0[2][2], B1[2][2];
    const char* cA = cur.a; const char* cB = cur.b;
    PG8_STAGE(PG8_SB(0, 0), cB, voffB); PG8_STAGE(PG8_SA(0, 0), cA, voffA); PG8_STAGE(PG8_SB(0, 1), cB + hstepB, voffB); PG8_STAGE(PG8_SA(0, 1), cA + hstepA, voffA);
    if (wr == 1) PG8_BAR;
    PG8_WAIT_V(4); PG8_BAR;
    PG8_STAGE(PG8_SB(1, 0), cB + kstep, voffB); PG8_STAGE(PG8_SA(1, 0), cA + kstep, voffA); PG8_STAGE(PG8_SB(1, 1), cB + hstepB + kstep, voffB);
    PG8_WAIT_V(6); PG8_BAR;
    for (;;) {
        const bool has_next = next(ui + 1, nxt);
        const char* nA = has_next ? nxt.a : cA; const char* nB = has_next ? nxt.b : cB;
        for (int t = 0; t < nt; t += 2) {
            const bool last = (t == nt - 2);
            const char* a1 = cA + (size_t)(t + 1) * kstep;
            const char* a2 = last ? nA : cA + (size_t)(t + 2) * kstep; const char* b2 = last ? nB : cB + (size_t)(t + 2) * kstep;
            const char* a3 = a2 + kstep; const char* b3 = b2 + kstep;
            PG8_LDB(B0, 0, 0); PG8_SCHED; PG8_LDA(At, 0, 0); PG8_STAGE(PG8_SA(1, 1), a1 + hstepA, voffA);
            PG8_WAIT_L(8); PG8_BAR; PG8_WAIT_L(0); PG8_MMA(0, 0, At, B0); PG8_BAR; PG8_SCHED;
            PG8_LDB(B1, 0, 1); PG8_STAGE(PG8_SB(0, 0), b2, voffB);
            PG8_BAR; PG8_WAIT_L(0); PG8_MMA(0, 1, At, B1); PG8_BAR;
            PG8_LDA(At, 0, 1); PG8_STAGE(PG8_SA(0, 0), a2, voffA);
            PG8_BAR; PG8_WAIT_L(0); PG8_MMA(1, 0, At, B0); PG8_BAR; PG8_SCHED;
            PG8_STAGE(PG8_SB(0, 1), b2 + hstepB, voffB);
            PG8_WAIT_V(6); PG8_BAR; PG8_MMA(1, 1, At, B1); PG8_BAR;
            PG8_LDB(B0, 1, 0); PG8_SCHED; PG8_LDA(At, 1, 0); PG8_STAGE(PG8_SA(0, 1), a2 + hstepA, voffA);
            PG8_WAIT_L(8); PG8_BAR; PG8_WAIT_L(0); PG8_MMA(0, 0, At, B0); PG8_BAR; PG8_SCHED;
            PG8_LDB(B1, 1, 1); PG8_STAGE(PG8_SB(1, 0), b3, voffB);
            PG8_BAR; PG8_WAIT_L(0); PG8_MMA(0, 1, At, B1); PG8_BAR;
            PG8_LDA(At, 1, 1); PG8_STAGE(PG8_SA(1, 0), a3, voffA);
            PG8_BAR; PG8_WAIT_L(0); PG8_MMA(1, 0, At, B0); PG8_BAR; PG8_SCHED;
            PG8_STAGE(PG8_SB(1, 1), b3 + hstepB, voffB);
            PG8_WAIT_V(6); PG8_BAR; PG8_MMA(1, 1, At, B1); PG8_BAR;
        }
#pragma unroll
        for (int ai = 0; ai < 2; ++ai)
#pragma unroll
            for (int mm = 0; mm < 4; ++mm) { const int row = cur.pm * BM + ai * HALF + wr * 64 + mm * 16 + fr;
#pragma unroll
                for (int bj = 0; bj < 2; ++bj) E(cur.b1, cur.b2, cur.b3, row, cur.pn * BM + bj * HALF + wc * 32 + 4 * fq, acc[ai][bj][mm][0], acc[ai][bj][mm][1]); }
        if (!has_next) break;
#pragma unroll
        for (int a = 0; a < 2; ++a)
#pragma unroll
            for (int b = 0; b < 2; ++b)
#pragma unroll
                for (int m = 0; m < 4; ++m)
#pragma unroll
                    for (int n = 0; n < 2; ++n) acc[a][b][m][n] = (f32x4){0.f, 0.f, 0.f, 0.f};
        cur = nxt; cA = nA; cB = nB; ++ui;
    }
    PG8_WAIT_V(0);
    if (wr == 0) PG8_BAR;
    PG8_BAR;
#undef PG8_SA
#undef PG8_SB
#undef PG8_STAGE
#undef PG8_LDA
#undef PG8_LDB
#undef PG8_MMA
#undef PG8_WAIT_V
#undef PG8_WAIT_L
#undef PG8_BAR
#undef PG8_SCHED
}
}

struct EpiF32 { float* C; long ldc, s1, s2, s3; float scale;
    __device__ __forceinline__ void operator()(int b1, int b2, int b3, int m, int n, f32x4 v0, f32x4 v1) const {
        float* p = C + b1 * s1 + b2 * s2 + b3 * s3 + (long)m * ldc + n; *(f32x4*)p = v0 * scale; *(f32x4*)(p + 16) = v1 * scale; } };
struct EpiF32N { float* C; long ldc; int nvalid;
    __device__ __forceinline__ void operator()(int, int, int, int m, int n, f32x4 v0, f32x4 v1) const {
        if (n < nvalid) { float* p = C + (long)m * ldc + n; *(f32x4*)p = v0; *(f32x4*)(p + 16) = v1; } } };
struct EpiBf16 { bf16* C; long ldc, s1, s2, s3; float scale;
    __device__ __forceinline__ void operator()(int b1, int b2, int b3, int m, int n, f32x4 v0, f32x4 v1) const {
        bf16* p = C + b1 * s1 + b2 * s2 + b3 * s3 + (long)m * ldc + n; v0 = v0 * scale; v1 = v1 * scale;
        *(u32x2*)p = (u32x2){pk2(v0[0], v0[1]), pk2(v0[2], v0[3])}; *(u32x2*)(p + 16) = (u32x2){pk2(v1[0], v1[1]), pk2(v1[2], v1[3])}; } };
__device__ __forceinline__ void rope4(f32x4& v0, f32x4& v1, int pos, int j0, const float* tab) {
    const f32x4 cs = *(const f32x4*)(tab + pos * 16 + j0), sn = *(const f32x4*)(tab + 1024 + pos * 16 + j0);
    const f32x4 x1 = v0, x2 = v1; v0 = x1 * cs - x2 * sn; v1 = x1 * sn + x2 * cs;
}
struct EpiQMla { bf16* Q; const float* rtab;
    __device__ __forceinline__ void operator()(int, int, int, int m, int n, f32x4 v0, f32x4 v1) const {
        const int d = n % 192, d0 = d & ~31;
        if (m >= NPR && d0 >= 128) { const int t = (m - NPR) & 1023; const int pos = (d0 == 128) ? (t >> 6) : (t & 63); rope4(v0, v1, pos, d & 15, rtab); }
        bf16* p = Q + (long)m * 3072 + n;
        *(u32x2*)p = (u32x2){pk2(v0[0], v0[1]), pk2(v0[2], v0[3])}; *(u32x2*)(p + 16) = (u32x2){pk2(v1[0], v1[1]), pk2(v1[2], v1[3])}; } };
struct EpiKn { bf16* KC;
    __device__ __forceinline__ void operator()(int, int, int, int m, int n, f32x4 v0, f32x4 v1) const {
        bf16* p = KC + ((long)m * 16 + (n >> 7)) * 192 + (n & 127);
        *(u32x2*)p = (u32x2){pk2(v0[0], v0[1]), pk2(v0[2], v0[3])}; *(u32x2*)(p + 16) = (u32x2){pk2(v1[0], v1[1]), pk2(v1[2], v1[3])}; } };
struct EpiResid { float* Y; const float* X; const float* gate;
    __device__ __forceinline__ void operator()(int, int, int, int m, int n, f32x4 v0, f32x4 v1) const {
        const float* gp = gate + cond_of(m) * 12288 + n; const float* xp = X + (long)m * D + n; float* yp = Y + (long)m * D + n;
        const f32x4 g0 = *(const f32x4*)gp, g1 = *(const f32x4*)(gp + 16), x0 = *(const f32x4*)xp, x1 = *(const f32x4*)(xp + 16);
        *(f32x4*)yp = x0 * ALPHA + g0 * v0; *(f32x4*)(yp + 16) = x1 * ALPHA + g1 * v1; } };
struct EpiQkv1 { bf16* Q1; bf16* K1; bf16* VT1; float* outk; float* outv; const float* rtab;
    __device__ __forceinline__ void operator()(int, int, int, int m, int n, f32x4 v0, f32x4 v1) const {
        const int kvr = kvrow_of(m);
        if (n < 2560) {
            if (n >= 2048 && m < NPR) { float* p = outk + (long)m * 512 + (n - 2048); *(f32x4*)p = v0; *(f32x4*)(p + 16) = v1; }
            if (m >= NPR) { const int t = (m - NPR) & 1023; const int pos = ((n & 32) == 0) ? (t >> 6) : (t & 63); rope4(v0, v1, pos, n & 15, rtab); }
            bf16* p = (n < 2048) ? (Q1 + (long)m * 2048 + n) : (K1 + (long)kvr * 512 + (n - 2048));
            *(u32x2*)p = (u32x2){pk2(v0[0], v0[1]), pk2(v0[2], v0[3])}; *(u32x2*)(p + 16) = (u32x2){pk2(v1[0], v1[1]), pk2(v1[2], v1[3])};
        } else {
            const int c = n - 2560;
            if (m < NPR) { float* p = outv + (long)m * 512 + c; *(f32x4*)p = v0; *(f32x4*)(p + 16) = v1; }
#pragma unroll
            for (int i = 0; i < 4; ++i) { VT1[(long)(c + i) * KVR + kvr] = (bf16)f2bf(v0[i]); VT1[(long)(c + 16 + i) * KVR + kvr] = (bf16)f2bf(v1[i]); }
        } } };
struct EpiDft1 { bf16* YTp; bf16* YTs;
    __device__ __forceinline__ void operator()(int g, int, int, int j, int tok, f32x4 v0, f32x4 v1) const {
        const int h = j >> 9, c = j & 511;
#pragma unroll
        for (int q = 0; q < 2; ++q) { const int tk = tok + 16 * q; const f32x4 v = q ? v1 : v0; bf16* p;
            if (tk < NPR) { const int b = tk >> 8, t = tk & 255; p = YTp + ((long)(b * 2048 + g * 512 + c) * 512 + h * 256 + t); }
            else { const int s = tk - NPR, b = s >> 10, t = s & 1023; p = YTs + ((long)(b * 2048 + g * 512 + c) * 2048 + h * 1024 + t); }
            *(u32x2*)p = (u32x2){pk2(v[0], v[1]), pk2(v[2], v[3])}; } } };

template <class T> __device__ __forceinline__ T* opq(T* p) { asm volatile("" : "+s"(p)); return p; }
struct Frame {
    LAS unsigned char* lds;
    unsigned char* ws;
    int tid, lane, wave, bid, nblk, gw, ngw;
};

__device__ __forceinline__ void ln_row(const float* yrow, const float* g, const float* b, float* xrow, bf16* urow, const float* shift, const float* scale, float* orow, int lane) {
    f32x4 v[8]; float s = 0.f;
#pragma unroll
    for (int i = 0; i < 8; ++i) { v[i] = *(const f32x4*)(yrow + i * 256 + lane * 4); s += (v[i][0] + v[i][1]) + (v[i][2] + v[i][3]); }
    const float mean = wave_sum(s) * (1.f / D); float s2 = 0.f;
#pragma unroll
    for (int i = 0; i < 8; ++i) { v[i] = v[i] - mean; s2 += (v[i][0] * v[i][0] + v[i][1] * v[i][1]) + (v[i][2] * v[i][2] + v[i][3] * v[i][3]); }
    const float rstd = rsqrtf(wave_sum(s2) * (1.f / D) + LN_EPS);
#pragma unroll
    for (int i = 0; i < 8; ++i) { const int c = i * 256 + lane * 4;
        const f32x4 o = v[i] * rstd * *(const f32x4*)(g + c) + *(const f32x4*)(b + c);
        *(f32x4*)(xrow + c) = o;
        if (orow) *(f32x4*)(orow + c) = o;
        if (urow) { const f32x4 u = o * (*(const f32x4*)(scale + c) + 1.0f) + *(const f32x4*)(shift + c); *(u32x2*)(urow + c) = (u32x2){pk2(u[0], u[1]), pk2(u[2], u[3])}; } }
}

template <int NV, bool BAND>
__device__ __forceinline__ void softmax_row(float* row, int t, bool has_sink, float sink, int lane) {
    f32x4 v[NV]; float mx = -3.0e38f;
#pragma unroll
    for (int i = 0; i < NV; ++i) { v[i] = *(const f32x4*)(row + i * 256 + lane * 4);
#pragma unroll
        for (int e = 0; e < 4; ++e) { if (BAND) { const int s = i * 256 + lane * 4 + e; const int dlt = t - s; const bool ok = (s >= 1024) || (dlt <= 128 && dlt >= -128); if (!ok) v[i][e] = -3.0e38f; } mx = fmaxf(mx, v[i][e]); } }
    mx = wave_max(mx); if (has_sink) mx = fmaxf(mx, sink);
    float sum = 0.f;
#pragma unroll
    for (int i = 0; i < NV; ++i)
#pragma unroll
        for (int e = 0; e < 4; ++e) { const float p = (v[i][e] < -1.0e38f) ? 0.f : __expf(v[i][e] - mx); v[i][e] = p; sum += p; }
    sum = wave_sum(sum); if (has_sink) sum += __expf(sink - mx);
    const float inv = 1.f / sum;
    bf16* prow = (bf16*)row;
#pragma unroll
    for (int i = 0; i < NV; ++i) *(u32x2*)(prow + i * 256 + lane * 4) = (u32x2){pk2(v[i][0] * inv, v[i][1] * inv), pk2(v[i][2] * inv, v[i][3] * inv)};
}

__device__ __forceinline__ void transpose_item(const float* W, int K, int N, bf16* WT, int row_off, LAS float* scr, int item, int lane) {
    const int nblkn = N / 32, kb = item / nblkn, nb = item % nblkn, k0 = 64 * kb, n0 = 32 * nb;
#pragma unroll 8
    for (int i = 0; i < 32; ++i) { const int kk = 2 * i + (lane >> 5); scr[kk * 33 + (lane & 31)] = W[(size_t)(k0 + kk) * N + n0 + (lane & 31)]; }
    LDS_WAIT();
    const int c = lane & 7;
#pragma unroll
    for (int j = 0; j < 4; ++j) { const int n = (lane >> 3) + 8 * j; const LAS float* s = scr + (8 * c) * 33 + n;
        u32x4 o; o.x = pk2(s[0 * 33], s[1 * 33]); o.y = pk2(s[2 * 33], s[3 * 33]); o.z = pk2(s[4 * 33], s[5 * 33]); o.w = pk2(s[6 * 33], s[7 * 33]);
        *(u32x4*)(WT + (size_t)(row_off + n0 + n) * K + k0 + 8 * c) = o; }
    LDS_WAIT();
}

__device__ __forceinline__ int cflat(int l) {
    int a = 0, base = 0;
    if (l >= 16) { a = 1; base = 16; } if (l >= 24) { a = 2; base = 24; } if (l >= 29) { a = 3; base = 29; } if (l >= 33) { a = 4; base = 33; }
    if (l >= 36) { a = 5; base = 36; } if (l >= 38) { a = 6; base = 38; } if (l >= 40) { a = 7; base = 40; } if (l >= 42) { a = 8 + (l - 42); base = l; }
    return l < 50 ? a * 16 + (l - base) : 9999;
}
#if !MK_PER_PHASE
#define SYNC() xcd_barrier(bar)
#else
#define SYNC() do {} while (0)
#endif
#define PH_BEGIN unsigned char* ws = opq(ws_)
#define IP(i) opq(args.in[i])
#define MODS ((float*)(ws + WS_MODS))
#define ROPET ((float*)(ws + WS_MODS + 640 * 1024))
#define X ((float*)(ws + WS_X))
#define Y ((float*)(ws + WS_Y))
#define Ub ((bf16*)(ws + WS_U))
#define Ob ((bf16*)(ws + WS_O))
#define SCR (ws + WS_SCR)
#define IN(k) (lo <= (k) && (k) < hi)
#define ENDPH(k) do { if (hi > (k) + 1) SYNC(); } while (0)
template <int L>
__device__ __forceinline__ void layer_phases(const Args& args, const Frame& F, unsigned char* const ws_, const int lo, const int hi, const XcdBarrier& bar) {
    int ub;
        const int P = 2 + L * 16;
#define modL (MODS + L * 3 * 12288)
        if constexpr (L == 0) {
#define T0 ((float*)SCR)
#define QN ((bf16*)(ws + WS_QN))
#define CKV ((bf16*)(ws + WS_CKV))
#define Qb ((bf16*)(ws + WS_Q))
#define KC ((bf16*)(ws + WS_KC))
#define VT ((bf16*)(ws + WS_VT))
#define SCp ((float*)SCR)
#define SCs ((float*)(SCR + 64 * MiB))
            if (IN(P + 0)) { PH_BEGIN;
                ub = 0; GemmP g{Ub, (const bf16*)(ws + WS_W0T), D, D, 0, 0, 0, 0, 0, 0, MT, 1280, D, 1, 1, 1};
                pg8::gemm_phase(F.lds, g, EpiF32N{T0, 1088, 1088}, F.bid, F.nblk, ub);
                ENDPH(P + 0);
            }
            if (IN(P + 1)) { PH_BEGIN;
                const float* qg = IP(I_QNORM); const float* kg = IP(I_KVNORM);
                for (int m = F.gw; m < MT; m += F.ngw) {
                    const float* tr = T0 + (size_t)m * 1088; const int kvr = kvrow_of(m); const int c = F.lane * 8;
                    { f32x4 a = *(const f32x4*)(tr + c), b = *(const f32x4*)(tr + c + 4);
                      float ss = (a[0] * a[0] + a[1] * a[1]) + (a[2] * a[2] + a[3] * a[3]) + (b[0] * b[0] + b[1] * b[1]) + (b[2] * b[2] + b[3] * b[3]);
                      const float r = rsqrtf(wave_sum(ss) * (1.f / 512.f) + RMS_EPS);
                      a = a * r * *(const f32x4*)(qg + c); b = b * r * *(const f32x4*)(qg + c + 4);
                      *(u32x4*)(QN + (size_t)m * 512 + c) = (u32x4){pk2(a[0], a[1]), pk2(a[2], a[3]), pk2(b[0], b[1]), pk2(b[2], b[3])}; }
                    { f32x4 a = *(const f32x4*)(tr + 512 + c), b = *(const f32x4*)(tr + 512 + c + 4);
                      float ss = (a[0] * a[0] + a[1] * a[1]) + (a[2] * a[2] + a[3] * a[3]) + (b[0] * b[0] + b[1] * b[1]) + (b[2] * b[2] + b[3] * b[3]);
                      const float r = rsqrtf(wave_sum(ss) * (1.f / 512.f) + RMS_EPS);
                      a = a * r * *(const f32x4*)(kg + c); b = b * r * *(const f32x4*)(kg + c + 4);
                      *(u32x4*)(CKV + (size_t)kvr * 512 + c) = (u32x4){pk2(a[0], a[1]), pk2(a[2], a[3]), pk2(b[0], b[1]), pk2(b[2], b[3])};
                      if (m < NPR) { float* o = args.out + OUT_CKV + (size_t)m * 512 + c; *(f32x4*)o = a; *(f32x4*)(o + 4) = b; } }
                    { float x = tr[1024 + F.lane];
                      if (m < NPR) args.out[OUT_KR + (size_t)m * 64 + F.lane] = x;
                      else { const int t = (m - NPR) & 1023, e = F.lane, j = e & 15; const int pos = (e < 32) ? (t >> 6) : (t & 63);
                          const float cs = ROPET[pos * 16 + j], sn = ROPET[1024 + pos * 16 + j];
                          const float pr = __shfl_xor(x, 16); x = ((e & 16) == 0) ? (x * cs - pr * sn) : (pr * sn + x * cs); }
                      const bf16 xb = (bf16)f2bf(x);
#pragma unroll
                      for (int h = 0; h < 16; ++h) KC[((size_t)kvr * 16 + h) * 192 + 128 + F.lane] = xb; }
                }
                ENDPH(P + 1);
            }
            if (IN(P + 2)) { PH_BEGIN;
                ub = 0; GemmP g{QN, (const bf16*)(ws + WS_WUQT), 512, 512, 0, 0, 0, 0, 0, 0, MT, 3072, 512, 1, 1, 1};
                pg8::gemm_phase(F.lds, g, EpiQMla{Qb, ROPET}, F.bid, F.nblk, ub);
                GemmP g2{CKV, (const bf16*)(ws + WS_WUKT), 512, 512, 0, 0, 0, 0, 0, 0, KVR, 2048, 512, 1, 1, 1};
                pg8::gemm_phase(F.lds, g2, EpiKn{KC}, F.bid, F.nblk, ub);
                GemmP g3{(const bf16*)(ws + WS_WUVT), CKV, 512, 512, 0, 0, 0, 0, 0, 0, 2048, KVR, 512, 1, 1, 1};
                pg8::gemm_phase(F.lds, g3, EpiBf16{VT, KVR, 0, 0, 0, 1.f}, F.bid, F.nblk, ub);
                ENDPH(P + 2);
            }
            if (IN(P + 3)) { PH_BEGIN;
                ub = 0;
                GemmP gp{Qb, KC, 3072, 3072, 256L * 3072, 192, 0, 256L * 3072, 192, 0, 256, 256, 192, 16, 16, 1};
                sg_gemm(F.lds, gp, EpiF32{SCp, 256, 16L * 256 * 256, 256L * 256, 0, MLA_SCALE}, F.bid, F.nblk, ub);
                GemmP gs{Qb + (size_t)NPR * 3072, KC + (size_t)NPR * 3072, 3072, 3072, 1024L * 3072, 192, 0, 1280L * 3072, 192, 0, 1024, 1280, 192, 2, 16, 1};
                sg_gemm(F.lds, gs, EpiF32{SCs, 1280, 16L * 1024 * 1280, 1024L * 1280, 0, MLA_SCALE}, F.bid, F.nblk, ub);
                ENDPH(P + 3);
            }
            if (IN(P + 4)) { PH_BEGIN;
                for (int r = F.gw; r < 16 * 16 * 256; r += F.ngw) softmax_row<1, false>(SCp + (size_t)r * 256, 0, false, 0.f, F.lane);
                for (int r = F.gw; r < 2 * 16 * 1024; r += F.ngw) softmax_row<5, false>(SCs + (size_t)r * 1280, 0, false, 0.f, F.lane);
                ENDPH(P + 4);
            }
            if (IN(P + 5)) { PH_BEGIN;
                ub = 0;
                GemmP gp{(const bf16*)SCp, VT, 512, KVR, 16L * 256 * 512, 256L * 512, 0, 256, 128L * KVR, 0, 256, 128, 256, 16, 16, 1};
                sg_gemm(F.lds, gp, EpiBf16{Ob, D, 256L * D, 128, 0, 1.f}, F.bid, F.nblk, ub);
                GemmP gs{(const bf16*)SCs, VT + NPR, 2560, KVR, 16L * 1024 * 2560, 1024L * 2560, 0, 1280, 128L * KVR, 0, 1024, 128, 1280, 2, 16, 1};
                sg_gemm(F.lds, gs, EpiBf16{Ob + (size_t)NPR * D, D, 1024L * D, 128, 0, 1.f}, F.bid, F.nblk, ub);
                ENDPH(P + 5);
            }
        } else if constexpr (L == 1) {
#undef SCs
#define SCs ((float*)(SCR + 128 * MiB))
#define Q1 ((bf16*)(ws + WS_Q))
#define K1 ((bf16*)(ws + WS_KC))
#define VT1 ((bf16*)(ws + WS_VT))
            if (IN(P + 0)) { PH_BEGIN;
                const int gt = F.bid * NTHR + F.tid, ngt = F.nblk * NTHR;
                { const float* c1 = IP(I_C1K);
                  for (int i = gt; i < 2 * 256 * 512; i += ngt) { const int b = i >> 17, r = i & 131071; K1[(size_t)(NPR + b * 1280 + 1024) * 512 + r] = (bf16)f2bf(c1[i]); } }
                { const float* c1 = IP(I_C1V);
                  for (int i = gt; i < 2 * 256 * 512; i += ngt) { const int b = i >> 17, s = (i >> 9) & 255, c = i & 511; VT1[(size_t)c * KVR + NPR + b * 1280 + 1024 + s] = (bf16)f2bf(c1[i]); } }
                ub = 0; GemmP g{Ub, (const bf16*)(ws + WS_WQKVT), D, D, 0, 0, 0, 0, 0, 0, MT, 3072, D, 1, 1, 1};
                pg8::gemm_phase(F.lds, g, EpiQkv1{Q1, K1, VT1, args.out + OUT_K1, args.out + OUT_V1, ROPET}, F.bid, F.nblk, ub);
                ENDPH(P + 0);
            }
            if (IN(P + 3)) { PH_BEGIN;
                ub = 0;
                GemmP gp{Q1, K1, D, 512, 256L * D, 256, 64, 256L * 512, 64, 0, 256, 256, 64, 16, 8, 4};
                sg_gemm(F.lds, gp, EpiF32{SCp, 256, 32L * 256 * 256, 4L * 256 * 256, 256L * 256, GQA_SCALE}, F.bid, F.nblk, ub);
                GemmP gs{Q1 + (size_t)NPR * D, K1 + (size_t)NPR * 512, D, 512, 1024L * D, 256, 64, 1280L * 512, 64, 0, 1024, 1280, 64, 2, 8, 4};
                sg_gemm(F.lds, gs, EpiF32{SCs, 1280, 32L * 1024 * 1280, 4L * 1024 * 1280, 1024L * 1280, GQA_SCALE}, F.bid, F.nblk, ub);
                ENDPH(P + 3);
            }
            if (IN(P + 4)) { PH_BEGIN;
                const float* sink = IP(I_SINK);
                for (int r = F.gw; r < 16 * 32 * 256; r += F.ngw) softmax_row<1, false>(SCp + (size_t)r * 256, 0, true, sink[(r >> 8) & 31], F.lane);
                for (int r = F.gw; r < 2 * 32 * 1024; r += F.ngw) softmax_row<5, true>(SCs + (size_t)r * 1280, r & 1023, true, sink[(r >> 10) & 31], F.lane);
                ENDPH(P + 4);
            }
            if (IN(P + 5)) { PH_BEGIN;
                ub = 0;
                GemmP gp{(const bf16*)SCp, VT1, 512, KVR, 32L * 256 * 512, 4L * 256 * 512, 256L * 512, 256, 64L * KVR, 0, 256, 64, 256, 16, 8, 4};
                sg_gemm(F.lds, gp, EpiBf16{Ob, D, 256L * D, 256, 64, 1.f}, F.bid, F.nblk, ub);
                GemmP gs{(const bf16*)SCs, VT1 + NPR, 2560, KVR, 32L * 1024 * 2560, 4L * 1024 * 2560, 1024L * 2560, 1280, 64L * KVR, 0, 1024, 64, 1280, 2, 8, 4};
                sg_gemm(F.lds, gs, EpiBf16{Ob + (size_t)NPR * D, D, 1024L * D, 256, 64, 1.f}, F.bid, F.nblk, ub);
                ENDPH(P + 5);
            }
        } else if constexpr (L == 2) {
#define YTp ((bf16*)SCR)
#define YTs ((bf16*)(SCR + 32 * MiB))
            if (IN(P + 0)) { PH_BEGIN;
                ub = 0; GemmP g{(const bf16*)(ws + WS_CS512), Ub, 512, D, 0, 0, 0, 512, 0, 0, 1024, MT, 512, 4, 1, 1};
                pg8::gemm_phase(F.lds, g, EpiDft1{YTp, YTs}, F.bid, F.nblk, ub);
                ENDPH(P + 0);
            }
            if (IN(P + 5)) { PH_BEGIN;
                ub = 0;
                GemmP gp{(const bf16*)(ws + WS_CT256), YTp, 512, 512, 0, 0, 0, 2048L * 512, 0, 0, 256, 2048, 512, 16, 1, 1};
                pg8::gemm_phase(F.lds, gp, EpiBf16{Ob, D, 256L * D, 0, 0, 0.0027621358640099515f}, F.bid, F.nblk, ub);
                GemmP gs{(const bf16*)(ws + WS_CT1024), YTs, 2048, 2048, 0, 0, 0, 2048L * 2048, 0, 0, 1024, 2048, 2048, 2, 1, 1};
                pg8::gemm_phase(F.lds, gs, EpiBf16{Ob + (size_t)NPR * D, D, 1024L * D, 0, 0, 0.0013810679320049757f}, F.bid, F.nblk, ub);
                ENDPH(P + 5);
            }
        } else {
#define BCH ((bf16*)SCR)
            if (IN(P + 0)) { PH_BEGIN;
                ub = 0; GemmP g{Ub, (const bf16*)(ws + WS_WINT), D, D, 0, 0, 0, 0, 0, 0, MT, 6144, D, 1, 1, 1};
                pg8::gemm_phase(F.lds, g, EpiBf16{BCH, 6144, 0, 0, 0, 1.f}, F.bid, F.nblk, ub);
                ENDPH(P + 0);
            }
            if (IN(P + 5)) { PH_BEGIN;
                const float* cw = IP(I_CONVW); const float* cb = IP(I_CONVB);
                for (int m = F.gw; m < MT; m += F.ngw) {
                    const int t = (m < NPR) ? (m & 255) : ((m - NPR) & 1023); const int T = (m < NPR) ? 256 : 1024;
                    const bool hasp = t > 0, hasn = t < T - 1;
#pragma unroll
                    for (int i = 0; i < 4; ++i) { const int c = i * 512 + F.lane * 8; const bf16* r0 = BCH + (size_t)m * 6144 + c;
                        const u32x4 bb = *(const u32x4*)r0, cc = *(const u32x4*)(r0 + 2048), hh = *(const u32x4*)(r0 + 4096);
                        u32x4 cp = {0u, 0u, 0u, 0u}, hp = cp, cn = cp, hn = cp;
                        if (hasp) { cp = *(const u32x4*)(r0 - 6144 + 2048); hp = *(const u32x4*)(r0 - 6144 + 4096); }
                        if (hasn) { cn = *(const u32x4*)(r0 + 6144 + 2048); hn = *(const u32x4*)(r0 + 6144 + 4096); }
                        unsigned o[4];
#pragma unroll
                        for (int q = 0; q < 4; ++q) { const int d = c + 2 * q;
                            const float z0l = bflo(cp[q]) * bflo(hp[q]), z0h = bfhi(cp[q]) * bfhi(hp[q]);
                            const float z1l = bflo(cc[q]) * bflo(hh[q]), z1h = bfhi(cc[q]) * bfhi(hh[q]);
                            const float z2l = bflo(cn[q]) * bflo(hn[q]), z2h = bfhi(cn[q]) * bfhi(hn[q]);
                            const float yl = bflo(bb[q]) * (cw[d] * z0l + cw[D + d] * z1l + cw[2 * D + d] * z2l + cb[d]);
                            const float yh = bfhi(bb[q]) * (cw[d + 1] * z0h + cw[D + d + 1] * z1h + cw[2 * D + d + 1] * z2h + cb[d + 1]);
                            o[q] = pk2(yl, yh); }
                        *(u32x4*)(Ob + (size_t)m * D + c) = (u32x4){o[0], o[1], o[2], o[3]}; }
                }
                ENDPH(P + 5);
            }
        }
        if (IN(P + 6)) { PH_BEGIN;
            const size_t wofs = (L == 0) ? WS_WOT0 : (L == 1) ? WS_WOT1 : (L == 2) ? WS_WFT : WS_WCOT;
            ub = 0; GemmP g{Ob, (const bf16*)(ws + wofs), D, D, 0, 0, 0, 0, 0, 0, MT, D, D, 1, 1, 1};
            pg8::gemm_phase(F.lds, g, EpiResid{Y, X, modL + 2 * D}, F.bid, F.nblk, ub);
            ENDPH(P + 6);
        }
        if (IN(P + 7)) { PH_BEGIN;
            const float* g1 = IP(I_LN1G) + L * D; const float* b1 = IP(I_LN1B) + L * D;
            for (int m = F.gw; m < MT; m += F.ngw) { const float* md = modL + cond_of(m) * 12288;
                ln_row(Y + (size_t)m * D, g1, b1, X + (size_t)m * D, Ub + (size_t)m * D, md + 3 * D, md + 4 * D, nullptr, F.lane); }
            ENDPH(P + 7);
        }
#define PS ((float*)(SCR + 24 * MiB))
#define PU4 ((unsigned char*)(ws + WS_PU))
#define PV4 ((unsigned char*)(ws + WS_PV))
#define SU4 ((bf16*)(ws + WS_PU + 16 * MiB))
#define SV4 ((bf16*)(ws + WS_PV + 16 * MiB))
#define TKI ((int*)(SCR + 80 * MiB))
#define TKG ((float*)(SCR + 84 * MiB))
        if (IN(P + 8)) { PH_BEGIN;
            ub = 0; GemmP g{Ub, (const bf16*)(ws + WS_WPQT) + (size_t)L * D * D, D, D, 0, 0, 0, 0, 0, 0, MT, D, D, 1, 1, 1};
            pg8::gemm_phase(F.lds, g, EpiF32{PS, D, 0, 0, 0, 1.f}, F.bid, F.nblk, ub);
            ENDPH(P + 8);
        }
        if (IN(P + 9)) { PH_BEGIN;
            LAS float* wl = (LAS float*)(F.lds + F.wave * 12288); LAS float* psl = wl + 1024;
            LAS float* sv = wl; LAS int* si = (LAS int*)(wl + 256); LAS float* ts = wl + 512; LAS int* te = (LAS int*)(wl + 640); LAS float* cl = wl + 896;
            int ca, cbb;
            { const int l = F.lane; int a = 0, base = 0;
              if (l >= 16) { a = 1; base = 16; } if (l >= 24) { a = 2; base = 24; } if (l >= 29) { a = 3; base = 29; } if (l >= 33) { a = 4; base = 33; }
              if (l >= 36) { a = 5; base = 36; } if (l >= 38) { a = 6; base = 38; } if (l >= 40) { a = 7; base = 40; } if (l >= 42) { a = 8 + (l - 42); base = l; }
              ca = a; cbb = l - base; }
            const bool cvalid = F.lane < 50;
            const float* pu = IP(I_PEERU) + (size_t)L * 16384 * D; const float* pv = IP(I_PEERV) + (size_t)L * 16384 * D;
            int crow = F.gw;
            auto convert_rows = [&](int nrows) {
                for (int it = 0; it < nrows && crow < 32768; ++it, crow += F.ngw) {
                    const bool isv = crow >= 16384; const int e = crow & 16383;
                    const GAS float* src = (const GAS float*)((isv ? pv : pu) + (size_t)e * D) + F.lane * 4;
                    f32x4 v[8]; float mx = 0.f;
#pragma unroll
                    for (int j = 0; j < 8; ++j) { v[j] = *(const GAS f32x4*)(src + j * 256);
                        mx = fmaxf(mx, fmaxf(fmaxf(fabsf(v[j][0]), fabsf(v[j][1])), fmaxf(fabsf(v[j][2]), fabsf(v[j][3])))); }
                    const unsigned sb = f2bf(mx * (1.00390625f / 6.0f)); const float sq = __uint_as_float(sb << 16);
                    const float inv = sq > 0.f ? 1.0f / sq : 0.f;
                    u32x4 o;
#pragma unroll
                    for (int d = 0; d < 4; ++d) { unsigned w = 0u;
                        w = __builtin_amdgcn_cvt_scalef32_pk_fp4_f32(w, v[2 * d][0] * inv, v[2 * d][1] * inv, 1.0f, 0);
                        w = __builtin_amdgcn_cvt_scalef32_pk_fp4_f32(w, v[2 * d][2] * inv, v[2 * d][3] * inv, 1.0f, 1);
                        w = __builtin_amdgcn_cvt_scalef32_pk_fp4_f32(w, v[2 * d + 1][0] * inv, v[2 * d + 1][1] * inv, 1.0f, 2);
                        w = __builtin_amdgcn_cvt_scalef32_pk_fp4_f32(w, v[2 * d + 1][2] * inv, v[2 * d + 1][3] * inv, 1.0f, 3);
                        o[d] = w; }
                    *(GAS u32x4*)((GAS unsigned char*)((isv ? PV4 : PU4) + (size_t)e * 1024) + F.lane * 16) = o;
                    ((GAS bf16*)((isv ? SV4 : SU4) + (size_t)e * 64))[F.lane] = (bf16)sb;
                } };
            for (int m = F.gw; m < MT; m += F.ngw) {
                const float* ps = PS + (size_t)m * D;
#pragma unroll
                for (int i = 0; i < 8; ++i) *(LAS f32x4*)(psl + i * 256 + F.lane * 4) = *(const GAS f32x4*)((const GAS float*)ps + (unsigned)(i * 256 + F.lane * 4));
                LDS_WAIT();
                for (int q = 0; q < 16; ++q) {
                    const LAS float* pl = psl + q * 128;
                    const float sa = pl[F.lane], sb = pl[64 + F.lane];
                    int ra = 0, rb = 0;
#pragma unroll 4
                    for (int j4 = 0; j4 < 16; ++j4) {
                        const f32x4 va4 = *(const LAS f32x4*)(pl + j4 * 4), vb4 = *(const LAS f32x4*)(pl + 64 + j4 * 4);
#pragma unroll
                        for (int e = 0; e < 4; ++e) { const int j = j4 * 4 + e; const float va = va4[e], vb = vb4[e];
                            ra += (va > sa || (va == sa && j < F.lane)) ? 1 : 0; ra += (vb > sa) ? 1 : 0;
                            rb += (va >= sb) ? 1 : 0; rb += (vb > sb || (vb == sb && j < F.lane)) ? 1 : 0; } }
                    if (ra < 16) { sv[q * 16 + ra] = sa; si[q * 16 + ra] = F.lane; }
                    if (rb < 16) { sv[q * 16 + rb] = sb; si[q * 16 + rb] = 64 + F.lane; }
                }
                LDS_WAIT();
                for (int h = 0; h < 8; ++h) {
                    float cv = -3.0e38f; int cf = 9999, ce = 0;
                    if (cvalid) { cv = sv[(2 * h) * 16 + ca] + sv[(2 * h + 1) * 16 + cbb]; cf = ca * 16 + cbb; ce = si[(2 * h) * 16 + ca] * 128 + si[(2 * h + 1) * 16 + cbb]; }
                    cl[F.lane] = cv; LDS_WAIT();
                    int rk = 0;
#pragma unroll 4
                    for (int j4 = 0; j4 < 13; ++j4) { const f32x4 v4 = *(const LAS f32x4*)(cl + j4 * 4);
#pragma unroll
                        for (int e = 0; e < 4; ++e) { const int j = j4 * 4 + e; const float vj = v4[e]; const int fj = cflat(j);
                            rk += (vj > cv || (vj == cv && fj < cf)) ? 1 : 0; } }
                    if (cvalid && rk < 16) { ts[h * 16 + rk] = cv; te[h * 16 + rk] = ce; }
                }
                LDS_WAIT();
#pragma unroll
                for (int q = 0; q < 2; ++q) { const int e = q * 64 + F.lane; const float sx = ts[e]; float mx = sx;
#pragma unroll
                    for (int o = 1; o < 16; o <<= 1) mx = fmaxf(mx, __shfl_xor(mx, o));
                    const float p = __expf(sx - mx); float sm = p;
#pragma unroll
                    for (int o = 1; o < 16; o <<= 1) sm += __shfl_xor(sm, o);
                    ((GAS float*)TKG)[(unsigned)(m * 128 + e)] = p / sm; ((GAS int*)TKI)[(unsigned)(m * 128 + e)] = te[e]; }
                convert_rows(6);
            }
            convert_rows(1 << 20);
            ENDPH(P + 9);
        }
        if (IN(P + 10)) { PH_BEGIN;
            const float* g2 = IP(I_LN2G) + L * D; const float* b2 = IP(I_LN2B) + L * D;
            const GAS unsigned char* pu4 = (const GAS unsigned char*)PU4 + F.lane * 16; const GAS unsigned char* pv4 = (const GAS unsigned char*)PV4 + F.lane * 16;
            const GAS bf16* su4 = (const GAS bf16*)SU4 + F.lane; const GAS bf16* sv4 = (const GAS bf16*)SV4 + F.lane;
            for (int m = F.gw; m < MT; m += F.ngw) {
                const int idA = ((const GAS int*)TKI)[(unsigned)(m * 128 + F.lane)], idB = ((const GAS int*)TKI)[(unsigned)(m * 128 + 64 + F.lane)];
                const float gtA = ((const GAS float*)TKG)[(unsigned)(m * 128 + F.lane)], gtB = ((const GAS float*)TKG)[(unsigned)(m * 128 + 64 + F.lane)];
                float xf[8][4];
#pragma unroll
                for (int j = 0; j < 8; ++j) { const u32x2 w = *(const GAS u32x2*)((const GAS bf16*)Ub + (size_t)m * D + (unsigned)(j * 256 + F.lane * 4));
                    xf[j][0] = bflo(w[0]); xf[j][1] = bfhi(w[0]); xf[j][2] = bflo(w[1]); xf[j][3] = bfhi(w[1]); }
                float fa[8][4];
#pragma unroll
                for (int j = 0; j < 8; ++j)
#pragma unroll
                    for (int e = 0; e < 4; ++e) fa[j][e] = 0.f;
                struct GBuf { u32x4 u[4], v[4]; unsigned short su[4], sv[4]; float g[4]; };
                auto gload = [&](GBuf& B, int eg) {
#pragma unroll
                    for (int q = 0; q < 4; ++q) { const int e = eg + q;
                        const int ex = (e < 64) ? __builtin_amdgcn_readlane(idA, e & 63) : __builtin_amdgcn_readlane(idB, e & 63);
                        B.g[q] = __builtin_bit_cast(float, (e < 64) ? __builtin_amdgcn_readlane(__builtin_bit_cast(int, gtA), e & 63) : __builtin_amdgcn_readlane(__builtin_bit_cast(int, gtB), e & 63));
                        B.u[q] = *(const GAS u32x4*)(pu4 + (size_t)ex * 1024); B.v[q] = *(const GAS u32x4*)(pv4 + (size_t)ex * 1024);
                        B.su[q] = su4[(size_t)ex * 64]; B.sv[q] = sv4[(size_t)ex * 64]; } };
                auto gcomp = [&](const GBuf& B) {
#pragma unroll
                    for (int q = 0; q < 4; ++q) {
                        float h0 = 0.f, h1 = 0.f;
#pragma unroll
                        for (int d = 0; d < 4; ++d) { const unsigned w = B.u[q][d];
                            const f32x2 r0 = __builtin_amdgcn_cvt_scalef32_pk_f32_fp4(w, 1.0f, 0), r1 = __builtin_amdgcn_cvt_scalef32_pk_f32_fp4(w, 1.0f, 1),
                                        r2 = __builtin_amdgcn_cvt_scalef32_pk_f32_fp4(w, 1.0f, 2), r3 = __builtin_amdgcn_cvt_scalef32_pk_f32_fp4(w, 1.0f, 3);
                            h0 += r0[0] * xf[2 * d][0]; h1 += r0[1] * xf[2 * d][1]; h0 += r1[0] * xf[2 * d][2]; h1 += r1[1] * xf[2 * d][3];
                            h0 += r2[0] * xf[2 * d + 1][0]; h1 += r2[1] * xf[2 * d + 1][1]; h0 += r3[0] * xf[2 * d + 1][2]; h1 += r3[1] * xf[2 * d + 1][3]; }
                        const float hh = wave_sum((h0 + h1) * __uint_as_float((unsigned)B.su[q] << 16));
                        const float a = 0.5f * hh * (1.0f + erff(hh * 0.70710678118654752f)) * B.g[q] * __uint_as_float((unsigned)B.sv[q] << 16);
#pragma unroll
                        for (int d = 0; d < 4; ++d) { const unsigned w = B.v[q][d];
                            const f32x2 r0 = __builtin_amdgcn_cvt_scalef32_pk_f32_fp4(w, 1.0f, 0), r1 = __builtin_amdgcn_cvt_scalef32_pk_f32_fp4(w, 1.0f, 1),
                                        r2 = __builtin_amdgcn_cvt_scalef32_pk_f32_fp4(w, 1.0f, 2), r3 = __builtin_amdgcn_cvt_scalef32_pk_f32_fp4(w, 1.0f, 3);
                            fa[2 * d][0] += a * r0[0]; fa[2 * d][1] += a * r0[1]; fa[2 * d][2] += a * r1[0]; fa[2 * d][3] += a * r1[1];
                            fa[2 * d + 1][0] += a * r2[0]; fa[2 * d + 1][1] += a * r2[1]; fa[2 * d + 1][2] += a * r3[0]; fa[2 * d + 1][3] += a * r3[1]; }
                    } };
                {
                    GBuf A, B;
                    gload(A, 0);
                    for (int eg = 0; eg < 128; eg += 8) {
                        gload(B, eg + 4);
                        gcomp(A);
                        if (eg + 8 < 128) gload(A, eg + 8);
                        gcomp(B);
                    }
                }
                const int cnd = cond_of(m);
                const GAS float* gt2 = (const GAS float*)(modL + cnd * 12288 + 5 * D); GAS float* xrow = (GAS float*)(X + (size_t)m * D);
                const unsigned lo4 = (unsigned)F.lane * 4u;
                float s = 0.f;
#pragma unroll
                for (int j = 0; j < 8; ++j) { const unsigned c = lo4 + (unsigned)(j * 256);
                    const f32x4 x0 = *(const GAS f32x4*)(xrow + c), g0 = *(const GAS f32x4*)(gt2 + c);
#pragma unroll
                    for (int e = 0; e < 4; ++e) { fa[j][e] = ALPHA * x0[e] + g0[e] * fa[j][e]; s += fa[j][e]; } }
                const float mean = wave_sum(s) * (1.f / D); float s2 = 0.f;
#pragma unroll
                for (int j = 0; j < 8; ++j)
#pragma unroll
                    for (int e = 0; e < 4; ++e) { fa[j][e] -= mean; s2 += fa[j][e] * fa[j][e]; }
                const float rstd = rsqrtf(wave_sum(s2) * (1.f / D) + LN_EPS);
                const GAS float* mdn = (const GAS float*)(MODS + ((L < 3 ? L + 1 : L) * 3 + cnd) * 12288);
                const GAS float* g2g = (const GAS float*)g2; const GAS float* b2g = (const GAS float*)b2;
                GAS float* orow = (GAS float*)(args.out + OUT_Y + (size_t)m * D); GAS bf16* urow = (GAS bf16*)(Ub + (size_t)m * D);
#pragma unroll
                for (int j = 0; j < 8; ++j) { const unsigned c = lo4 + (unsigned)(j * 256);
                    const f32x4 f = {fa[j][0], fa[j][1], fa[j][2], fa[j][3]};
                    const f32x4 o = f * rstd * *(const GAS f32x4*)(g2g + c) + *(const GAS f32x4*)(b2g + c);
                    *(GAS f32x4*)(xrow + c) = o;
                    if (L == 3) *(GAS f32x4*)(orow + c) = o;
                    else { const f32x4 u = o * (*(const GAS f32x4*)(mdn + D + c) + 1.0f) + *(const GAS f32x4*)(mdn + c); *(GAS u32x2*)(urow + c) = (u32x2){pk2(u[0], u[1]), pk2(u[2], u[3])}; } }
            }
            ENDPH(P + 10);
        }
}

__global__ void __launch_bounds__(NTHR, 2) fwd(Args args) {
    extern __shared__ __attribute__((aligned(16))) unsigned char lds_raw[];
    Frame F;
    F.lds = (LAS unsigned char*)lds_raw; F.ws = args.ws;
    F.tid = threadIdx.x; F.lane = F.tid & 63; F.wave = __builtin_amdgcn_readfirstlane(F.tid >> 6);
    F.bid = blockIdx.x; F.nblk = gridDim.x; F.gw = F.bid * NWAVE + F.wave; F.ngw = F.nblk * NWAVE;
    unsigned char* const ws_ = args.ws;
    const int lo = args.ph_lo, hi = args.ph_hi;
    volatile LAS unsigned* MISC = (volatile LAS unsigned*)(F.lds + LDS_MISC);
    if (F.tid < 16) MISC[F.tid] = 0u;
    __syncthreads();
    XcdBarrier bar; bar.bar = (unsigned*)(ws_ + WS_CTL) + 4096; bar.x = 0; bar.st = MISC + 8;
#if !MK_PER_PHASE
    bar = xcd_barrier_post((unsigned*)(ws_ + WS_CTL) + 4096, MISC + 8);
#endif
    int ub;

    if (IN(0)) { PH_BEGIN;
        LAS float* sc = (LAS float*)F.lds;
        LAS float* part = (LAS float*)(F.lds + 24576);
        for (int i = F.tid; i < 3 * D; i += NTHR) { const int j = i >> 11, k = i & 2047; const float c = (j == 0) ? IP(I_CCTX)[k] : IP(I_C)[(j - 1) * D + k]; sc[i] = c / (1.f + __expf(-c)); }
        __syncthreads();
        const float* adaw = IP(I_ADAW); const float* adab = IP(I_ADAB);
        for (int u = F.bid; u < 768; u += F.nblk) {
            const int layer = u / 192, n0 = (u % 192) * 64, kr = F.lane >> 4, cq = F.lane & 15;
            f32x4 a0 = {0.f, 0.f, 0.f, 0.f}, a1 = a0, a2 = a0;
            const float* wp = adaw + ((size_t)layer * D + F.wave * 256 + kr) * 12288 + n0 + cq * 4;
#pragma unroll 8
            for (int it = 0; it < 64; ++it) { const f32x4 w = *(const f32x4*)(wp + (size_t)it * 4 * 12288); const int k = F.wave * 256 + it * 4 + kr;
                a0 += w * sc[k]; a1 += w * sc[D + k]; a2 += w * sc[2 * D + k]; }
#pragma unroll
            for (int e = 0; e < 4; ++e) { a0[e] += __shfl_xor(a0[e], 16); a0[e] += __shfl_xor(a0[e], 32); a1[e] += __shfl_xor(a1[e], 16); a1[e] += __shfl_xor(a1[e], 32); a2[e] += __shfl_xor(a2[e], 16); a2[e] += __shfl_xor(a2[e], 32); }
            if (F.lane < 16) {
#pragma unroll
                for (int e = 0; e < 4; ++e) { part[(F.wave * 3 + 0) * 64 + cq * 4 + e] = a0[e]; part[(F.wave * 3 + 1) * 64 + cq * 4 + e] = a1[e]; part[(F.wave * 3 + 2) * 64 + cq * 4 + e] = a2[e]; } }
            __syncthreads();
            if (F.tid < 192) { const int j = F.tid >> 6, c = F.tid & 63; float s = adab[layer * 12288 + n0 + c];
#pragma unroll
                for (int w = 0; w < 8; ++w) s += part[(w * 3 + j) * 64 + c];
                MODS[(layer * 3 + j) * 12288 + n0 + c] = s; }
            __syncthreads();
        }
        {
            LAS float* scr = (LAS float*)(F.lds + F.wave * 8448);
            for (int it = F.gw; it < args.tj_total; it += F.ngw) {
                int j = 0;
#pragma unroll
                for (int q = 1; q < NTJOB; ++q) j = (it >= args.tj[q].first) ? q : j;
                const TJob& J = args.tj[j];
                transpose_item(J.W, J.K, J.N, (bf16*)(ws + J.dst), J.row_off, scr, it - J.first, F.lane);
            }
        }
        const int gt = F.bid * NTHR + F.tid, ngt = F.nblk * NTHR;
        { const float* wq = IP(I_WPQ); bf16* WQb = (bf16*)SCR;
          for (int i = gt; i < 4 * 2048 * 2048 / 8; i += ngt) { const f32x4 a = *(const GAS f32x4*)((const GAS float*)wq + (size_t)i * 8), b = *(const GAS f32x4*)((const GAS float*)wq + (size_t)i * 8 + 4);
              *(GAS u32x4*)((GAS bf16*)WQb + (size_t)i * 8) = (u32x4){pk2(a[0], a[1]), pk2(a[2], a[3]), pk2(b[0], b[1]), pk2(b[2], b[3])}; } }
        if (gt < 1024) { const int pos = gt >> 4, j = gt & 15; const float inv = exp2f(-(float)j * (13.287712379549449f / 16.0f)); float sn, cs; sincosf((float)pos * inv, &sn, &cs);
            ROPET[gt] = cs; ROPET[1024 + gt] = sn; }
        { const float* sk = IP(I_SUBK); bf16* SK = (bf16*)(ws + WS_SK);
          for (int i = gt; i < 4 * 16 * 128 * 128 / 4; i += ngt) { const f32x4 v = *(const f32x4*)(sk + (size_t)i * 4); *(u32x2*)(SK + (size_t)i * 4) = (u32x2){pk2(v[0], v[1]), pk2(v[2], v[3])}; } }
        { bf16* CS = (bf16*)(ws + WS_CS512);
          for (int i = gt; i < 1024 * 512; i += ngt) { const int j = i >> 9, c = i & 511, r = ((j & 511) * c) & 511; const float x = (float)r * (1.f / 256.f); CS[i] = (bf16)f2bf(j < 512 ? cospif(x) : sinpif(x)); } }
        { bf16* CT = (bf16*)(ws + WS_CT256);
          for (int i = gt; i < 256 * 512; i += ngt) { const int t = i >> 9, k = i & 511, r = (t * (k & 255)) & 255; const float x = (float)r * (1.f / 128.f); CT[i] = (bf16)f2bf(k < 256 ? cospif(x) : -sinpif(x)); } }
        { bf16* CT = (bf16*)(ws + WS_CT1024);
          for (int i = gt; i < 1024 * 2048; i += ngt) { const int t = i >> 11, k = i & 2047, r = (t * (k & 1023)) & 1023; const float x = (float)r * (1.f / 512.f); CT[i] = (bf16)f2bf(k < 1024 ? cospif(x) : -sinpif(x)); } }
        { const float* c0 = IP(I_C0CKV); bf16* ckvp = (bf16*)(ws + WS_CKV);
          for (int i = gt; i < 2 * 256 * 512; i += ngt) { const int b = i >> 17, r = i & 131071; ckvp[(size_t)(NPR + b * 1280 + 1024) * 512 + r] = (bf16)f2bf(c0[i]); } }
        { const float* c0 = IP(I_C0KR); bf16* kcp = (bf16*)(ws + WS_KC);
          for (int i = gt; i < 2 * 256 * 64 * 16; i += ngt) { const int h = i & 15, e = i >> 4, j = e & 63, s = (e >> 6) & 255, b = e >> 14;
              kcp[((size_t)(NPR + b * 1280 + 1024 + s) * 16 + h) * 192 + 128 + j] = (bf16)f2bf(c0[e]); } }
        ENDPH(0);
    }
    if (IN(1)) { PH_BEGIN;
        for (int m = F.gw; m < MT; m += F.ngw) {
            const float* xr = (m < NPR) ? IP(I_XP) + (size_t)m * D : IP(I_XS) + (size_t)(m - NPR) * D;
            const float* md = MODS + cond_of(m) * 12288;
#pragma unroll
            for (int i = 0; i < 8; ++i) { const int c = i * 256 + F.lane * 4; const f32x4 v = *(const f32x4*)(xr + c);
                *(f32x4*)(X + (size_t)m * D + c) = v;
                const f32x4 u = v * (*(const f32x4*)(md + D + c) + 1.0f) + *(const f32x4*)(md + c);
                *(u32x2*)(Ub + (size_t)m * D + c) = (u32x2){pk2(u[0], u[1]), pk2(u[2], u[3])}; }
        }
        {
            int ub = 0; GemmP g{(const bf16*)(ws + WS_SK), (const bf16*)SCR, 128, D, 16L * 16384, 16384, 0, (long)D * D, 128, 0, 128, D, 128, 4, 16, 1};
            sg_gemm(F.lds, g, EpiBf16{(bf16*)(ws + WS_WPQT), D, (long)D * D, 128L * D, 0, 1.f}, F.bid, F.nblk, ub);
        }
        ENDPH(1);
    }

    layer_phases<0>(args, F, ws_, lo, hi, bar);
    layer_phases<1>(args, F, ws_, lo, hi, bar);
    layer_phases<2>(args, F, ws_, lo, hi, bar);
    layer_phases<3>(args, F, ws_, lo, hi, bar);
}

static const int kPhases[] = {0, 1,
    2, 3, 4, 5, 6, 7, 8, 9, 10, 11, 12,
    18, 21, 22, 23, 24, 25, 26, 27, 28,
    34, 39, 40, 41, 42, 43, 44,
    50, 55, 56, 57, 58, 59, 60};

extern "C" void kernel_launch(void* const* d_in, const int* in_sizes, int n_in, void* d_out, int out_size, void* d_ws, size_t ws_size, hipStream_t stream) {
    static int grid = 0;
    if (grid == 0) {
        if (n_in != 34 || ws_size < WS_END) { fprintf(stderr, "kernel_launch: unexpected n_in %d / ws_size %zu\n", n_in, ws_size); grid = -1; return; }
        int dev = 0, cus = 0;
        if (hipGetDevice(&dev) != hipSuccess || hipDeviceGetAttribute(&cus, hipDeviceAttributeMultiprocessorCount, dev) != hipSuccess) { grid = -1; return; }
        if (hipFuncSetAttribute((const void*)fwd, hipFuncAttributeMaxDynamicSharedMemorySize, LDS_BYTES) != hipSuccess) { fprintf(stderr, "kernel_launch: hipFuncSetAttribute failed\n"); grid = -1; return; }
        int per_cu = 0;
        if (hipOccupancyMaxActiveBlocksPerMultiprocessor(&per_cu, (const void*)fwd, NTHR, LDS_BYTES) != hipSuccess || per_cu < 1) fprintf(stderr, "kernel_launch: occupancy query says %d\n", per_cu);
        (void)hipGetLastError();
        grid = cus;
    }
    if (grid < 0) return;
    (void)hipMemsetAsync((char*)d_ws + WS_CTL, 0, CTL_BYTES, stream);
    Args a{};
    for (int i = 0; i < 34; ++i) a.in[i] = (const float*)d_in[i];
    a.out = (float*)d_out; a.ws = (unsigned char*)d_ws;
    {
        struct J { int idx; size_t sub; size_t dst; int K, N, row_off; };
        const J js[NTJOB] = {
            {I_WDQ, 0, WS_W0T, 2048, 512, 0}, {I_WDKV, 0, WS_W0T, 2048, 576, 512}, {I_WUQ, 0, WS_WUQT, 512, 3072, 0}, {I_WUK, 0, WS_WUKT, 512, 2048, 0},
            {I_WUV, 0, WS_WUVT, 512, 2048, 0}, {I_WO0, 0, WS_WOT0, 2048, 2048, 0}, {I_WQKV, 0, WS_WQKVT, 2048, 3072, 0}, {I_WO1, 0, WS_WOT1, 2048, 2048, 0},
            {I_WF, 0, WS_WFT, 2048, 2048, 0}, {I_WIN, 0, WS_WINT, 2048, 6144, 0}, {I_WCO, 0, WS_WCOT, 2048, 2048, 0}};
        int first = 0;
        for (int j = 0; j < NTJOB; ++j) { a.tj[j].W = (const float*)d_in[js[j].idx] + js[j].sub; a.tj[j].dst = js[j].dst; a.tj[j].K = js[j].K; a.tj[j].N = js[j].N; a.tj[j].row_off = js[j].row_off; a.tj[j].first = first;
            first += (js[j].K / 64) * (js[j].N / 32); }
        a.tj_total = first;
    }
#if MK_PER_PHASE
    for (size_t i = 0; i < sizeof(kPhases) / sizeof(kPhases[0]); ++i) {
        a.ph_lo = kPhases[i]; a.ph_hi = kPhases[i] + 1;
        hipLaunchKernelGGL(fwd, dim3(grid), dim3(NTHR), LDS_BYTES, stream, a);
    }
#else
    a.ph_lo = 0; a.ph_hi = 1 << 20;
    hipLaunchKernelGGL(fwd, dim3(grid), dim3(NTHR), LDS_BYTES, stream, a);
#endif
    const hipError_t le = hipPeekAtLastError();
    if (le != hipSuccess) fprintf(stderr, "kernel_launch: launch failed: %s\n", hipGetErrorName(le));
}
```

```cpp
#include <hip/hip_runtime.h>
#include <cstdio>
#include <cstdint>

#ifndef MK_PER_PHASE
#define MK_PER_PHASE 0
#endif

#define LAS __attribute__((address_space(3)))
typedef unsigned short bf16;
typedef short bf16x8 __attribute__((ext_vector_type(8)));
typedef float f32x4 __attribute__((ext_vector_type(4)));
typedef unsigned u32x4 __attribute__((ext_vector_type(4)));
typedef unsigned u32x2 __attribute__((ext_vector_type(2)));
typedef __bf16 bf16x2_t __attribute__((ext_vector_type(2)));
typedef float f32x2 __attribute__((ext_vector_type(2)));
#define GAS __attribute__((address_space(1)))
__device__ __forceinline__ unsigned pack_fp8x4(f32x4 a) { int w = __builtin_amdgcn_cvt_pk_fp8_f32(a[0], a[1], 0, false); w = __builtin_amdgcn_cvt_pk_fp8_f32(a[2], a[3], w, true); return (unsigned)w; }

constexpr int D = 2048, NPR = 4096, MT = 6144, KVR = 6656;
constexpr int NTHR = 512, NWAVE = 8;
constexpr float ALPHA = 1.6817928305074290f;
constexpr float MLA_SCALE = 0.07216878364870322f;
constexpr float GQA_SCALE = 0.125f;
constexpr float LN_EPS = 1e-5f, RMS_EPS = 1e-6f;

constexpr size_t MiB = 1u << 20;
constexpr size_t WS_CTL = 0, CTL_BYTES = 1 * MiB;
constexpr size_t WS_MODS = 1 * MiB;
constexpr size_t WS_W0T = 2 * MiB, WS_WUQT = 7 * MiB, WS_WUKT = 10 * MiB, WS_WUVT = 12 * MiB, WS_WOT0 = 14 * MiB, WS_WQKVT = 22 * MiB,
                 WS_WOT1 = 34 * MiB, WS_WFT = 42 * MiB, WS_WINT = 50 * MiB, WS_WCOT = 74 * MiB, WS_WPQT = 82 * MiB, WS_SK = 114 * MiB,
                 WS_CS512 = 116 * MiB, WS_CT256 = 117 * MiB, WS_CT1024 = 118 * MiB, WS_PU = 122 * MiB, WS_PV = 186 * MiB,
                 WS_X = 250 * MiB, WS_Y = 298 * MiB, WS_U = 346 * MiB, WS_O = 370 * MiB, WS_Q = 394 * MiB, WS_KC = 430 * MiB,
                 WS_VT = 469 * MiB, WS_QN = 495 * MiB, WS_CKV = 501 * MiB, WS_SCR = 508 * MiB, WS_END = 956 * MiB;
constexpr size_t OUT_Y = 0, OUT_CKV = 12582912, OUT_KR = 14680064, OUT_K1 = 14942208, OUT_V1 = 17039360;

constexpr int LDS_BYTES = 147456;
constexpr int LDS_MISC = 140 * 1024;

#define LDS_WAIT() asm volatile("s_waitcnt lgkmcnt(0)" ::: "memory")
__device__ __forceinline__ unsigned f2bf(float f) { unsigned u = __float_as_uint(f); return (u + 0x7fffu + ((u >> 16) & 1u)) >> 16; }
__device__ __forceinline__ unsigned pk2(float lo, float hi) { unsigned r; asm("v_cvt_pk_bf16_f32 %0, %1, %2" : "=v"(r) : "v"(lo), "v"(hi)); return r; }
__device__ __forceinline__ float bflo(unsigned w) { return __uint_as_float(w << 16); }
__device__ __forceinline__ float bfhi(unsigned w) { return __uint_as_float(w & 0xffff0000u); }
__device__ __forceinline__ float wave_sum(float v) {
#pragma unroll
    for (int o = 1; o < 64; o <<= 1) v += __shfl_xor(v, o);
    return v;
}
__device__ __forceinline__ float wave_max(float v) {
#pragma unroll
    for (int o = 1; o < 64; o <<= 1) v = fmaxf(v, __shfl_xor(v, o));
    return v;
}
__device__ __forceinline__ float dot2bf(unsigned w, unsigned x, float acc) {
    return __builtin_amdgcn_fdot2_f32_bf16(__builtin_bit_cast(bf16x2_t, w), __builtin_bit_cast(bf16x2_t, x), acc, false);
}
__device__ __forceinline__ int cond_of(int m) { return m < NPR ? 0 : 1 + ((m - NPR) >> 10); }
__device__ __forceinline__ int kvrow_of(int m) { return m < NPR ? m : NPR + ((m - NPR) >> 10) * 1280 + ((m - NPR) & 1023); }

#define XB_TMO      128
#define XB_XCNT(j)  (256  + 64 * (j))
#define XB_XSUB(j)  (1280 + 64 * (j))
#define XB_XGEN(j)  (2304 + 64 * (j))
#define XB_TOP      3328
#define XB_TOPGEN   3392
#define XCD_BAR_WORDS 3456
#define XB_SPIN_CAP (1u << 22)
__device__ __forceinline__ unsigned xb_ld(unsigned* p)              { return __hip_atomic_load(p, __ATOMIC_RELAXED, __HIP_MEMORY_SCOPE_AGENT); }
__device__ __forceinline__ unsigned xb_add(unsigned* p, unsigned v) { return __hip_atomic_fetch_add(p, v, __ATOMIC_RELAXED, __HIP_MEMORY_SCOPE_AGENT); }
__device__ __forceinline__ unsigned xb_xcc_id() { return (unsigned)__builtin_amdgcn_s_getreg((3 << 11) | 20) & 0xFu; }
#define XB_SPIN(cond, bar) do { unsigned _sp = 0; while (cond) { __builtin_amdgcn_s_sleep(1); \
    if ((++_sp & 255u) == 0u) { if (xb_ld(&(bar)[XB_TMO])) break; if (_sp > XB_SPIN_CAP) { atomicAdd(&(bar)[XB_TMO], 1u); break; } } } } while (0)
struct XcdBarrier { unsigned* bar; unsigned x; volatile LAS unsigned* st; };
__device__ __forceinline__ XcdBarrier xcd_barrier_post(unsigned* bar, volatile LAS unsigned* st) {
    XcdBarrier b; b.bar = bar; b.x = xb_xcc_id(); b.st = st;
    if (threadIdx.x == 0) (void)xb_add(&bar[XB_XCNT(b.x)], 1u);
    return b;
}
__device__ __forceinline__ void xcd_barrier_complete(unsigned* bar, unsigned x, unsigned& nloc, unsigned& nx) {
    const unsigned G = gridDim.x * gridDim.y * gridDim.z;
    unsigned sum, cnt, mine, sp = 0u;
    for (;;) {
        sum = 0u; cnt = 0u; mine = 0u;
#pragma unroll
        for (unsigned j = 0; j < 16; ++j) { const unsigned c = xb_ld(&bar[XB_XCNT(j)]); sum += c; cnt += (c > 0u) ? 1u : 0u; mine = (j == x) ? c : mine; }
        if (sum == G) break;
        __builtin_amdgcn_s_sleep(1);
        if ((++sp & 255u) == 0u) { if (xb_ld(&bar[XB_TMO])) break; if (sp > XB_SPIN_CAP) { atomicAdd(&bar[XB_TMO], 1u); break; } }
    }
    nloc = mine > 0u ? mine : 1u; nx = cnt > 0u ? cnt : 1u;
}
__device__ __forceinline__ void xcd_barrier(const XcdBarrier& b) {
    asm volatile("s_waitcnt vmcnt(0)" ::: "memory");
    __syncthreads();
    if (threadIdx.x == 0) {
        unsigned* bar = b.bar;
        __builtin_amdgcn_s_waitcnt(0);
        unsigned nloc = b.st[0], nx = b.st[1];
        if (nloc == 0u) { xcd_barrier_complete(bar, b.x, nloc, nx); b.st[0] = nloc; b.st[1] = nx; }
        const unsigned old = xb_add(&bar[XB_XSUB(b.x)], 1u);
        const unsigned gen = old / nloc;
        if (old + 1u == (gen + 1u) * nloc) {
            __builtin_amdgcn_fence(__ATOMIC_RELEASE, "agent");
            asm volatile("s_waitcnt vmcnt(0)" ::: "memory");
            const unsigned og = xb_add(&bar[XB_TOP], 1u);
            const unsigned tg = og / nx;
            if (og + 1u == (tg + 1u) * nx) xb_add(&bar[XB_TOPGEN], 1u);
            else XB_SPIN(xb_ld(&bar[XB_TOPGEN]) == tg, bar);
            __builtin_amdgcn_fence(__ATOMIC_ACQUIRE, "agent");
            xb_add(&bar[XB_XGEN(b.x)], 1u);
            asm volatile("s_waitcnt vmcnt(0)" ::: "memory");
        } else {
            XB_SPIN(xb_ld(&bar[XB_XGEN(b.x)]) == gen, bar);
            __builtin_amdgcn_fence(__ATOMIC_ACQUIRE, "agent");
            asm volatile("s_waitcnt vmcnt(0)" ::: "memory");
        }
    }
    __syncthreads();
}

struct TJob { const float* W; unsigned long long dst; int K, N, row_off, first; };
constexpr int NTJOB = 11;
struct Args {
    const float* in[34];
    float* out;
    unsigned char* ws;
    TJob tj[NTJOB];
    int tj_total;
    int ph_lo, ph_hi, pad;
};
enum { I_XP = 0, I_XS, I_C0CKV, I_C0KR, I_C1K, I_C1V, I_C, I_CCTX, I_ADAW, I_ADAB, I_LN1G, I_LN1B, I_LN2G, I_LN2B,
       I_WDQ, I_QNORM, I_WUQ, I_WDKV, I_KVNORM, I_WUK, I_WUV, I_WO0, I_WQKV, I_SINK, I_WO1, I_WF, I_WIN, I_CONVW, I_CONVB, I_WCO,
       I_WPQ, I_SUBK, I_PEERU, I_PEERV };

struct GemmP {
    const bf16* A; const bf16* B;
    long lda, ldb;
    long sA1, sA2, sA3, sB1, sB2, sB3;
    int M, N, K, nb1, nb2, nb3;
};
constexpr int SG_LDT = 72;
constexpr int SG_TILE = 128 * SG_LDT * 2;
template <class Epi>
__device__ __forceinline__ void sg_gemm(LAS unsigned char* lds, const GemmP g, const Epi& E, int bid, int nblk, int& ubase) {
    const int tid = threadIdx.x, lane = tid & 63, wave = __builtin_amdgcn_readfirstlane(tid >> 6);
    const int wm = wave >> 2, wn = wave & 3, fr = lane & 15, fq = lane >> 4;
    const int tiles_m = (g.M + 127) >> 7, tiles_n = (g.N + 127) >> 7;
    const int nbatch = g.nb1 * g.nb2 * g.nb3;
    const int U = nbatch * tiles_m * tiles_n;
    const int nk = g.K >> 6;
    int first = (bid - (ubase % nblk) + nblk) % nblk;
    ubase += U;
    const int lrow0 = tid >> 3, lkc = tid & 7;
    const int aoff = (wm * 64 + fr) * (SG_LDT * 2) + fq * 16;
    const int boff = (wn * 32 + fr) * (SG_LDT * 2) + fq * 16;
    for (int u = first; u < U; u += nblk) {
        const int tn = u % tiles_n; const int r1 = u / tiles_n; const int tm = r1 % tiles_m; const int b = r1 / tiles_m;
        const int b3 = b % g.nb3, b12 = b / g.nb3, b2 = b12 % g.nb2, b1 = b12 / g.nb2;
        const int m0 = tm << 7, n0 = tn << 7;
        const bf16* Ab = g.A + b1 * g.sA1 + b2 * g.sA2 + b3 * g.sA3;
        const bf16* Bb = g.B + b1 * g.sB1 + b2 * g.sB2 + b3 * g.sB3;
        int ar0 = m0 + lrow0, ar1 = ar0 + 64; ar0 = ar0 < g.M ? ar0 : g.M - 1; ar1 = ar1 < g.M ? ar1 : g.M - 1;
        int br0 = n0 + lrow0, br1 = br0 + 64; br0 = br0 < g.N ? br0 : g.N - 1; br1 = br1 < g.N ? br1 : g.N - 1;
        const bf16* pa0 = Ab + (long)ar0 * g.lda + lkc * 8; const bf16* pa1 = Ab + (long)ar1 * g.lda + lkc * 8;
        const bf16* pb0 = Bb + (long)br0 * g.ldb + lkc * 8; const bf16* pb1 = Bb + (long)br1 * g.ldb + lkc * 8;
        f32x4 acc[4][2];
#pragma unroll
        for (int i = 0; i < 4; ++i) { acc[i][0] = (f32x4){0.f, 0.f, 0.f, 0.f}; acc[i][1] = (f32x4){0.f, 0.f, 0.f, 0.f}; }
        u32x4 ra0 = *(const u32x4*)pa0, ra1 = *(const u32x4*)pa1, rb0 = *(const u32x4*)pb0, rb1 = *(const u32x4*)pb1;
        const int wofs = lrow0 * (SG_LDT * 2) + lkc * 16;
        *(LAS u32x4*)(lds + wofs) = ra0; *(LAS u32x4*)(lds + wofs + 64 * SG_LDT * 2) = ra1;
        *(LAS u32x4*)(lds + SG_TILE + wofs) = rb0; *(LAS u32x4*)(lds + SG_TILE + wofs + 64 * SG_LDT * 2) = rb1;
        __syncthreads();
        for (int kt = 0; kt < nk; ++kt) {
            const int cur = (kt & 1) * 2 * SG_TILE, nxt = ((kt + 1) & 1) * 2 * SG_TILE;
            const bool more = (kt + 1 < nk);
            if (more) { const int ko = (kt + 1) << 6; ra0 = *(const u32x4*)(pa0 + ko); ra1 = *(const u32x4*)(pa1 + ko); rb0 = *(const u32x4*)(pb0 + ko); rb1 = *(const u32x4*)(pb1 + ko); }
#pragma unroll
            for (int ks = 0; ks < 2; ++ks) {
                bf16x8 af[4], bfr[2];
#pragma unroll
                for (int i = 0; i < 4; ++i) af[i] = *(const LAS bf16x8*)(lds + cur + aoff + i * 16 * SG_LDT * 2 + ks * 64);
#pragma unroll
                for (int j = 0; j < 2; ++j) bfr[j] = *(const LAS bf16x8*)(lds + cur + SG_TILE + boff + j * 16 * SG_LDT * 2 + ks * 64);
#pragma unroll
                for (int i = 0; i < 4; ++i)
#pragma unroll
                    for (int j = 0; j < 2; ++j) acc[i][j] = __builtin_amdgcn_mfma_f32_16x16x32_bf16(bfr[j], af[i], acc[i][j], 0, 0, 0);
            }
            if (more) {
                *(LAS u32x4*)(lds + nxt + wofs) = ra0; *(LAS u32x4*)(lds + nxt + wofs + 64 * SG_LDT * 2) = ra1;
                *(LAS u32x4*)(lds + nxt + SG_TILE + wofs) = rb0; *(LAS u32x4*)(lds + nxt + SG_TILE + wofs + 64 * SG_LDT * 2) = rb1;
            }
            __syncthreads();
        }
        const int nn = n0 + wn * 32 + 4 * fq;
        if (n0 + wn * 32 < g.N) {
#pragma unroll
            for (int i = 0; i < 4; ++i) { const int m = m0 + wm * 64 + i * 16 + fr; if (m < g.M) E(b1, b2, b3, m, nn, acc[i][0], acc[i][1]); }
        }
    }
}

namespace pg8 {
constexpr int BM = 256, BK = 64, HALF = 128, HTB = HALF * BK * 2, STAGE_BYTES = 8 * HTB, WGM = 8;
__device__ __forceinline__ int lds_byte(int r, int c) { const int st = (r >> 4) * 2 + (c >> 5), rr = r & 15, cc = c & 31, ob = rr * 64 + cc * 2; return st * 1024 + (ob ^ (((ob >> 9) & 1) << 5)); }
__device__ __forceinline__ void stage_rc(int b, int& R, int& C) { const int st = b / 1024, sb = b % 1024, swz = sb ^ (((sb >> 9) & 1) << 5); R = (st >> 1) * 16 + swz / 64; C = (st & 1) * 32 + (swz % 64) / 2; }
struct Unit { const char* a; const char* b; int pm, pn, b1, b2, b3; };
template <class Epi>
__device__ __forceinline__ void gemm_phase(LAS unsigned char* lds, const GemmP g, const Epi& E, int bid, int nblk, int& ubase) {
    const int tid = threadIdx.x, wid = __builtin_amdgcn_readfirstlane(tid >> 6), lane = tid & 63, wr = wid >> 2, wc = wid & 3, fr = lane & 15, fq = lane >> 4;
    const int nt = g.K / BK;
    const int nM = g.M / BM, nN = g.N / BM, nwg = nM * nN, U = g.nb1 * g.nb2 * g.nb3 * nwg;
    const int cidx = (bid - (ubase % nblk) + nblk) % nblk; ubase += U;
    auto next = [&](int i, Unit& u) -> bool {
        const long Lq = (long)i * nblk + cidx; if (Lq >= U) return false;
        const int b = (int)(Lq / nwg), w = (int)(Lq % nwg);
        const int nig = WGM * nN, gid = w / nig, fm = gid * WGM, gsz = (nM - fm) < WGM ? (nM - fm) : WGM;
        u.pm = fm + ((w % nig) % gsz); u.pn = (w % nig) / gsz;
        u.b3 = b % g.nb3; const int b12 = b / g.nb3; u.b2 = b12 % g.nb2; u.b1 = b12 / g.nb2;
        u.a = (const char*)(g.A + u.b1 * g.sA1 + u.b2 * g.sA2 + u.b3 * g.sA3 + (long)u.pm * BM * g.lda);
        u.b = (const char*)(g.B + u.b1 * g.sB1 + u.b2 * g.sB2 + u.b3 * g.sB3 + (long)u.pn * BM * g.ldb);
        return true; };
    unsigned voffA[2], voffB[2];
#pragma unroll
    for (int i = 0; i < 2; ++i) { int R, C; stage_rc(tid * 16 + i * 8192, R, C); voffA[i] = (unsigned)(R * (int)g.lda + C) * 2u; voffB[i] = (unsigned)(R * (int)g.ldb + C) * 2u; }
    const size_t kstep = (size_t)(BK * 2);
    const size_t hstepA = (size_t)HALF * g.lda * 2, hstepB = (size_t)HALF * g.ldb * 2;
    const unsigned ldsw = (unsigned)wid * 1024u;
    const int aoff = lds_byte(wr * 64 + fr, fq * 8), boff = lds_byte(wc * 32 + fr, fq * 8);
#define PG8_SA(b, h) (((b) * 2 + (h)) * HTB)
#define PG8_SB(b, h) ((4 + (b) * 2 + (h)) * HTB)
#define PG8_STAGE(bufoff, gbase, voff) do { _Pragma("unroll") for (int _i = 0; _i < 2; ++_i) \
        __builtin_amdgcn_global_load_lds((const unsigned*)((const char*)(gbase) + (voff)[_i]), (LAS unsigned*)(lds + (bufoff) + ldsw + _i * 8192), 16, 0, 0); } while (0)
#define PG8_LDA(dst, b, h) do { _Pragma("unroll") for (int m = 0; m < 4; ++m) _Pragma("unroll") for (int k = 0; k < 2; ++k) dst[m][k] = *(const LAS bf16x8*)(lds + PG8_SA(b, h) + aoff + m * 2048 + k * 1024); } while (0)
#define PG8_LDB(dst, b, h) do { _Pragma("unroll") for (int n = 0; n < 2; ++n) _Pragma("unroll") for (int k = 0; k < 2; ++k) dst[n][k] = *(const LAS bf16x8*)(lds + PG8_SB(b, h) + boff + n * 2048 + k * 1024); } while (0)
#define PG8_MMA(ai, bj, At, Bt) do { __builtin_amdgcn_s_setprio(1); _Pragma("unroll") for (int m = 0; m < 4; ++m) _Pragma("unroll") for (int n = 0; n < 2; ++n) _Pragma("unroll") for (int k = 0; k < 2; ++k) \
        acc[ai][bj][m][n] = __builtin_amdgcn_mfma_f32_16x16x32_bf16(Bt[n][k], At[m][k], acc[ai][bj][m][n], 0, 0, 0); __builtin_amdgcn_s_setprio(0); } while (0)
#define PG8_WAIT_V(n) asm volatile("s_waitcnt vmcnt(" #n ")" ::: "memory")
#define PG8_WAIT_L(n) asm volatile("s_waitcnt lgkmcnt(" #n ")" ::: "memory")
#define PG8_BAR __builtin_amdgcn_s_barrier()
#define PG8_SCHED __builtin_amdgcn_sched_barrier(0)
    Unit cur, nxt; int ui = 0;
    if (!next(0, cur)) return;
    f32x4 acc[2][2][4][2];
#pragma unroll
    for (int a = 0; a < 2; ++a)
#pragma unroll
        for (int b = 0; b < 2; ++b)
#pragma unroll
            for (int m = 0; m < 4; ++m)
#pragma unroll
                for (int n = 0; n < 2; ++n) acc[a][b][m][n] = (f32x4){0.f, 0.f, 0.f, 0.f};
    bf16x8 At[4][2], B0[2][2], B1[2][2];
    const char* cA = cur.a; const char* cB = cur.b;
    PG8_STAGE(PG8_SB(0, 0), cB, voffB); PG8_STAGE(PG8_SA(0, 0), cA, voffA); PG8_STAGE(PG8_SB(0, 1), cB + hstepB, voffB); PG8_STAGE(PG8_SA(0, 1), cA + hstepA, voffA);
    if (wr == 1) PG8_BAR;
    PG8_WAIT_V(4); PG8_BAR;
    PG8_STAGE(PG8_SB(1, 0), cB + kstep, voffB); PG8_STAGE(PG8_SA(1, 0), cA + kstep, voffA); PG8_STAGE(PG8_SB(1, 1), cB + hstepB + kstep, voffB);
    PG8_WAIT_V(6); PG8_BAR;
    for (;;) {
        const bool has_next = next(ui + 1, nxt);
        const char* nA = has_next ? nxt.a : cA; const char* nB = has_next ? nxt.b : cB;
        for (int t = 0; t < nt; t += 2) {
            const bool last = (t == nt - 2);
            const char* a1 = cA + (size_t)(t + 1) * kstep;
            const char* a2 = last ? nA : cA + (size_t)(t + 2) * kstep; const char* b2 = last ? nB : cB + (size_t)(t + 2) * kstep;
            const char* a3 = a2 + kstep; const char* b3 = b2 + kstep;
            PG8_LDB(B0, 0, 0); PG8_SCHED; PG8_LDA(At, 0, 0); PG8_STAGE(PG8_SA(1, 1), a1 + hstepA, voffA);
            PG8_WAIT_L(8); PG8_BAR; PG8_WAIT_L(0); PG8_MMA(0, 0, At, B0); PG8_BAR; PG8_SCHED;
            PG8_LDB(B1, 0, 1); PG8_STAGE(PG8_SB(0, 0), b2, voffB);
            PG8_BAR; PG8_WAIT_L(0); PG8_MMA(0, 1, At, B1); PG8_BAR;
            PG8_LDA(At, 0, 1); PG8_STAGE(PG8_SA(0, 0), a2, voffA);
            PG8_BAR; PG8_WAIT_L(0); PG8_MMA(1, 0, At, B0); PG8_BAR; PG8_SCHED;
            PG8_STAGE(PG8_SB(0, 1), b2 + hstepB, voffB);
            PG8_WAIT_V(6); PG8_BAR; PG8_MMA(1, 1, At, B1); PG8_BAR;
            PG8_LDB(B0, 1, 0); PG8_SCHED; PG8_LDA(At, 1, 0); PG8_STAGE(PG8_SA(0, 1), a2 + hstepA, voffA);
            PG8_WAIT_L(8); PG8_BAR; PG8_WAIT_L(0); PG8_MMA(0, 0, At, B0); PG8_BAR; PG8_SCHED;
            PG8_LDB(B1, 1, 1); PG8_STAGE(PG8_SB(1, 0), b3, voffB);
            PG8_BAR; PG8_WAIT_L(0); PG8_MMA(0, 1, At, B1); PG8_BAR;
            PG8_LDA(At, 1, 1); PG8_STAGE(PG8_SA(1, 0), a3, voffA);
            PG8_BAR; PG8_WAIT_L(0); PG8_MMA(1, 0, At, B0); PG8_BAR; PG8_SCHED;
            PG8_STAGE(PG8_SB(1, 1), b3 + hstepB, voffB);
            PG8_WAIT_V(6); PG8_BAR; PG8_MMA(1, 1, At, B1); PG8_BAR;
        }
#pragma unroll
        for (int ai = 0; ai < 2; ++ai)
#pragma unroll
            for (int mm = 0; mm < 4; ++mm) { const int row = cur.pm * BM + ai * HALF + wr * 64 + mm * 16 + fr;
#pragma unroll
                for (int bj = 0; bj < 2; ++bj) E(cur.b1, cur.b2, cur.b3, row, cur.pn * BM + bj * HALF + wc * 32 + 4 * fq, acc[ai][bj][mm][0], acc[ai][bj][mm][1]); }
        if (!has_next) break;
#pragma unroll
        for (int a = 0; a < 2; ++a)
#pragma unroll
            for (int b = 0; b < 2; ++b)
#pragma unroll
                for (int m = 0; m < 4; ++m)
#pragma unroll
                    for (int n = 0; n < 2; ++n) acc[a][b][m][n] = (f32x4){0.f, 0.f, 0.f, 0.f};
        cur = nxt; cA = nA; cB = nB; ++ui;
    }
    PG8_WAIT_V(0);
    if (wr == 0) PG8_BAR;
    PG8_BAR;
#undef PG8_SA
#undef PG8_SB
#undef PG8_STAGE
#undef PG8_LDA
#undef PG8_LDB
#undef PG8_MMA
#undef PG8_WAIT_V
#undef PG8_WAIT_L
#undef PG8_BAR
#undef PG8_SCHED
}
}

struct EpiF32 { float* C; long ldc, s1, s2, s3; float scale;
    __device__ __forceinline__ void operator()(int b1, int b2, int b3, int m, int n, f32x4 v0, f32x4 v1) const {
        float* p = C + b1 * s1 + b2 * s2 + b3 * s3 + (long)m * ldc + n; *(f32x4*)p = v0 * scale; *(f32x4*)(p + 16) = v1 * scale; } };
struct EpiF32N { float* C; long ldc; int nvalid;
    __device__ __forceinline__ void operator()(int, int, int, int m, int n, f32x4 v0, f32x4 v1) const {
        if (n < nvalid) { float* p = C + (long)m * ldc + n; *(f32x4*)p = v0; *(f32x4*)(p + 16) = v1; } } };
struct EpiBf16 { bf16* C; long ldc, s1, s2, s3; float scale;
    __device__ __forceinline__ void operator()(int b1, int b2, int b3, int m, int n, f32x4 v0, f32x4 v1) const {
        bf16* p = C + b1 * s1 + b2 * s2 + b3 * s3 + (long)m * ldc + n; v0 = v0 * scale; v1 = v1 * scale;
        *(u32x2*)p = (u32x2){pk2(v0[0], v0[1]), pk2(v0[2], v0[3])}; *(u32x2*)(p + 16) = (u32x2){pk2(v1[0], v1[1]), pk2(v1[2], v1[3])}; } };
__device__ __forceinline__ void rope4(f32x4& v0, f32x4& v1, int pos, int j0, const float* tab) {
    const f32x4 cs = *(const f32x4*)(tab + pos * 16 + j0), sn = *(const f32x4*)(tab + 1024 + pos * 16 + j0);
    const f32x4 x1 = v0, x2 = v1; v0 = x1 * cs - x2 * sn; v1 = x1 * sn + x2 * cs;
}
struct EpiQMla { bf16* Q; const float* rtab;
    __device__ __forceinline__ void operator()(int, int, int, int m, int n, f32x4 v0, f32x4 v1) const {
        const int d = n % 192, d0 = d & ~31;
        if (m >= NPR && d0 >= 128) { const int t = (m - NPR) & 1023; const int pos = (d0 == 128) ? (t >> 6) : (t & 63); rope4(v0, v1, pos, d & 15, rtab); }
        bf16* p = Q + (long)m * 3072 + n;
        *(u32x2*)p = (u32x2){pk2(v0[0], v0[1]), pk2(v0[2], v0[3])}; *(u32x2*)(p + 16) = (u32x2){pk2(v1[0], v1[1]), pk2(v1[2], v1[3])}; } };
struct EpiKn { bf16* KC;
    __device__ __forceinline__ void operator()(int, int, int, int m, int n, f32x4 v0, f32x4 v1) const {
        bf16* p = KC + ((long)m * 16 + (n >> 7)) * 192 + (n & 127);
        *(u32x2*)p = (u32x2){pk2(v0[0], v0[1]), pk2(v0[2], v0[3])}; *(u32x2*)(p + 16) = (u32x2){pk2(v1[0], v1[1]), pk2(v1[2], v1[3])}; } };
struct EpiResid { float* Y; const float* X; const float* gate;
    __device__ __forceinline__ void operator()(int, int, int, int m, int n, f32x4 v0, f32x4 v1) const {
        const float* gp = gate + cond_of(m) * 12288 + n; const float* xp = X + (long)m * D + n; float* yp = Y + (long)m * D + n;
        const f32x4 g0 = *(const f32x4*)gp, g1 = *(const f32x4*)(gp + 16), x0 = *(const f32x4*)xp, x1 = *(const f32x4*)(xp + 16);
        *(f32x4*)yp = x0 * ALPHA + g0 * v0; *(f32x4*)(yp + 16) = x1 * ALPHA + g1 * v1; } };
struct EpiQkv1 { bf16* Q1; bf16* K1; bf16* VT1; float* outk; float* outv; const float* rtab;
    __device__ __forceinline__ void operator()(int, int, int, int m, int n, f32x4 v0, f32x4 v1) const {
        const int kvr = kvrow_of(m);
        if (n < 2560) {
            if (n >= 2048 && m < NPR) { float* p = outk + (long)m * 512 + (n - 2048); *(f32x4*)p = v0; *(f32x4*)(p + 16) = v1; }
            if (m >= NPR) { const int t = (m - NPR) & 1023; const int pos = ((n & 32) == 0) ? (t >> 6) : (t & 63); rope4(v0, v1, pos, n & 15, rtab); }
            bf16* p = (n < 2048) ? (Q1 + (long)m * 2048 + n) : (K1 + (long)kvr * 512 + (n - 2048));
            *(u32x2*)p = (u32x2){pk2(v0[0], v0[1]), pk2(v0[2], v0[3])}; *(u32x2*)(p + 16) = (u32x2){pk2(v1[0], v1[1]), pk2(v1[2], v1[3])};
        } else {
            const int c = n - 2560;
            if (m < NPR) { float* p = outv + (long)m * 512 + c; *(f32x4*)p = v0; *(f32x4*)(p + 16) = v1; }
#pragma unroll
            for (int i = 0; i < 4; ++i) { VT1[(long)(c + i) * KVR + kvr] = (bf16)f2bf(v0[i]); VT1[(long)(c + 16 + i) * KVR + kvr] = (bf16)f2bf(v1[i]); }
        } } };
struct EpiDft1 { bf16* YTp; bf16* YTs;
    __device__ __forceinline__ void operator()(int g, int, int, int j, int tok, f32x4 v0, f32x4 v1) const {
        const int h = j >> 9, c = j & 511;
#pragma unroll
        for (int q = 0; q < 2; ++q) { const int tk = tok + 16 * q; const f32x4 v = q ? v1 : v0; bf16* p;
            if (tk < NPR) { const int b = tk >> 8, t = tk & 255; p = YTp + ((long)(b * 2048 + g * 512 + c) * 512 + h * 256 + t); }
            else { const int s = tk - NPR, b = s >> 10, t = s & 1023; p = YTs + ((long)(b * 2048 + g * 512 + c) * 2048 + h * 1024 + t); }
            *(u32x2*)p = (u32x2){pk2(v[0], v[1]), pk2(v[2], v[3])}; } } };

__device__ __forceinline__ f32x4 ldg4(const float* base, unsigned boff) { return *(const GAS f32x4*)((const GAS char*)base + boff); }
__device__ __forceinline__ void stg4(float* base, unsigned boff, f32x4 v) { *(GAS f32x4*)((GAS char*)base + boff) = v; }
__device__ __forceinline__ u32x2 ldg2u(const void* base, unsigned boff) { return *(const GAS u32x2*)((const GAS char*)base + boff); }
__device__ __forceinline__ void stg2u(void* base, unsigned boff, u32x2 v) { *(GAS u32x2*)((GAS char*)base + boff) = v; }
template <class T> __device__ __forceinline__ T* opq(T* p) { asm volatile("" : "+s"(p)); return p; }
struct Frame {
    LAS unsigned char* lds;
    unsigned char* ws;
    int tid, lane, wave, bid, nblk, gw, ngw;
};

__device__ __forceinline__ void ln_row(const float* yrow, const float* g, const float* b, float* xrow, bf16* urow, const float* shift, const float* scale, float* orow, int lane) {
    f32x4 v[8]; float s = 0.f;
#pragma unroll
    for (int i = 0; i < 8; ++i) { v[i] = *(const f32x4*)(yrow + i * 256 + lane * 4); s += (v[i][0] + v[i][1]) + (v[i][2] + v[i][3]); }
    const float mean = wave_sum(s) * (1.f / D); float s2 = 0.f;
#pragma unroll
    for (int i = 0; i < 8; ++i) { v[i] = v[i] - mean; s2 += (v[i][0] * v[i][0] + v[i][1] * v[i][1]) + (v[i][2] * v[i][2] + v[i][3] * v[i][3]); }
    const float rstd = rsqrtf(wave_sum(s2) * (1.f / D) + LN_EPS);
#pragma unroll
    for (int i = 0; i < 8; ++i) { const int c = i * 256 + lane * 4;
        const f32x4 o = v[i] * rstd * *(const f32x4*)(g + c) + *(const f32x4*)(b + c);
        *(f32x4*)(xrow + c) = o;
        if (orow) *(f32x4*)(orow + c) = o;
        if (urow) { const f32x4 u = o * (*(const f32x4*)(scale + c) + 1.0f) + *(const f32x4*)(shift + c); *(u32x2*)(urow + c) = (u32x2){pk2(u[0], u[1]), pk2(u[2], u[3])}; } }
}

template <int NV, bool BAND>
__device__ __forceinline__ void softmax_row(float* row, int t, bool has_sink, float sink, int lane) {
    f32x4 v[NV]; float mx = -3.0e38f;
#pragma unroll
    for (int i = 0; i < NV; ++i) { v[i] = *(const f32x4*)(row + i * 256 + lane * 4);
#pragma unroll
        for (int e = 0; e < 4; ++e) { if (BAND) { const int s = i * 256 + lane * 4 + e; const int dlt = t - s; const bool ok = (s >= 1024) || (dlt <= 128 && dlt >= -128); if (!ok) v[i][e] = -3.0e38f; } mx = fmaxf(mx, v[i][e]); } }
    mx = wave_max(mx); if (has_sink) mx = fmaxf(mx, sink);
    float sum = 0.f;
#pragma unroll
    for (int i = 0; i < NV; ++i)
#pragma unroll
        for (int e = 0; e < 4; ++e) { const float p = (v[i][e] < -1.0e38f) ? 0.f : __expf(v[i][e] - mx); v[i][e] = p; sum += p; }
    sum = wave_sum(sum); if (has_sink) sum += __expf(sink - mx);
    const float inv = 1.f / sum;
    bf16* prow = (bf16*)row;
#pragma unroll
    for (int i = 0; i < NV; ++i) *(u32x2*)(prow + i * 256 + lane * 4) = (u32x2){pk2(v[i][0] * inv, v[i][1] * inv), pk2(v[i][2] * inv, v[i][3] * inv)};
}

__device__ __forceinline__ void transpose_item(const float* W, int K, int N, bf16* WT, int row_off, LAS float* scr, int item, int lane) {
    const int nblkn = N / 32, kb = item / nblkn, nb = item % nblkn, k0 = 64 * kb, n0 = 32 * nb;
#pragma unroll 8
    for (int i = 0; i < 32; ++i) { const int kk = 2 * i + (lane >> 5); scr[kk * 33 + (lane & 31)] = W[(size_t)(k0 + kk) * N + n0 + (lane & 31)]; }
    LDS_WAIT();
    const int c = lane & 7;
#pragma unroll
    for (int j = 0; j < 4; ++j) { const int n = (lane >> 3) + 8 * j; const LAS float* s = scr + (8 * c) * 33 + n;
        u32x4 o; o.x = pk2(s[0 * 33], s[1 * 33]); o.y = pk2(s[2 * 33], s[3 * 33]); o.z = pk2(s[4 * 33], s[5 * 33]); o.w = pk2(s[6 * 33], s[7 * 33]);
        *(u32x4*)(WT + (size_t)(row_off + n0 + n) * K + k0 + 8 * c) = o; }
    LDS_WAIT();
}

__device__ __forceinline__ int cflat(int l) {
    int a = 0, base = 0;
    if (l >= 16) { a = 1; base = 16; } if (l >= 24) { a = 2; base = 24; } if (l >= 29) { a = 3; base = 29; } if (l >= 33) { a = 4; base = 33; }
    if (l >= 36) { a = 5; base = 36; } if (l >= 38) { a = 6; base = 38; } if (l >= 40) { a = 7; base = 40; } if (l >= 42) { a = 8 + (l - 42); base = l; }
    return l < 50 ? a * 16 + (l - base) : 9999;
}
#if !MK_PER_PHASE
#define SYNC() xcd_barrier(bar)
#else
#define SYNC() do {} while (0)
#endif
#define PH_BEGIN unsigned char* ws = opq(ws_)
#define IP(i) opq(args.in[i])
#define MODS ((float*)(ws + WS_MODS))
#define ROPET ((float*)(ws + WS_MODS + 640 * 1024))
#define X ((float*)(ws + WS_X))
#define Y ((float*)(ws + WS_Y))
#define Ub ((bf16*)(ws + WS_U))
#define Ob ((bf16*)(ws + WS_O))
#define SCR (ws + WS_SCR)
#define IN(k) (lo <= (k) && (k) < hi)
#define ENDPH(k) do { if (hi > (k) + 1) SYNC(); } while (0)
template <int L>
__device__ __forceinline__ void layer_phases(const Args& args, const Frame& F, unsigned char* const ws_, const int lo, const int hi, const XcdBarrier& bar) {
    int ub;
        const int P = 2 + L * 16;
#define modL (MODS + L * 3 * 12288)
        if constexpr (L == 0) {
#define T0 ((float*)SCR)
#define QN ((bf16*)(ws + WS_QN))
#define CKV ((bf16*)(ws + WS_CKV))
#define Qb ((bf16*)(ws + WS_Q))
#define KC ((bf16*)(ws + WS_KC))
#define VT ((bf16*)(ws + WS_VT))
#define SCp ((float*)SCR)
#define SCs ((float*)(SCR + 64 * MiB))
            if (IN(P + 0)) { PH_BEGIN;
                ub = 0; GemmP g{Ub, (const bf16*)(ws + WS_W0T), D, D, 0, 0, 0, 0, 0, 0, MT, 1280, D, 1, 1, 1};
                pg8::gemm_phase(F.lds, g, EpiF32N{T0, 1088, 1088}, F.bid, F.nblk, ub);
                ENDPH(P + 0);
            }
            if (IN(P + 1)) { PH_BEGIN;
                const float* qg = IP(I_QNORM); const float* kg = IP(I_KVNORM);
                for (int m = F.gw; m < MT; m += F.ngw) {
                    const float* tr = T0 + (size_t)m * 1088; const int kvr = kvrow_of(m); const int c = F.lane * 8;
                    { f32x4 a = *(const f32x4*)(tr + c), b = *(const f32x4*)(tr + c + 4);
                      float ss = (a[0] * a[0] + a[1] * a[1]) + (a[2] * a[2] + a[3] * a[3]) + (b[0] * b[0] + b[1] * b[1]) + (b[2] * b[2] + b[3] * b[3]);
                      const float r = rsqrtf(wave_sum(ss) * (1.f / 512.f) + RMS_EPS);
                      a = a * r * *(const f32x4*)(qg + c); b = b * r * *(const f32x4*)(qg + c + 4);
                      *(u32x4*)(QN + (size_t)m * 512 + c) = (u32x4){pk2(a[0], a[1]), pk2(a[2], a[3]), pk2(b[0], b[1]), pk2(b[2], b[3])}; }
                    { f32x4 a = *(const f32x4*)(tr + 512 + c), b = *(const f32x4*)(tr + 512 + c + 4);
                      float ss = (a[0] * a[0] + a[1] * a[1]) + (a[2] * a[2] + a[3] * a[3]) + (b[0] * b[0] + b[1] * b[1]) + (b[2] * b[2] + b[3] * b[3]);
                      const float r = rsqrtf(wave_sum(ss) * (1.f / 512.f) + RMS_EPS);
                      a = a * r * *(const f32x4*)(kg + c); b = b * r * *(const f32x4*)(kg + c + 4);
                      *(u32x4*)(CKV + (size_t)kvr * 512 + c) = (u32x4){pk2(a[0], a[1]), pk2(a[2], a[3]), pk2(b[0], b[1]), pk2(b[2], b[3])};
                      if (m < NPR) { float* o = args.out + OUT_CKV + (size_t)m * 512 + c; *(f32x4*)o = a; *(f32x4*)(o + 4) = b; } }
                    { float x = tr[1024 + F.lane];
                      if (m < NPR) args.out[OUT_KR + (size_t)m * 64 + F.lane] = x;
                      else { const int t = (m - NPR) & 1023, e = F.lane, j = e & 15; const int pos = (e < 32) ? (t >> 6) : (t & 63);
                          const float cs = ROPET[pos * 16 + j], sn = ROPET[1024 + pos * 16 + j];
                          const float pr = __shfl_xor(x, 16); x = ((e & 16) == 0) ? (x * cs - pr * sn) : (pr * sn + x * cs); }
                      const bf16 xb = (bf16)f2bf(x);
#pragma unroll
                      for (int h = 0; h < 16; ++h) KC[((size_t)kvr * 16 + h) * 192 + 128 + F.lane] = xb; }
                }
                ENDPH(P + 1);
            }
            if (IN(P + 2)) { PH_BEGIN;
                ub = 0; GemmP g{QN, (const bf16*)(ws + WS_WUQT), 512, 512, 0, 0, 0, 0, 0, 0, MT, 3072, 512, 1, 1, 1};
                pg8::gemm_phase(F.lds, g, EpiQMla{Qb, ROPET}, F.bid, F.nblk, ub);
                GemmP g2{CKV, (const bf16*)(ws + WS_WUKT), 512, 512, 0, 0, 0, 0, 0, 0, KVR, 2048, 512, 1, 1, 1};
                pg8::gemm_phase(F.lds, g2, EpiKn{KC}, F.bid, F.nblk, ub);
                GemmP g3{(const bf16*)(ws + WS_WUVT), CKV, 512, 512, 0, 0, 0, 0, 0, 0, 2048, KVR, 512, 1, 1, 1};
                pg8::gemm_phase(F.lds, g3, EpiBf16{VT, KVR, 0, 0, 0, 1.f}, F.bid, F.nblk, ub);
                ENDPH(P + 2);
            }
            if (IN(P + 3)) { PH_BEGIN;
                ub = 0;
                GemmP gp{Qb, KC, 3072, 3072, 256L * 3072, 192, 0, 256L * 3072, 192, 0, 256, 256, 192, 16, 16, 1};
                sg_gemm(F.lds, gp, EpiF32{SCp, 256, 16L * 256 * 256, 256L * 256, 0, MLA_SCALE}, F.bid, F.nblk, ub);
                GemmP gs{Qb + (size_t)NPR * 3072, KC + (size_t)NPR * 3072, 3072, 3072, 1024L * 3072, 192, 0, 1280L * 3072, 192, 0, 1024, 1280, 192, 2, 16, 1};
                sg_gemm(F.lds, gs, EpiF32{SCs, 1280, 16L * 1024 * 1280, 1024L * 1280, 0, MLA_SCALE}, F.bid, F.nblk, ub);
                ENDPH(P + 3);
            }
            if (IN(P + 4)) { PH_BEGIN;
                for (int r = F.gw; r < 16 * 16 * 256; r += F.ngw) softmax_row<1, false>(SCp + (size_t)r * 256, 0, false, 0.f, F.lane);
                for (int r = F.gw; r < 2 * 16 * 1024; r += F.ngw) softmax_row<5, false>(SCs + (size_t)r * 1280, 0, false, 0.f, F.lane);
                ENDPH(P + 4);
            }
            if (IN(P + 5)) { PH_BEGIN;
                ub = 0;
                GemmP gp{(const bf16*)SCp, VT, 512, KVR, 16L * 256 * 512, 256L * 512, 0, 256, 128L * KVR, 0, 256, 128, 256, 16, 16, 1};
                sg_gemm(F.lds, gp, EpiBf16{Ob, D, 256L * D, 128, 0, 1.f}, F.bid, F.nblk, ub);
                GemmP gs{(const bf16*)SCs, VT + NPR, 2560, KVR, 16L * 1024 * 2560, 1024L * 2560, 0, 1280, 128L * KVR, 0, 1024, 128, 1280, 2, 16, 1};
                sg_gemm(F.lds, gs, EpiBf16{Ob + (size_t)NPR * D, D, 1024L * D, 128, 0, 1.f}, F.bid, F.nblk, ub);
                ENDPH(P + 5);
            }
        } else if constexpr (L == 1) {
#undef SCs
#define SCs ((float*)(SCR + 128 * MiB))
#define Q1 ((bf16*)(ws + WS_Q))
#define K1 ((bf16*)(ws + WS_KC))
#define VT1 ((bf16*)(ws + WS_VT))
            if (IN(P + 0)) { PH_BEGIN;
                const int gt = F.bid * NTHR + F.tid, ngt = F.nblk * NTHR;
                { const float* c1 = IP(I_C1K);
                  for (int i = gt; i < 2 * 256 * 512; i += ngt) { const int b = i >> 17, r = i & 131071; K1[(size_t)(NPR + b * 1280 + 1024) * 512 + r] = (bf16)f2bf(c1[i]); } }
                { const float* c1 = IP(I_C1V);
                  for (int i = gt; i < 2 * 256 * 512; i += ngt) { const int b = i >> 17, s = (i >> 9) & 255, c = i & 511; VT1[(size_t)c * KVR + NPR + b * 1280 + 1024 + s] = (bf16)f2bf(c1[i]); } }
                ub = 0; GemmP g{Ub, (const bf16*)(ws + WS_WQKVT), D, D, 0, 0, 0, 0, 0, 0, MT, 3072, D, 1, 1, 1};
                pg8::gemm_phase(F.lds, g, EpiQkv1{Q1, K1, VT1, args.out + OUT_K1, args.out + OUT_V1, ROPET}, F.bid, F.nblk, ub);
                ENDPH(P + 0);
            }
            if (IN(P + 3)) { PH_BEGIN;
                ub = 0;
                GemmP gp{Q1, K1, D, 512, 256L * D, 256, 64, 256L * 512, 64, 0, 256, 256, 64, 16, 8, 4};
                sg_gemm(F.lds, gp, EpiF32{SCp, 256, 32L * 256 * 256, 4L * 256 * 256, 256L * 256, GQA_SCALE}, F.bid, F.nblk, ub);
                GemmP gs{Q1 + (size_t)NPR * D, K1 + (size_t)NPR * 512, D, 512, 1024L * D, 256, 64, 1280L * 512, 64, 0, 1024, 1280, 64, 2, 8, 4};
                sg_gemm(F.lds, gs, EpiF32{SCs, 1280, 32L * 1024 * 1280, 4L * 1024 * 1280, 1024L * 1280, GQA_SCALE}, F.bid, F.nblk, ub);
                ENDPH(P + 3);
            }
            if (IN(P + 4)) { PH_BEGIN;
                const float* sink = IP(I_SINK);
                for (int r = F.gw; r < 16 * 32 * 256; r += F.ngw) softmax_row<1, false>(SCp + (size_t)r * 256, 0, true, sink[(r >> 8) & 31], F.lane);
                for (int r = F.gw; r < 2 * 32 * 1024; r += F.ngw) softmax_row<5, true>(SCs + (size_t)r * 1280, r & 1023, true, sink[(r >> 10) & 31], F.lane);
                ENDPH(P + 4);
            }
            if (IN(P + 5)) { PH_BEGIN;
                ub = 0;
                GemmP gp{(const bf16*)SCp, VT1, 512, KVR, 32L * 256 * 512, 4L * 256 * 512, 256L * 512, 256, 64L * KVR, 0, 256, 64, 256, 16, 8, 4};
                sg_gemm(F.lds, gp, EpiBf16{Ob, D, 256L * D, 256, 64, 1.f}, F.bid, F.nblk, ub);
                GemmP gs{(const bf16*)SCs, VT1 + NPR, 2560, KVR, 32L * 1024 * 2560, 4L * 1024 * 2560, 1024L * 2560, 1280, 64L * KVR, 0, 1024, 64, 1280, 2, 8, 4};
                sg_gemm(F.lds, gs, EpiBf16{Ob + (size_t)NPR * D, D, 1024L * D, 256, 64, 1.f}, F.bid, F.nblk, ub);
                ENDPH(P + 5);
            }
        } else if constexpr (L == 2) {
#define YTp ((bf16*)SCR)
#define YTs ((bf16*)(SCR + 32 * MiB))
            if (IN(P + 0)) { PH_BEGIN;
                ub = 0; GemmP g{(const bf16*)(ws + WS_CS512), Ub, 512, D, 0, 0, 0, 512, 0, 0, 1024, MT, 512, 4, 1, 1};
                pg8::gemm_phase(F.lds, g, EpiDft1{YTp, YTs}, F.bid, F.nblk, ub);
                ENDPH(P + 0);
            }
            if (IN(P + 5)) { PH_BEGIN;
                ub = 0;
                GemmP gp{(const bf16*)(ws + WS_CT256), YTp, 512, 512, 0, 0, 0, 2048L * 512, 0, 0, 256, 2048, 512, 16, 1, 1};
                pg8::gemm_phase(F.lds, gp, EpiBf16{Ob, D, 256L * D, 0, 0, 0.0027621358640099515f}, F.bid, F.nblk, ub);
                GemmP gs{(const bf16*)(ws + WS_CT1024), YTs, 2048, 2048, 0, 0, 0, 2048L * 2048, 0, 0, 1024, 2048, 2048, 2, 1, 1};
                pg8::gemm_phase(F.lds, gs, EpiBf16{Ob + (size_t)NPR * D, D, 1024L * D, 0, 0, 0.0013810679320049757f}, F.bid, F.nblk, ub);
                ENDPH(P + 5);
            }
        } else {
#define BCH ((bf16*)SCR)
            if (IN(P + 0)) { PH_BEGIN;
                ub = 0; GemmP g{Ub, (const bf16*)(ws + WS_WINT), D, D, 0, 0, 0, 0, 0, 0, MT, 6144, D, 1, 1, 1};
                pg8::gemm_phase(F.lds, g, EpiBf16{BCH, 6144, 0, 0, 0, 1.f}, F.bid, F.nblk, ub);
                ENDPH(P + 0);
            }
            if (IN(P + 5)) { PH_BEGIN;
                const float* cw = IP(I_CONVW); const float* cb = IP(I_CONVB);
                for (int m = F.gw; m < MT; m += F.ngw) {
                    const int t = (m < NPR) ? (m & 255) : ((m - NPR) & 1023); const int T = (m < NPR) ? 256 : 1024;
                    const bool hasp = t > 0, hasn = t < T - 1;
#pragma unroll
                    for (int i = 0; i < 4; ++i) { const int c = i * 512 + F.lane * 8; const bf16* r0 = BCH + (size_t)m * 6144 + c;
                        const u32x4 bb = *(const u32x4*)r0, cc = *(const u32x4*)(r0 + 2048), hh = *(const u32x4*)(r0 + 4096);
                        u32x4 cp = {0u, 0u, 0u, 0u}, hp = cp, cn = cp, hn = cp;
                        if (hasp) { cp = *(const u32x4*)(r0 - 6144 + 2048); hp = *(const u32x4*)(r0 - 6144 + 4096); }
                        if (hasn) { cn = *(const u32x4*)(r0 + 6144 + 2048); hn = *(const u32x4*)(r0 + 6144 + 4096); }
                        unsigned o[4];
#pragma unroll
                        for (int q = 0; q < 4; ++q) { const int d = c + 2 * q;
                            const float z0l = bflo(cp[q]) * bflo(hp[q]), z0h = bfhi(cp[q]) * bfhi(hp[q]);
                            const float z1l = bflo(cc[q]) * bflo(hh[q]), z1h = bfhi(cc[q]) * bfhi(hh[q]);
                            const float z2l = bflo(cn[q]) * bflo(hn[q]), z2h = bfhi(cn[q]) * bfhi(hn[q]);
                            const float yl = bflo(bb[q]) * (cw[d] * z0l + cw[D + d] * z1l + cw[2 * D + d] * z2l + cb[d]);
                            const float yh = bfhi(bb[q]) * (cw[d + 1] * z0h + cw[D + d + 1] * z1h + cw[2 * D + d + 1] * z2h + cb[d + 1]);
                            o[q] = pk2(yl, yh); }
                        *(u32x4*)(Ob + (size_t)m * D + c) = (u32x4){o[0], o[1], o[2], o[3]}; }
                }
                ENDPH(P + 5);
            }
        }
        if (IN(P + 6)) { PH_BEGIN;
            const size_t wofs = (L == 0) ? WS_WOT0 : (L == 1) ? WS_WOT1 : (L == 2) ? WS_WFT : WS_WCOT;
            ub = 0; GemmP g{Ob, (const bf16*)(ws + wofs), D, D, 0, 0, 0, 0, 0, 0, MT, D, D, 1, 1, 1};
            pg8::gemm_phase(F.lds, g, EpiResid{Y, X, modL + 2 * D}, F.bid, F.nblk, ub);
            ENDPH(P + 6);
        }
        if (IN(P + 7)) { PH_BEGIN;
            const float* g1 = IP(I_LN1G) + L * D; const float* b1 = IP(I_LN1B) + L * D;
            for (int m = F.gw; m < MT; m += F.ngw) { const float* md = modL + cond_of(m) * 12288;
                ln_row(Y + (size_t)m * D, g1, b1, X + (size_t)m * D, Ub + (size_t)m * D, md + 3 * D, md + 4 * D, nullptr, F.lane); }
            ENDPH(P + 7);
        }
#define PS ((float*)(SCR + 24 * MiB))
#define PU4 ((unsigned char*)(ws + WS_PU))
#define PV4 ((unsigned char*)(ws + WS_PV))
#define SU4 ((bf16*)(ws + WS_PU + 16 * MiB))
#define SV4 ((bf16*)(ws + WS_PV + 16 * MiB))
#define TKI ((int*)(SCR + 80 * MiB))
#define TKG ((float*)(SCR + 84 * MiB))
        if (IN(P + 8)) { PH_BEGIN;
            ub = 0; GemmP g{Ub, (const bf16*)(ws + WS_WPQT) + (size_t)L * D * D, D, D, 0, 0, 0, 0, 0, 0, MT, D, D, 1, 1, 1};
            pg8::gemm_phase(F.lds, g, EpiF32{PS, D, 0, 0, 0, 1.f}, F.bid, F.nblk, ub);
            ENDPH(P + 8);
        }
        if (IN(P + 9)) { PH_BEGIN;
            LAS float* sv = (LAS float*)(F.lds + F.wave * 12288); LAS int* si = (LAS int*)(sv + 1024);
            const float* pu = IP(I_PEERU) + (size_t)L * 16384 * D; const float* pv = IP(I_PEERV) + (size_t)L * 16384 * D;
            int crow = F.gw;
            auto convert_rows = [&](int nrows) {
                for (int it = 0; it < nrows && crow < 32768; ++it, crow += F.ngw) {
                    const bool isv = crow >= 16384; const int e = crow & 16383;
                    const GAS float* src = (const GAS float*)((isv ? pv : pu) + (size_t)e * D) + F.lane * 4;
                    f32x4 v[8]; float mx = 0.f;
#pragma unroll
                    for (int j = 0; j < 8; ++j) { v[j] = *(const GAS f32x4*)(src + j * 256);
                        mx = fmaxf(mx, fmaxf(fmaxf(fabsf(v[j][0]), fabsf(v[j][1])), fmaxf(fabsf(v[j][2]), fabsf(v[j][3])))); }
                    const unsigned sb = f2bf(mx * (1.00390625f / 6.0f)); const float sq = __uint_as_float(sb << 16);
                    const float inv = sq > 0.f ? 1.0f / sq : 0.f;
                    u32x4 o;
#pragma unroll
                    for (int d = 0; d < 4; ++d) { unsigned w = 0u;
                        w = __builtin_amdgcn_cvt_scalef32_pk_fp4_f32(w, v[2 * d][0] * inv, v[2 * d][1] * inv, 1.0f, 0);
                        w = __builtin_amdgcn_cvt_scalef32_pk_fp4_f32(w, v[2 * d][2] * inv, v[2 * d][3] * inv, 1.0f, 1);
                        w = __builtin_amdgcn_cvt_scalef32_pk_fp4_f32(w, v[2 * d + 1][0] * inv, v[2 * d + 1][1] * inv, 1.0f, 2);
                        w = __builtin_amdgcn_cvt_scalef32_pk_fp4_f32(w, v[2 * d + 1][2] * inv, v[2 * d + 1][3] * inv, 1.0f, 3);
                        o[d] = w; }
                    *(GAS u32x4*)((GAS unsigned char*)((isv ? PV4 : PU4) + (size_t)e * 1024) + F.lane * 16) = o;
                    ((GAS bf16*)((isv ? SV4 : SU4) + (size_t)e * 64))[F.lane] = (bf16)sb;
                } };
            if (F.gw < MT / 4) {
                const int m0 = F.gw * 4;
                const float* psb = PS + (size_t)m0 * D;
                const unsigned lofs = (unsigned)F.lane * 512u;
                unsigned top[16];
#pragma unroll
                for (int k = 0; k < 16; ++k) top[k] = 0u;
                f32x4 cur[4], nxt[4];
#pragma unroll
                for (int i = 0; i < 4; ++i) cur[i] = ldg4(psb, lofs + 16u * i);
                for (int ch = 0; ch < 8; ++ch) {
                    if (ch < 7) {
#pragma unroll
                        for (int i = 0; i < 4; ++i) nxt[i] = ldg4(psb, lofs + (unsigned)((ch + 1) * 64 + 16 * i)); }
#pragma unroll
                    for (int i = 0; i < 4; ++i)
#pragma unroll
                        for (int e = 0; e < 4; ++e) { const unsigned u = __float_as_uint(cur[i][e]); const unsigned key = u ^ ((unsigned)((int)u >> 31) | 0x80000000u);
                            unsigned x = (key & ~127u) | (unsigned)(127 - (ch * 16 + i * 4 + e));
#pragma unroll
                            for (int k = 0; k < 16; ++k) { const unsigned hi = top[k] > x ? top[k] : x; x = top[k] > x ? x : top[k]; top[k] = hi; } }
#pragma unroll
                    for (int i = 0; i < 4; ++i) cur[i] = nxt[i];
                }
#pragma unroll
                for (int k = 0; k < 16; ++k) { const int idx = 127 - (int)(top[k] & 127u);
                    sv[F.lane * 16 + k] = *(const GAS float*)((const GAS char*)psb + (lofs + (unsigned)idx * 4u)); si[F.lane * 16 + k] = idx; }
                LDS_WAIT();
                if (F.lane < 32) {
                    const int tl = F.lane >> 3, h = F.lane & 7, la = (tl * 16 + 2 * h) * 16, lb = la + 16;
                    float va[16], vb[16];
#pragma unroll
                    for (int k = 0; k < 16; ++k) { va[k] = sv[la + k]; vb[k] = sv[lb + k]; }
                    unsigned tp[16];
#pragma unroll
                    for (int k = 0; k < 16; ++k) tp[k] = 0u;
#pragma unroll
                    for (int c = 0; c < 50; ++c) { const int fl = cflat(c); const float sum = va[fl >> 4] + vb[fl & 15];
                        const unsigned u = __float_as_uint(sum); const unsigned key = u ^ ((unsigned)((int)u >> 31) | 0x80000000u);
                        unsigned x = (key & ~63u) | (unsigned)(63 - c);
#pragma unroll
                        for (int k = 0; k < 16; ++k) { const unsigned hi = tp[k] > x ? tp[k] : x; x = tp[k] > x ? x : tp[k]; tp[k] = hi; } }
                    float sc[16]; int id[16]; float mx = -3.0e38f;
#pragma unroll
                    for (int k = 0; k < 16; ++k) { const int c = 63 - (int)(tp[k] & 63u); const int fl = cflat(c), a = fl >> 4, b = fl & 15;
                        sc[k] = sv[la + a] + sv[lb + b]; id[k] = si[la + a] * 128 + si[lb + b]; mx = fmaxf(mx, sc[k]); }
                    float sm = 0.f;
#pragma unroll
                    for (int k = 0; k < 16; ++k) { sc[k] = __expf(sc[k] - mx); sm += sc[k]; }
                    const float inv = 1.f / sm;
                    const unsigned ob = (unsigned)((m0 + tl) * 128 + h * 16) * 4u;
#pragma unroll
                    for (int k4 = 0; k4 < 4; ++k4) {
                        *(GAS f32x4*)((GAS char*)TKG + ob + 16u * k4) = (f32x4){sc[4 * k4] * inv, sc[4 * k4 + 1] * inv, sc[4 * k4 + 2] * inv, sc[4 * k4 + 3] * inv};
                        *(GAS u32x4*)((GAS char*)TKI + ob + 16u * k4) = (u32x4){(unsigned)id[4 * k4], (unsigned)id[4 * k4 + 1], (unsigned)id[4 * k4 + 2], (unsigned)id[4 * k4 + 3]}; }
                }
            }
            convert_rows(1 << 20);
            ENDPH(P + 9);
        }
        if (IN(P + 10)) { PH_BEGIN;
            const float* g2 = IP(I_LN2G) + L * D; const float* b2 = IP(I_LN2B) + L * D;
            const unsigned char* pu4 = PU4; const unsigned char* pv4 = PV4; const bf16* su4 = SU4; const bf16* sv4 = SV4;
            for (int m = F.gw; m < MT; m += F.ngw) {
                const int idA = ((const GAS int*)TKI)[(unsigned)(m * 128 + F.lane)], idB = ((const GAS int*)TKI)[(unsigned)(m * 128 + 64 + F.lane)];
                const float gtA = ((const GAS float*)TKG)[(unsigned)(m * 128 + F.lane)], gtB = ((const GAS float*)TKG)[(unsigned)(m * 128 + 64 + F.lane)];
                u32x2 xp[8];
#pragma unroll
                for (int j = 0; j < 8; ++j) xp[j] = ldg2u(Ub + (size_t)m * D, (unsigned)F.lane * 8u + (unsigned)(j * 512));
                struct RL { u32x4 w; unsigned short s; };
                auto ldrow = [&](RL& r, const unsigned char* tb, const bf16* sb, int e) {
                    const int ex = (e < 64) ? __builtin_amdgcn_readlane(idA, e & 63) : __builtin_amdgcn_readlane(idB, e & 63);
                    r.w = *(const GAS u32x4*)((const GAS char*)(tb + (size_t)ex * 1024) + (unsigned)F.lane * 16u); r.s = *(const GAS unsigned short*)((const GAS char*)(sb + (size_t)ex * 64) + (unsigned)F.lane * 2u); };
                float a0 = 0.f, a1 = 0.f, a2 = 0.f, a3 = 0.f;
                {
                    RL ring[16];
#pragma unroll
                    for (int r = 0; r < 16; ++r) ldrow(ring[r], pu4, su4, r);
                    __builtin_amdgcn_sched_barrier(0);
#pragma unroll
                    for (int c = 0; c < 4; ++c) {
                        float hp[32];
#pragma unroll
                        for (int i = 0; i < 32; ++i) {
                            const RL cur = ring[i & 15];
                            const int en = c * 32 + i + 16;
                            if (en < 128) ldrow(ring[i & 15], pu4, su4, en);
                            __builtin_amdgcn_sched_barrier(0);
                            float acc = 0.f;
#pragma unroll
                            for (int d = 0; d < 4; ++d) { const unsigned w = cur.w[d];
                                const f32x2 r0 = __builtin_amdgcn_cvt_scalef32_pk_f32_fp4(w, 1.0f, 0), r1 = __builtin_amdgcn_cvt_scalef32_pk_f32_fp4(w, 1.0f, 1), r2 = __builtin_amdgcn_cvt_scalef32_pk_f32_fp4(w, 1.0f, 2), r3 = __builtin_amdgcn_cvt_scalef32_pk_f32_fp4(w, 1.0f, 3);
                                acc += r0[0] * bflo(xp[2 * d][0]) + r0[1] * bfhi(xp[2 * d][0]) + r1[0] * bflo(xp[2 * d][1]) + r1[1] * bfhi(xp[2 * d][1]);
                                acc += r2[0] * bflo(xp[2 * d + 1][0]) + r2[1] * bfhi(xp[2 * d + 1][0]) + r3[0] * bflo(xp[2 * d + 1][1]) + r3[1] * bfhi(xp[2 * d + 1][1]); }
                            hp[i] = acc * __uint_as_float((unsigned)cur.s << 16);
                        }
#pragma unroll
                        for (int st = 0; st < 5; ++st) { const int o = 32 >> st, n = 16 >> st; const bool up = (F.lane & o) != 0;
#pragma unroll
                            for (int i = 0; i < n; ++i) { const float keep = up ? hp[i + n] : hp[i], send = up ? hp[i] : hp[i + n]; hp[i] = keep + __shfl_xor(send, o); } }
                        const float hh = hp[0] + __shfl_xor(hp[0], 1);
                        const float gsel = (c < 2) ? gtA : gtB;
                        const float gte = __shfl(gsel, (c * 32 + (F.lane >> 1)) & 63);
                        const float av = 0.5f * hh * (1.0f + erff(hh * 0.70710678118654752f)) * gte;
                        a0 = (c == 0) ? av : a0; a1 = (c == 1) ? av : a1; a2 = (c == 2) ? av : a2; a3 = (c == 3) ? av : a3;
                    }
                }
                f32x2 fb[8][2];
#pragma unroll
                for (int j = 0; j < 8; ++j) { fb[j][0] = (f32x2){0.f, 0.f}; fb[j][1] = (f32x2){0.f, 0.f}; }
                {
                    RL ring[16];
#pragma unroll
                    for (int r = 0; r < 16; ++r) ldrow(ring[r], pv4, sv4, r);
                    __builtin_amdgcn_sched_barrier(0);
#pragma unroll
                    for (int c = 0; c < 4; ++c) {
                        const float asel = (c == 0) ? a0 : (c == 1) ? a1 : (c == 2) ? a2 : a3;
#pragma unroll
                        for (int i = 0; i < 32; ++i) {
                            const RL cur = ring[i & 15];
                            const int en = c * 32 + i + 16;
                            if (en < 128) ldrow(ring[i & 15], pv4, sv4, en);
                            __builtin_amdgcn_sched_barrier(0);
                            const float ae = __builtin_bit_cast(float, __builtin_amdgcn_readlane(__builtin_bit_cast(int, asel), 2 * i));
                            const float as = ae * __uint_as_float((unsigned)cur.s << 16); const f32x2 as2 = {as, as};
#pragma unroll
                            for (int d = 0; d < 4; ++d) { const unsigned w = cur.w[d];
                                fb[2 * d][0] += as2 * __builtin_amdgcn_cvt_scalef32_pk_f32_fp4(w, 1.0f, 0); fb[2 * d][1] += as2 * __builtin_amdgcn_cvt_scalef32_pk_f32_fp4(w, 1.0f, 1);
                                fb[2 * d + 1][0] += as2 * __builtin_amdgcn_cvt_scalef32_pk_f32_fp4(w, 1.0f, 2); fb[2 * d + 1][1] += as2 * __builtin_amdgcn_cvt_scalef32_pk_f32_fp4(w, 1.0f, 3); }
                        }
                    }
                }
                float fa[8][4];
#pragma unroll
                for (int j = 0; j < 8; ++j) { fa[j][0] = fb[j][0][0]; fa[j][1] = fb[j][0][1]; fa[j][2] = fb[j][1][0]; fa[j][3] = fb[j][1][1]; }
                const int cnd = cond_of(m);
                const float* gt2 = modL + cnd * 12288 + 5 * D; float* xrow = X + (size_t)m * D;
                const unsigned lb = (unsigned)F.lane * 16u;
                float s = 0.f;
#pragma unroll
                for (int j = 0; j < 8; ++j) { const unsigned c = lb + (unsigned)(j * 1024);
                    const f32x4 x0 = ldg4(xrow, c), g0 = ldg4(gt2, c);
#pragma unroll
                    for (int e = 0; e < 4; ++e) { fa[j][e] = ALPHA * x0[e] + g0[e] * fa[j][e]; s += fa[j][e]; } }
                const float mean = wave_sum(s) * (1.f / D); float s2 = 0.f;
#pragma unroll
                for (int j = 0; j < 8; ++j)
#pragma unroll
                    for (int e = 0; e < 4; ++e) { fa[j][e] -= mean; s2 += fa[j][e] * fa[j][e]; }
                const float rstd = rsqrtf(wave_sum(s2) * (1.f / D) + LN_EPS);
                const float* mdn = MODS + ((L < 3 ? L + 1 : L) * 3 + cnd) * 12288;
                float* orow = args.out + OUT_Y + (size_t)m * D; bf16* urow = Ub + (size_t)m * D;
#pragma unroll
                for (int j = 0; j < 8; ++j) { const unsigned c = lb + (unsigned)(j * 1024);
                    const f32x4 f = {fa[j][0], fa[j][1], fa[j][2], fa[j][3]};
                    const f32x4 o = f * rstd * ldg4(g2, c) + ldg4(b2, c);
                    stg4(xrow, c, o);
                    if (L == 3) stg4(orow, c, o);
                    else { const f32x4 u = o * (ldg4(mdn + D, c) + 1.0f) + ldg4(mdn, c); stg2u(urow, (unsigned)F.lane * 8u + (unsigned)(j * 512), (u32x2){pk2(u[0], u[1]), pk2(u[2], u[3])}); } }
            }
            ENDPH(P + 10);
        }
}

__global__ void __launch_bounds__(NTHR, 2) fwd(Args args) {
    extern __shared__ __attribute__((aligned(16))) unsigned char lds_raw[];
    Frame F;
    F.lds = (LAS unsigned char*)lds_raw; F.ws = args.ws;
    F.tid = threadIdx.x; F.lane = F.tid & 63; F.wave = __builtin_amdgcn_readfirstlane(F.tid >> 6);
    F.bid = blockIdx.x; F.nblk = gridDim.x; F.gw = F.bid * NWAVE + F.wave; F.ngw = F.nblk * NWAVE;
    unsigned char* const ws_ = args.ws;
    const int lo = args.ph_lo, hi = args.ph_hi;
    volatile LAS unsigned* MISC = (volatile LAS unsigned*)(F.lds + LDS_MISC);
    if (F.tid < 16) MISC[F.tid] = 0u;
    __syncthreads();
    XcdBarrier bar; bar.bar = (unsigned*)(ws_ + WS_CTL) + 4096; bar.x = 0; bar.st = MISC + 8;
#if !MK_PER_PHASE
    bar = xcd_barrier_post((unsigned*)(ws_ + WS_CTL) + 4096, MISC + 8);
#endif
    int ub;

    if (IN(0)) { PH_BEGIN;
        LAS float* sc = (LAS float*)F.lds;
        LAS float* part = (LAS float*)(F.lds + 24576);
        for (int i = F.tid; i < 3 * D; i += NTHR) { const int j = i >> 11, k = i & 2047; const float c = (j == 0) ? IP(I_CCTX)[k] : IP(I_C)[(j - 1) * D + k]; sc[i] = c / (1.f + __expf(-c)); }
        __syncthreads();
        const float* adaw = IP(I_ADAW); const float* adab = IP(I_ADAB);
        for (int u = F.bid; u < 768; u += F.nblk) {
            const int layer = u / 192, n0 = (u % 192) * 64, kr = F.lane >> 4, cq = F.lane & 15;
            f32x4 a0 = {0.f, 0.f, 0.f, 0.f}, a1 = a0, a2 = a0;
            const float* wp = adaw + ((size_t)layer * D + F.wave * 256 + kr) * 12288 + n0 + cq * 4;
#pragma unroll 8
            for (int it = 0; it < 64; ++it) { const f32x4 w = *(const f32x4*)(wp + (size_t)it * 4 * 12288); const int k = F.wave * 256 + it * 4 + kr;
                a0 += w * sc[k]; a1 += w * sc[D + k]; a2 += w * sc[2 * D + k]; }
#pragma unroll
            for (int e = 0; e < 4; ++e) { a0[e] += __shfl_xor(a0[e], 16); a0[e] += __shfl_xor(a0[e], 32); a1[e] += __shfl_xor(a1[e], 16); a1[e] += __shfl_xor(a1[e], 32); a2[e] += __shfl_xor(a2[e], 16); a2[e] += __shfl_xor(a2[e], 32); }
            if (F.lane < 16) {
#pragma unroll
                for (int e = 0; e < 4; ++e) { part[(F.wave * 3 + 0) * 64 + cq * 4 + e] = a0[e]; part[(F.wave * 3 + 1) * 64 + cq * 4 + e] = a1[e]; part[(F.wave * 3 + 2) * 64 + cq * 4 + e] = a2[e]; } }
            __syncthreads();
            if (F.tid < 192) { const int j = F.tid >> 6, c = F.tid & 63; float s = adab[layer * 12288 + n0 + c];
#pragma unroll
                for (int w = 0; w < 8; ++w) s += part[(w * 3 + j) * 64 + c];
                MODS[(layer * 3 + j) * 12288 + n0 + c] = s; }
            __syncthreads();
        }
        {
            LAS float* scr = (LAS float*)(F.lds + F.wave * 8448);
            for (int it = F.gw; it < args.tj_total; it += F.ngw) {
                int j = 0;
#pragma unroll
                for (int q = 1; q < NTJOB; ++q) j = (it >= args.tj[q].first) ? q : j;
                const TJob& J = args.tj[j];
                transpose_item(J.W, J.K, J.N, (bf16*)(ws + J.dst), J.row_off, scr, it - J.first, F.lane);
            }
        }
        const int gt = F.bid * NTHR + F.tid, ngt = F.nblk * NTHR;
        { const float* wq = IP(I_WPQ); bf16* WQb = (bf16*)SCR;
          for (int i = gt; i < 4 * 2048 * 2048 / 8; i += ngt) { const f32x4 a = *(const GAS f32x4*)((const GAS float*)wq + (size_t)i * 8), b = *(const GAS f32x4*)((const GAS float*)wq + (size_t)i * 8 + 4);
              *(GAS u32x4*)((GAS bf16*)WQb + (size_t)i * 8) = (u32x4){pk2(a[0], a[1]), pk2(a[2], a[3]), pk2(b[0], b[1]), pk2(b[2], b[3])}; } }
        if (gt < 1024) { const int pos = gt >> 4, j = gt & 15; const float inv = exp2f(-(float)j * (13.287712379549449f / 16.0f)); float sn, cs; sincosf((float)pos * inv, &sn, &cs);
            ROPET[gt] = cs; ROPET[1024 + gt] = sn; }
        { const float* sk = IP(I_SUBK); bf16* SK = (bf16*)(ws + WS_SK);
          for (int i = gt; i < 4 * 16 * 128 * 128 / 4; i += ngt) { const f32x4 v = *(const f32x4*)(sk + (size_t)i * 4); *(u32x2*)(SK + (size_t)i * 4) = (u32x2){pk2(v[0], v[1]), pk2(v[2], v[3])}; } }
        { bf16* CS = (bf16*)(ws + WS_CS512);
          for (int i = gt; i < 1024 * 512; i += ngt) { const int j = i >> 9, c = i & 511, r = ((j & 511) * c) & 511; const float x = (float)r * (1.f / 256.f); CS[i] = (bf16)f2bf(j < 512 ? cospif(x) : sinpif(x)); } }
        { bf16* CT = (bf16*)(ws + WS_CT256);
          for (int i = gt; i < 256 * 512; i += ngt) { const int t = i >> 9, k = i & 511, r = (t * (k & 255)) & 255; const float x = (float)r * (1.f / 128.f); CT[i] = (bf16)f2bf(k < 256 ? cospif(x) : -sinpif(x)); } }
        { bf16* CT = (bf16*)(ws + WS_CT1024);
          for (int i = gt; i < 1024 * 2048; i += ngt) { const int t = i >> 11, k = i & 2047, r = (t * (k & 1023)) & 1023; const float x = (float)r * (1.f / 512.f); CT[i] = (bf16)f2bf(k < 1024 ? cospif(x) : -sinpif(x)); } }
        { const float* c0 = IP(I_C0CKV); bf16* ckvp = (bf16*)(ws + WS_CKV);
          for (int i = gt; i < 2 * 256 * 512; i += ngt) { const int b = i >> 17, r = i & 131071; ckvp[(size_t)(NPR + b * 1280 + 1024) * 512 + r] = (bf16)f2bf(c0[i]); } }
        { const float* c0 = IP(I_C0KR); bf16* kcp = (bf16*)(ws + WS_KC);
          for (int i = gt; i < 2 * 256 * 64 * 16; i += ngt) { const int h = i & 15, e = i >> 4, j = e & 63, s = (e >> 6) & 255, b = e >> 14;
              kcp[((size_t)(NPR + b * 1280 + 1024 + s) * 16 + h) * 192 + 128 + j] = (bf16)f2bf(c0[e]); } }
        ENDPH(0);
    }
    if (IN(1)) { PH_BEGIN;
        for (int m = F.gw; m < MT; m += F.ngw) {
            const float* xr = (m < NPR) ? IP(I_XP) + (size_t)m * D : IP(I_XS) + (size_t)(m - NPR) * D;
            const float* md = MODS + cond_of(m) * 12288;
#pragma unroll
            for (int i = 0; i < 8; ++i) { const int c = i * 256 + F.lane * 4; const f32x4 v = *(const f32x4*)(xr + c);
                *(f32x4*)(X + (size_t)m * D + c) = v;
                const f32x4 u = v * (*(const f32x4*)(md + D + c) + 1.0f) + *(const f32x4*)(md + c);
                *(u32x2*)(Ub + (size_t)m * D + c) = (u32x2){pk2(u[0], u[1]), pk2(u[2], u[3])}; }
        }
        {
            int ub = 0; GemmP g{(const bf16*)(ws + WS_SK), (const bf16*)SCR, 128, D, 16L * 16384, 16384, 0, (long)D * D, 128, 0, 128, D, 128, 4, 16, 1};
            sg_gemm(F.lds, g, EpiBf16{(bf16*)(ws + WS_WPQT), D, (long)D * D, 128L * D, 0, 1.f}, F.bid, F.nblk, ub);
        }
        ENDPH(1);
    }

    layer_phases<0>(args, F, ws_, lo, hi, bar);
    layer_phases<1>(args, F, ws_, lo, hi, bar);
    layer_phases<2>(args, F, ws_, lo, hi, bar);
    layer_phases<3>(args, F, ws_, lo, hi, bar);
}

static const int kPhases[] = {0, 1,
    2, 3, 4, 5, 6, 7, 8, 9, 10, 11, 12,
    18, 21, 22, 23, 24, 25, 26, 27, 28,
    34, 39, 40, 41, 42, 43, 44,
    50, 55, 56, 57, 58, 59, 60};

extern "C" void kernel_launch(void* const* d_in, const int* in_sizes, int n_in, void* d_out, int out_size, void* d_ws, size_t ws_size, hipStream_t stream) {
    static int grid = 0;
    if (grid == 0) {
        if (n_in != 34 || ws_size < WS_END) { fprintf(stderr, "kernel_launch: unexpected n_in %d / ws_size %zu\n", n_in, ws_size); grid = -1; return; }
        int dev = 0, cus = 0;
        if (hipGetDevice(&dev) != hipSuccess || hipDeviceGetAttribute(&cus, hipDeviceAttributeMultiprocessorCount, dev) != hipSuccess) { grid = -1; return; }
        if (hipFuncSetAttribute((const void*)fwd, hipFuncAttributeMaxDynamicSharedMemorySize, LDS_BYTES) != hipSuccess) { fprintf(stderr, "kernel_launch: hipFuncSetAttribute failed\n"); grid = -1; return; }
        int per_cu = 0;
        if (hipOccupancyMaxActiveBlocksPerMultiprocessor(&per_cu, (const void*)fwd, NTHR, LDS_BYTES) != hipSuccess || per_cu < 1) fprintf(stderr, "kernel_launch: occupancy query says %d\n", per_cu);
        (void)hipGetLastError();
        grid = cus;
    }
    if (grid < 0) return;
    (void)hipMemsetAsync((char*)d_ws + WS_CTL, 0, CTL_BYTES, stream);
    Args a{};
    for (int i = 0; i < 34; ++i) a.in[i] = (const float*)d_in[i];
    a.out = (float*)d_out; a.ws = (unsigned char*)d_ws;
    {
        struct J { int idx; size_t sub; size_t dst; int K, N, row_off; };
        const J js[NTJOB] = {
            {I_WDQ, 0, WS_W0T, 2048, 512, 0}, {I_WDKV, 0, WS_W0T, 2048, 576, 512}, {I_WUQ, 0, WS_WUQT, 512, 3072, 0}, {I_WUK, 0, WS_WUKT, 512, 2048, 0},
            {I_WUV, 0, WS_WUVT, 512, 2048, 0}, {I_WO0, 0, WS_WOT0, 2048, 2048, 0}, {I_WQKV, 0, WS_WQKVT, 2048, 3072, 0}, {I_WO1, 0, WS_WOT1, 2048, 2048, 0},
            {I_WF, 0, WS_WFT, 2048, 2048, 0}, {I_WIN, 0, WS_WINT, 2048, 6144, 0}, {I_WCO, 0, WS_WCOT, 2048, 2048, 0}};
        int first = 0;
        for (int j = 0; j < NTJOB; ++j) { a.tj[j].W = (const float*)d_in[js[j].idx] + js[j].sub; a.tj[j].dst = js[j].dst; a.tj[j].K = js[j].K; a.tj[j].N = js[j].N; a.tj[j].row_off = js[j].row_off; a.tj[j].first = first;
            first += (js[j].K / 64) * (js[j].N / 32); }
        a.tj_total = first;
    }
#if MK_PER_PHASE
    for (size_t i = 0; i < sizeof(kPhases) / sizeof(kPhases[0]); ++i) {
        a.ph_lo = kPhases[i]; a.ph_hi = kPhases[i] + 1;
        hipLaunchKernelGGL(fwd, dim3(grid), dim3(NTHR), LDS_BYTES, stream, a);
    }
#else
    a.ph_lo = 0; a.ph_hi = 1 << 20;
    hipLaunchKernelGGL(fwd, dim3(grid), dim3(NTHR), LDS_BYTES, stream, a);
#endif
    const hipError_t le = hipPeekAtLastError();
    if (le != hipSuccess) fprintf(stderr, "kernel_launch: launch failed: %s\n", hipGetErrorName(le));
}
```

```cpp
#include <hip/hip_runtime.h>
#include <cstdio>
#include <cstdint>

#ifndef MK_PER_PHASE
#define MK_PER_PHASE 0
#endif

#define LAS __attribute__((address_space(3)))
typedef unsigned short bf16;
typedef short bf16x8 __attribute__((ext_vector_type(8)));
typedef float f32x4 __attribute__((ext_vector_type(4)));
typedef unsigned u32x4 __attribute__((ext_vector_type(4)));
typedef unsigned u32x2 __attribute__((ext_vector_type(2)));
typedef __bf16 bf16x2_t __attribute__((ext_vector_type(2)));
typedef float f32x2 __attribute__((ext_vector_type(2)));
#define GAS __attribute__((address_space(1)))
__device__ __forceinline__ unsigned pack_fp8x4(f32x4 a) { int w = __builtin_amdgcn_cvt_pk_fp8_f32(a[0], a[1], 0, false); w = __builtin_amdgcn_cvt_pk_fp8_f32(a[2], a[3], w, true); return (unsigned)w; }

constexpr int D = 2048, NPR = 4096, MT = 6144, KVR = 6656;
constexpr int NTHR = 512, NWAVE = 8;
constexpr float ALPHA = 1.6817928305074290f;
constexpr float MLA_SCALE = 0.07216878364870322f;
constexpr float GQA_SCALE = 0.125f;
constexpr float LN_EPS = 1e-5f, RMS_EPS = 1e-6f;

constexpr size_t MiB = 1u << 20;
constexpr size_t WS_CTL = 0, CTL_BYTES = 1 * MiB;
constexpr size_t WS_MODS = 1 * MiB;
constexpr size_t WS_W0T = 2 * MiB, WS_WUQT = 7 * MiB, WS_WUKT = 10 * MiB, WS_WUVT = 12 * MiB, WS_WOT0 = 14 * MiB, WS_WQKVT = 22 * MiB,
                 WS_WOT1 = 34 * MiB, WS_WFT = 42 * MiB, WS_WINT = 50 * MiB, WS_WCOT = 74 * MiB, WS_WPQT = 82 * MiB, WS_SK = 114 * MiB,
                 WS_CS512 = 116 * MiB, WS_CT256 = 117 * MiB, WS_CT1024 = 118 * MiB, WS_PU = 122 * MiB, WS_PV = 186 * MiB,
                 WS_X = 250 * MiB, WS_Y = 298 * MiB, WS_U = 346 * MiB, WS_O = 370 * MiB, WS_Q = 394 * MiB, WS_KC = 430 * MiB,
                 WS_VT = 469 * MiB, WS_QN = 495 * MiB, WS_CKV = 501 * MiB, WS_SCR = 508 * MiB, WS_END = 956 * MiB;
constexpr size_t OUT_Y = 0, OUT_CKV = 12582912, OUT_KR = 14680064, OUT_K1 = 14942208, OUT_V1 = 17039360;

constexpr int LDS_BYTES = 147456;
constexpr int LDS_MISC = 140 * 1024;

#define LDS_WAIT() asm volatile("s_waitcnt lgkmcnt(0)" ::: "memory")
__device__ __forceinline__ unsigned f2bf(float f) { unsigned u = __float_as_uint(f); return (u + 0x7fffu + ((u >> 16) & 1u)) >> 16; }
__device__ __forceinline__ unsigned pk2(float lo, float hi) { unsigned r; asm("v_cvt_pk_bf16_f32 %0, %1, %2" : "=v"(r) : "v"(lo), "v"(hi)); return r; }
__device__ __forceinline__ float bflo(unsigned w) { return __uint_as_float(w << 16); }
__device__ __forceinline__ float bfhi(unsigned w) { return __uint_as_float(w & 0xffff0000u); }
__device__ __forceinline__ float wave_sum(float v) {
#pragma unroll
    for (int o = 1; o < 64; o <<= 1) v += __shfl_xor(v, o);
    return v;
}
__device__ __forceinline__ float wave_max(float v) {
#pragma unroll
    for (int o = 1; o < 64; o <<= 1) v = fmaxf(v, __shfl_xor(v, o));
    return v;
}
__device__ __forceinline__ float dot2bf(unsigned w, unsigned x, float acc) {
    return __builtin_amdgcn_fdot2_f32_bf16(__builtin_bit_cast(bf16x2_t, w), __builtin_bit_cast(bf16x2_t, x), acc, false);
}
__device__ __forceinline__ int cond_of(int m) { return m < NPR ? 0 : 1 + ((m - NPR) >> 10); }
__device__ __forceinline__ int kvrow_of(int m) { return m < NPR ? m : NPR + ((m - NPR) >> 10) * 1280 + ((m - NPR) & 1023); }

#define XB_TMO      128
#define XB_XCNT(j)  (256  + 64 * (j))
#define XB_XSUB(j)  (1280 + 64 * (j))
#define XB_XGEN(j)  (2304 + 64 * (j))
#define XB_TOP      3328
#define XB_TOPGEN   3392
#define XCD_BAR_WORDS 3456
#define XB_SPIN_CAP (1u << 22)
__device__ __forceinline__ unsigned xb_ld(unsigned* p)              { return __hip_atomic_load(p, __ATOMIC_RELAXED, __HIP_MEMORY_SCOPE_AGENT); }
__device__ __forceinline__ unsigned xb_add(unsigned* p, unsigned v) { return __hip_atomic_fetch_add(p, v, __ATOMIC_RELAXED, __HIP_MEMORY_SCOPE_AGENT); }
__device__ __forceinline__ unsigned xb_xcc_id() { return (unsigned)__builtin_amdgcn_s_getreg((3 << 11) | 20) & 0xFu; }
#define XB_SPIN(cond, bar) do { unsigned _sp = 0; while (cond) { __builtin_amdgcn_s_sleep(1); \
    if ((++_sp & 255u) == 0u) { if (xb_ld(&(bar)[XB_TMO])) break; if (_sp > XB_SPIN_CAP) { atomicAdd(&(bar)[XB_TMO], 1u); break; } } } } while (0)
struct XcdBarrier { unsigned* bar; unsigned x; volatile LAS unsigned* st; };
__device__ __forceinline__ XcdBarrier xcd_barrier_post(unsigned* bar, volatile LAS unsigned* st) {
    XcdBarrier b; b.bar = bar; b.x = xb_xcc_id(); b.st = st;
    if (threadIdx.x == 0) (void)xb_add(&bar[XB_XCNT(b.x)], 1u);
    return b;
}
__device__ __forceinline__ void xcd_barrier_complete(unsigned* bar, unsigned x, unsigned& nloc, unsigned& nx) {
    const unsigned G = gridDim.x * gridDim.y * gridDim.z;
    unsigned sum, cnt, mine, sp = 0u;
    for (;;) {
        sum = 0u; cnt = 0u; mine = 0u;
#pragma unroll
        for (unsigned j = 0; j < 16; ++j) { const unsigned c = xb_ld(&bar[XB_XCNT(j)]); sum += c; cnt += (c > 0u) ? 1u : 0u; mine = (j == x) ? c : mine; }
        if (sum == G) break;
        __builtin_amdgcn_s_sleep(1);
        if ((++sp & 255u) == 0u) { if (xb_ld(&bar[XB_TMO])) break; if (sp > XB_SPIN_CAP) { atomicAdd(&bar[XB_TMO], 1u); break; } }
    }
    nloc = mine > 0u ? mine : 1u; nx = cnt > 0u ? cnt : 1u;
}
__device__ __forceinline__ void xcd_barrier(const XcdBarrier& b) {
    asm volatile("s_waitcnt vmcnt(0)" ::: "memory");
    __syncthreads();
    if (threadIdx.x == 0) {
        unsigned* bar = b.bar;
        __builtin_amdgcn_s_waitcnt(0);
        unsigned nloc = b.st[0], nx = b.st[1];
        if (nloc == 0u) { xcd_barrier_complete(bar, b.x, nloc, nx); b.st[0] = nloc; b.st[1] = nx; }
        const unsigned old = xb_add(&bar[XB_XSUB(b.x)], 1u);
        const unsigned gen = old / nloc;
        if (old + 1u == (gen + 1u) * nloc) {
            __builtin_amdgcn_fence(__ATOMIC_RELEASE, "agent");
            asm volatile("s_waitcnt vmcnt(0)" ::: "memory");
            const unsigned og = xb_add(&bar[XB_TOP], 1u);
            const unsigned tg = og / nx;
            if (og + 1u == (tg + 1u) * nx) xb_add(&bar[XB_TOPGEN], 1u);
            else XB_SPIN(xb_ld(&bar[XB_TOPGEN]) == tg, bar);
            __builtin_amdgcn_fence(__ATOMIC_ACQUIRE, "agent");
            xb_add(&bar[XB_XGEN(b.x)], 1u);
            asm volatile("s_waitcnt vmcnt(0)" ::: "memory");
        } else {
            XB_SPIN(xb_ld(&bar[XB_XGEN(b.x)]) == gen, bar);
            __builtin_amdgcn_fence(__ATOMIC_ACQUIRE, "agent");
            asm volatile("s_waitcnt vmcnt(0)" ::: "memory");
        }
    }
    __syncthreads();
}

struct TJob { const float* W; unsigned long long dst; int K, N, row_off, first; };
constexpr int NTJOB = 11;
struct Args {
    const float* in[34];
    float* out;
    unsigned char* ws;
    TJob tj[NTJOB];
    int tj_total;
    int ph_lo, ph_hi, pad;
};
enum { I_XP = 0, I_XS, I_C0CKV, I_C0KR, I_C1K, I_C1V, I_C, I_CCTX, I_ADAW, I_ADAB, I_LN1G, I_LN1B, I_LN2G, I_LN2B,
       I_WDQ, I_QNORM, I_WUQ, I_WDKV, I_KVNORM, I_WUK, I_WUV, I_WO0, I_WQKV, I_SINK, I_WO1, I_WF, I_WIN, I_CONVW, I_CONVB, I_WCO,
       I_WPQ, I_SUBK, I_PEERU, I_PEERV };

struct GemmP {
    const bf16* A; const bf16* B;
    long lda, ldb;
    long sA1, sA2, sA3, sB1, sB2, sB3;
    int M, N, K, nb1, nb2, nb3;
};
constexpr int SG_LDT = 72;
constexpr int SG_TILE = 128 * SG_LDT * 2;
template <class Epi>
__device__ __forceinline__ void sg_gemm(LAS unsigned char* lds, const GemmP g, const Epi& E, int bid, int nblk, int& ubase) {
    const int tid = threadIdx.x, lane = tid & 63, wave = __builtin_amdgcn_readfirstlane(tid >> 6);
    const int wm = wave >> 2, wn = wave & 3, fr = lane & 15, fq = lane >> 4;
    const int tiles_m = (g.M + 127) >> 7, tiles_n = (g.N + 127) >> 7;
    const int nbatch = g.nb1 * g.nb2 * g.nb3;
    const int U = nbatch * tiles_m * tiles_n;
    const int nk = g.K >> 6;
    int first = (bid - (ubase % nblk) + nblk) % nblk;
    ubase += U;
    const int lrow0 = tid >> 3, lkc = tid & 7;
    const int aoff = (wm * 64 + fr) * (SG_LDT * 2) + fq * 16;
    const int boff = (wn * 32 + fr) * (SG_LDT * 2) + fq * 16;
    for (int u = first; u < U; u += nblk) {
        const int tn = u % tiles_n; const int r1 = u / tiles_n; const int tm = r1 % tiles_m; const int b = r1 / tiles_m;
        const int b3 = b % g.nb3, b12 = b / g.nb3, b2 = b12 % g.nb2, b1 = b12 / g.nb2;
        const int m0 = tm << 7, n0 = tn << 7;
        const bf16* Ab = g.A + b1 * g.sA1 + b2 * g.sA2 + b3 * g.sA3;
        const bf16* Bb = g.B + b1 * g.sB1 + b2 * g.sB2 + b3 * g.sB3;
        int ar0 = m0 + lrow0, ar1 = ar0 + 64; ar0 = ar0 < g.M ? ar0 : g.M - 1; ar1 = ar1 < g.M ? ar1 : g.M - 1;
        int br0 = n0 + lrow0, br1 = br0 + 64; br0 = br0 < g.N ? br0 : g.N - 1; br1 = br1 < g.N ? br1 : g.N - 1;
        const bf16* pa0 = Ab + (long)ar0 * g.lda + lkc * 8; const bf16* pa1 = Ab + (long)ar1 * g.lda + lkc * 8;
        const bf16* pb0 = Bb + (long)br0 * g.ldb + lkc * 8; const bf16* pb1 = Bb + (long)br1 * g.ldb + lkc * 8;
        f32x4 acc[4][2];
#pragma unroll
        for (int i = 0; i < 4; ++i) { acc[i][0] = (f32x4){0.f, 0.f, 0.f, 0.f}; acc[i][1] = (f32x4){0.f, 0.f, 0.f, 0.f}; }
        u32x4 ra0 = *(const u32x4*)pa0, ra1 = *(const u32x4*)pa1, rb0 = *(const u32x4*)pb0, rb1 = *(const u32x4*)pb1;
        const int wofs = lrow0 * (SG_LDT * 2) + lkc * 16;
        *(LAS u32x4*)(lds + wofs) = ra0; *(LAS u32x4*)(lds + wofs + 64 * SG_LDT * 2) = ra1;
        *(LAS u32x4*)(lds + SG_TILE + wofs) = rb0; *(LAS u32x4*)(lds + SG_TILE + wofs + 64 * SG_LDT * 2) = rb1;
        __syncthreads();
        for (int kt = 0; kt < nk; ++kt) {
            const int cur = (kt & 1) * 2 * SG_TILE, nxt = ((kt + 1) & 1) * 2 * SG_TILE;
            const bool more = (kt + 1 < nk);
            if (more) { const int ko = (kt + 1) << 6; ra0 = *(const u32x4*)(pa0 + ko); ra1 = *(const u32x4*)(pa1 + ko); rb0 = *(const u32x4*)(pb0 + ko); rb1 = *(const u32x4*)(pb1 + ko); }
#pragma unroll
            for (int ks = 0; ks < 2; ++ks) {
                bf16x8 af[4], bfr[2];
#pragma unroll
                for (int i = 0; i < 4; ++i) af[i] = *(const LAS bf16x8*)(lds + cur + aoff + i * 16 * SG_LDT * 2 + ks * 64);
#pragma unroll
                for (int j = 0; j < 2; ++j) bfr[j] = *(const LAS bf16x8*)(lds + cur + SG_TILE + boff + j * 16 * SG_LDT * 2 + ks * 64);
#pragma unroll
                for (int i = 0; i < 4; ++i)
#pragma unroll
                    for (int j = 0; j < 2; ++j) acc[i][j] = __builtin_amdgcn_mfma_f32_16x16x32_bf16(bfr[j], af[i], acc[i][j], 0, 0, 0);
            }
            if (more) {
                *(LAS u32x4*)(lds + nxt + wofs) = ra0; *(LAS u32x4*)(lds + nxt + wofs + 64 * SG_LDT * 2) = ra1;
                *(LAS u32x4*)(lds + nxt + SG_TILE + wofs) = rb0; *(LAS u32x4*)(lds + nxt + SG_TILE + wofs + 64 * SG_LDT * 2) = rb1;
            }
            __syncthreads();
        }
        const int nn = n0 + wn * 32 + 4 * fq;
        if (n0 + wn * 32 < g.N) {
#pragma unroll
            for (int i = 0; i < 4; ++i) { const int m = m0 + wm * 64 + i * 16 + fr; if (m < g.M) E(b1, b2, b3, m, nn, acc[i][0], acc[i][1]); }
        }
    }
}

namespace pg8 {
constexpr int BM = 256, BK = 64, HALF = 128, HTB = HALF * BK * 2, STAGE_BYTES = 8 * HTB, WGM = 8;
__device__ __forceinline__ int lds_byte(int r, int c) { const int st = (r >> 4) * 2 + (c >> 5), rr = r & 15, cc = c & 31, ob = rr * 64 + cc * 2; return st * 1024 + (ob ^ (((ob >> 9) & 1) << 5)); }
__device__ __forceinline__ void stage_rc(int b, int& R, int& C) { const int st = b / 1024, sb = b % 1024, swz = sb ^ (((sb >> 9) & 1) << 5); R = (st >> 1) * 16 + swz / 64; C = (st & 1) * 32 + (swz % 64) / 2; }
struct Unit { const char* a; const char* b; int pm, pn, b1, b2, b3; };
template <class Epi>
__device__ __forceinline__ void gemm_phase(LAS unsigned char* lds, const GemmP g, const Epi& E, int bid, int nblk, int& ubase) {
    const int tid = threadIdx.x, wid = __builtin_amdgcn_readfirstlane(tid >> 6), lane = tid & 63, wr = wid >> 2, wc = wid & 3, fr = lane & 15, fq = lane >> 4;
    const int nt = g.K / BK;
    const int nM = g.M / BM, nN = g.N / BM, nwg = nM * nN, U = g.nb1 * g.nb2 * g.nb3 * nwg;
    const int cidx = (bid - (ubase % nblk) + nblk) % nblk; ubase += U;
    auto next = [&](int i, Unit& u) -> bool {
        const long Lq = (long)i * nblk + cidx; if (Lq >= U) return false;
        const int b = (int)(Lq / nwg), w = (int)(Lq % nwg);
        const int nig = WGM * nN, gid = w / nig, fm = gid * WGM, gsz = (nM - fm) < WGM ? (nM - fm) : WGM;
        u.pm = fm + ((w % nig) % gsz); u.pn = (w % nig) / gsz;
        u.b3 = b % g.nb3; const int b12 = b / g.nb3; u.b2 = b12 % g.nb2; u.b1 = b12 / g.nb2;
        u.a = (const char*)(g.A + u.b1 * g.sA1 + u.b2 * g.sA2 + u.b3 * g.sA3 + (long)u.pm * BM * g.lda);
        u.b = (const char*)(g.B + u.b1 * g.sB1 + u.b2 * g.sB2 + u.b3 * g.sB3 + (long)u.pn * BM * g.ldb);
        return true; };
    unsigned voffA[2], voffB[2];
#pragma unroll
    for (int i = 0; i < 2; ++i) { int R, C; stage_rc(tid * 16 + i * 8192, R, C); voffA[i] = (unsigned)(R * (int)g.lda + C) * 2u; voffB[i] = (unsigned)(R * (int)g.ldb + C) * 2u; }
    const size_t kstep = (size_t)(BK * 2);
    const size_t hstepA = (size_t)HALF * g.lda * 2, hstepB = (size_t)HALF * g.ldb * 2;
    const unsigned ldsw = (unsigned)wid * 1024u;
    const int aoff = lds_byte(wr * 64 + fr, fq * 8), boff = lds_byte(wc * 32 + fr, fq * 8);
#define PG8_SA(b, h) (((b) * 2 + (h)) * HTB)
#define PG8_SB(b, h) ((4 + (b) * 2 + (h)) * HTB)
#define PG8_STAGE(bufoff, gbase, voff) do { _Pragma("unroll") for (int _i = 0; _i < 2; ++_i) \
        __builtin_amdgcn_global_load_lds((const unsigned*)((const char*)(gbase) + (voff)[_i]), (LAS unsigned*)(lds + (bufoff) + ldsw + _i * 8192), 16, 0, 0); } while (0)
#define PG8_LDA(dst, b, h) do { _Pragma("unroll") for (int m = 0; m < 4; ++m) _Pragma("unroll") for (int k = 0; k < 2; ++k) dst[m][k] = *(const LAS bf16x8*)(lds + PG8_SA(b, h) + aoff + m * 2048 + k * 1024); } while (0)
#define PG8_LDB(dst, b, h) do { _Pragma("unroll") for (int n = 0; n < 2; ++n) _Pragma("unroll") for (int k = 0; k < 2; ++k) dst[n][k] = *(const LAS bf16x8*)(lds + PG8_SB(b, h) + boff + n * 2048 + k * 1024); } while (0)
#define PG8_MMA(ai, bj, At, Bt) do { __builtin_amdgcn_s_setprio(1); _Pragma("unroll") for (int m = 0; m < 4; ++m) _Pragma("unroll") for (int n = 0; n < 2; ++n) _Pragma("unroll") for (int k = 0; k < 2; ++k) \
        acc[ai][bj][m][n] = __builtin_amdgcn_mfma_f32_16x16x32_bf16(Bt[n][k], At[m][k], acc[ai][bj][m][n], 0, 0, 0); __builtin_amdgcn_s_setprio(0); } while (0)
#define PG8_WAIT_V(n) asm volatile("s_waitcnt vmcnt(" #n ")" ::: "memory")
#define PG8_WAIT_L(n) asm volatile("s_waitcnt lgkmcnt(" #n ")" ::: "memory")
#define PG8_BAR __builtin_amdgcn_s_barrier()
#define PG8_SCHED __builtin_amdgcn_sched_barrier(0)
    Unit cur, nxt; int ui = 0;
    if (!next(0, cur)) return;
    f32x4 acc[2][2][4][2];
#pragma unroll
    for (int a = 0; a < 2; ++a)
#pragma unroll
        for (int b = 0; b < 2; ++b)
#pragma unroll
            for (int m = 0; m < 4; ++m)
#pragma unroll
                for (int n = 0; n < 2; ++n) acc[a][b][m][n] = (f32x4){0.f, 0.f, 0.f, 0.f};
    bf16x8 At[4][2], B0[2][2], B1[2][2];
    const char* cA = cur.a; const char* cB = cur.b;
    PG8_STAGE(PG8_SB(0, 0), cB, voffB); PG8_STAGE(PG8_SA(0, 0), cA, voffA); PG8_STAGE(PG8_SB(0, 1), cB + hstepB, voffB); PG8_STAGE(PG8_SA(0, 1), cA + hstepA, voffA);
    if (wr == 1) PG8_BAR;
    PG8_WAIT_V(4); PG8_BAR;
    PG8_STAGE(PG8_SB(1, 0), cB + kstep, voffB); PG8_STAGE(PG8_SA(1, 0), cA + kstep, voffA); PG8_STAGE(PG8_SB(1, 1), cB + hstepB + kstep, voffB);
    PG8_WAIT_V(6); PG8_BAR;
    for (;;) {
        const bool has_next = next(ui + 1, nxt);
        const char* nA = has_next ? nxt.a : cA; const char* nB = has_next ? nxt.b : cB;
        for (int t = 0; t < nt; t += 2) {
            const bool last = (t == nt - 2);
            const char* a1 = cA + (size_t)(t + 1) * kstep;
            const char* a2 = last ? nA : cA + (size_t)(t + 2) * kstep; const char* b2 = last ? nB : cB + (size_t)(t + 2) * kstep;
            const char* a3 = a2 + kstep; const char* b3 = b2 + kstep;
            PG8_LDB(B0, 0, 0); PG8_SCHED; PG8_LDA(At, 0, 0); PG8_STAGE(PG8_SA(1, 1), a1 + hstepA, voffA);
            PG8_WAIT_L(8); PG8_BAR; PG8_WAIT_L(0); PG8_MMA(0, 0, At, B0); PG8_BAR; PG8_SCHED;
            PG8_LDB(B1, 0, 1); PG8_STAGE(PG8_SB(0, 0), b2, voffB);
            PG8_BAR; PG8_WAIT_L(0); PG8_MMA(0, 1, At, B1); PG8_BAR;
            PG8_LDA(At, 0, 1); PG8_STAGE(PG8_SA(0, 0), a2, voffA);
            PG8_BAR; PG8_WAIT_L(0); PG8_MMA(1, 0, At, B0); PG8_BAR; PG8_SCHED;
            PG8_STAGE(PG8_SB(0, 1), b2 + hstepB, voffB);
            PG8_WAIT_V(6); PG8_BAR; PG8_MMA(1, 1, At, B1); PG8_BAR;
            PG8_LDB(B0, 1, 0); PG8_SCHED; PG8_LDA(At, 1, 0); PG8_STAGE(PG8_SA(0, 1), a2 + hstepA, voffA);
            PG8_WAIT_L(8); PG8_BAR; PG8_WAIT_L(0); PG8_MMA(0, 0, At, B0); PG8_BAR; PG8_SCHED;
            PG8_LDB(B1, 1, 1); PG8_STAGE(PG8_SB(1, 0), b3, voffB);
            PG8_BAR; PG8_WAIT_L(0); PG8_MMA(0, 1, At, B1); PG8_BAR;
            PG8_LDA(At, 1, 1); PG8_STAGE(PG8_SA(1, 0), a3, voffA);
            PG8_BAR; PG8_WAIT_L(0); PG8_MMA(1, 0, At, B0); PG8_BAR; PG8_SCHED;
            PG8_STAGE(PG8_SB(1, 1), b3 + hstepB, voffB);
            PG8_WAIT_V(6); PG8_BAR; PG8_MMA(1, 1, At, B1); PG8_BAR;
        }
#pragma unroll
        for (int ai = 0; ai < 2; ++ai)
#pragma unroll
            for (int mm = 0; mm < 4; ++mm) { const int row = cur.pm * BM + ai * HALF + wr * 64 + mm * 16 + fr;
#pragma unroll
                for (int bj = 0; bj < 2; ++bj) E(cur.b1, cur.b2, cur.b3, row, cur.pn * BM + bj * HALF + wc * 32 + 4 * fq, acc[ai][bj][mm][0], acc[ai][bj][mm][1]); }
        if (!has_next) break;
#pragma unroll
        for (int a = 0; a < 2; ++a)
#pragma unroll
            for (int b = 0; b < 2; ++b)
#pragma unroll
                for (int m = 0; m < 4; ++m)
#pragma unroll
                    for (int n = 0; n < 2; ++n) acc[a][b][m][n] = (f32x4){0.f, 0.f, 0.f, 0.f};
        cur = nxt; cA = nA; cB = nB; ++ui;
    }
    PG8_WAIT_V(0);
    if (wr == 0) PG8_BAR;
    PG8_BAR;
#undef PG8_SA
#undef PG8_SB
#undef PG8_STAGE
#undef PG8_LDA
#undef PG8_LDB
#undef PG8_MMA
#undef PG8_WAIT_V
#undef PG8_WAIT_L
#undef PG8_BAR
#undef PG8_SCHED
}
}

struct AttnP {
    const bf16* Q; long ldq; long qb;
    const bf16* K; long ldk; long kb; int kshift;
    const bf16* VT; long ldv;
    bf16* O;
    const float* sink; float scale;
    int nb, nh, T, S, Tlat;
};
template <int DQ, int DV, bool BAND, bool SINK>
__device__ __forceinline__ void flash_attn(LAS unsigned char* lds, const AttnP p, int bid, int nblk, int& ubase) {
    constexpr int KROW = (DQ + 8) * 2, KBYTES = 64 * KROW, VROW = 144, VBYTES = DV * VROW, BUF = KBYTES + VBYTES;
    constexpr int KCH = 64 * DQ / 8 / 512, VCH = DV * 8 / 512, NKS = DQ / 32, NDF = DV / 16;
    const int tid = threadIdx.x, lane = tid & 63, wave = __builtin_amdgcn_readfirstlane(tid >> 6), fr = lane & 15, fq = lane >> 4;
    const int nqt = p.T >> 7, U = p.nb * p.nh * nqt;
    const int first = (bid - (ubase % nblk) + nblk) % nblk; ubase += U;
    for (int u = first; u < U; u += nblk) {
        const int qt = u % nqt, bh = u / nqt, h = bh % p.nh, b = bh / p.nh, hk = h >> p.kshift;
        const int t0 = qt << 7, tq = t0 + wave * 16 + fr;
        int lo = 0, hi = (p.S >> 6) - 1, nlat_end = (p.S >> 6);
        if (BAND) { const int a = t0 - 128; lo = (a > 0 ? a : 0) >> 6; const int e = t0 + 255; hi = ((e < p.Tlat - 1 ? e : p.Tlat - 1) >> 6); nlat_end = p.Tlat >> 6; }
        const int nlat = hi - lo + 1, ntile = BAND ? nlat + ((p.S - p.Tlat) >> 6) : (p.S >> 6);
        auto tile_of = [&](int i) -> int { return BAND ? (i < nlat ? lo + i : nlat_end + (i - nlat)) : i; };
        const bf16* Kb = p.K + ((long)b * p.kb) * p.ldk + hk * DQ;
        const bf16* Vb = p.VT + ((long)hk * DV) * p.ldv + (long)b * p.kb;
        bf16x8 qf[NKS];
        { const bf16* qp = p.Q + (long)b * p.qb + (long)tq * p.ldq + h * DQ + fq * 8;
#pragma unroll
          for (int ks = 0; ks < NKS; ++ks) qf[ks] = *(const bf16x8*)(qp + ks * 32); }
        float mrow = SINK ? p.sink[h] * 1.4426950408889634f : -1.0e30f, lrow = 0.f;
        f32x4 oacc[NDF];
#pragma unroll
        for (int d = 0; d < NDF; ++d) oacc[d] = (f32x4){0.f, 0.f, 0.f, 0.f};
        u32x4 rk[KCH], rv[VCH];
        auto gload = [&](int kt) {
#pragma unroll
            for (int i = 0; i < KCH; ++i) { const int c = tid + i * 512, r = c / (DQ / 8), kc = c % (DQ / 8); rk[i] = *(const u32x4*)(Kb + (long)(kt * 64 + r) * p.ldk + kc * 8); }
#pragma unroll
            for (int i = 0; i < VCH; ++i) { const int c = tid + i * 512, r = c >> 3, kc = c & 7; rv[i] = *(const u32x4*)(Vb + (long)r * p.ldv + kt * 64 + kc * 8); } };
        auto lstore = [&](int buf) {
#pragma unroll
            for (int i = 0; i < KCH; ++i) { const int c = tid + i * 512, r = c / (DQ / 8), kc = c % (DQ / 8); *(LAS u32x4*)(lds + buf * BUF + r * KROW + kc * 16) = rk[i]; }
#pragma unroll
            for (int i = 0; i < VCH; ++i) { const int c = tid + i * 512, r = c >> 3, kc = c & 7; *(LAS u32x4*)(lds + buf * BUF + KBYTES + r * VROW + kc * 16) = rv[i]; } };
        gload(tile_of(0)); lstore(0);
        __syncthreads();
        for (int it = 0; it < ntile; ++it) {
            const int cur = it & 1; const bool more = it + 1 < ntile; const int kt = tile_of(it);
            if (more) gload(tile_of(it + 1));
            const LAS unsigned char* kl = lds + cur * BUF; const LAS unsigned char* vl = kl + KBYTES;
            f32x4 sacc[4];
#pragma unroll
            for (int nf = 0; nf < 4; ++nf) { sacc[nf] = (f32x4){0.f, 0.f, 0.f, 0.f};
#pragma unroll
                for (int ks = 0; ks < NKS; ++ks) { const bf16x8 kf = *(const LAS bf16x8*)(kl + (16 * nf + fr) * KROW + (ks * 32 + fq * 8) * 2);
                    sacc[nf] = __builtin_amdgcn_mfma_f32_16x16x32_bf16(kf, qf[ks], sacc[nf], 0, 0, 0); } }
            float mx = -1.0e30f;
#pragma unroll
            for (int nf = 0; nf < 4; ++nf)
#pragma unroll
                for (int j = 0; j < 4; ++j) { float v = sacc[nf][j] * p.scale;
                    if (BAND) { const int sk = kt * 64 + 16 * nf + 4 * fq + j; const int dl = tq - sk; if (sk < p.Tlat && (dl > 128 || dl < -128)) v = -1.0e30f; }
                    sacc[nf][j] = v; mx = fmaxf(mx, v); }
            mx = fmaxf(mx, __shfl_xor(mx, 16)); mx = fmaxf(mx, __shfl_xor(mx, 32));
            const float mnew = fmaxf(mrow, mx), alpha = exp2f(mrow - mnew); mrow = mnew;
            float ps = 0.f;
#pragma unroll
            for (int nf = 0; nf < 4; ++nf)
#pragma unroll
                for (int j = 0; j < 4; ++j) { const float e = exp2f(sacc[nf][j] - mnew); sacc[nf][j] = e; ps += e; }
            lrow = lrow * alpha + ps;
#pragma unroll
            for (int d = 0; d < NDF; ++d) oacc[d] = oacc[d] * alpha;
#pragma unroll
            for (int ss = 0; ss < 2; ++ss) {
                const u32x4 pw = {pk2(sacc[2 * ss][0], sacc[2 * ss][1]), pk2(sacc[2 * ss][2], sacc[2 * ss][3]), pk2(sacc[2 * ss + 1][0], sacc[2 * ss + 1][1]), pk2(sacc[2 * ss + 1][2], sacc[2 * ss + 1][3])};
                const bf16x8 pf = __builtin_bit_cast(bf16x8, pw);
#pragma unroll
                for (int d = 0; d < NDF; ++d) { const LAS unsigned char* vp = vl + (16 * d + fr) * VROW + (32 * ss + 4 * fq) * 2;
                    const u32x2 v0 = *(const LAS u32x2*)vp, v1 = *(const LAS u32x2*)(vp + 32);
                    const u32x4 vw = {v0[0], v0[1], v1[0], v1[1]};
                    oacc[d] = __builtin_amdgcn_mfma_f32_16x16x32_bf16(__builtin_bit_cast(bf16x8, vw), pf, oacc[d], 0, 0, 0); } }
            if (more) lstore(cur ^ 1);
            __syncthreads();
        }
        float lt = lrow; lt += __shfl_xor(lt, 16); lt += __shfl_xor(lt, 32);
        if (SINK) lt += exp2f(p.sink[h] * 1.4426950408889634f - mrow);
        const float inv = 1.f / lt;
        bf16* op = p.O + ((long)b * p.T + tq) * 2048 + h * DV + 4 * fq;
#pragma unroll
        for (int d = 0; d < NDF; ++d) { const f32x4 o = oacc[d] * inv; *(u32x2*)(op + 16 * d) = (u32x2){pk2(o[0], o[1]), pk2(o[2], o[3])}; }
    }
}

struct EpiF32 { float* C; long ldc, s1, s2, s3; float scale;
    __device__ __forceinline__ void operator()(int b1, int b2, int b3, int m, int n, f32x4 v0, f32x4 v1) const {
        float* p = C + b1 * s1 + b2 * s2 + b3 * s3 + (long)m * ldc + n; *(f32x4*)p = v0 * scale; *(f32x4*)(p + 16) = v1 * scale; } };
struct EpiF32N { float* C; long ldc; int nvalid;
    __device__ __forceinline__ void operator()(int, int, int, int m, int n, f32x4 v0, f32x4 v1) const {
        if (n < nvalid) { float* p = C + (long)m * ldc + n; *(f32x4*)p = v0; *(f32x4*)(p + 16) = v1; } } };
struct EpiBf16 { bf16* C; long ldc, s1, s2, s3; float scale;
    __device__ __forceinline__ void operator()(int b1, int b2, int b3, int m, int n, f32x4 v0, f32x4 v1) const {
        bf16* p = C + b1 * s1 + b2 * s2 + b3 * s3 + (long)m * ldc + n; v0 = v0 * scale; v1 = v1 * scale;
        *(u32x2*)p = (u32x2){pk2(v0[0], v0[1]), pk2(v0[2], v0[3])}; *(u32x2*)(p + 16) = (u32x2){pk2(v1[0], v1[1]), pk2(v1[2], v1[3])}; } };
__device__ __forceinline__ void rope4(f32x4& v0, f32x4& v1, int pos, int j0, const float* tab) {
    const f32x4 cs = *(const f32x4*)(tab + pos * 16 + j0), sn = *(const f32x4*)(tab + 1024 + pos * 16 + j0);
    const f32x4 x1 = v0, x2 = v1; v0 = x1 * cs - x2 * sn; v1 = x1 * sn + x2 * cs;
}
struct EpiQMla { bf16* Q; const float* rtab;
    __device__ __forceinline__ void operator()(int, int, int, int m, int n, f32x4 v0, f32x4 v1) const {
        const int d = n % 192, d0 = d & ~31;
        if (m >= NPR && d0 >= 128) { const int t = (m - NPR) & 1023; const int pos = (d0 == 128) ? (t >> 6) : (t & 63); rope4(v0, v1, pos, d & 15, rtab); }
        bf16* p = Q + (long)m * 3072 + n;
        *(u32x2*)p = (u32x2){pk2(v0[0], v0[1]), pk2(v0[2], v0[3])}; *(u32x2*)(p + 16) = (u32x2){pk2(v1[0], v1[1]), pk2(v1[2], v1[3])}; } };
struct EpiKn { bf16* KC;
    __device__ __forceinline__ void operator()(int, int, int, int m, int n, f32x4 v0, f32x4 v1) const {
        bf16* p = KC + ((long)m * 16 + (n >> 7)) * 192 + (n & 127);
        *(u32x2*)p = (u32x2){pk2(v0[0], v0[1]), pk2(v0[2], v0[3])}; *(u32x2*)(p + 16) = (u32x2){pk2(v1[0], v1[1]), pk2(v1[2], v1[3])}; } };
struct EpiResid { float* Y; const float* X; const float* gate;
    __device__ __forceinline__ void operator()(int, int, int, int m, int n, f32x4 v0, f32x4 v1) const {
        const float* gp = gate + cond_of(m) * 12288 + n; const float* xp = X + (long)m * D + n; float* yp = Y + (long)m * D + n;
        const f32x4 g0 = *(const f32x4*)gp, g1 = *(const f32x4*)(gp + 16), x0 = *(const f32x4*)xp, x1 = *(const f32x4*)(xp + 16);
        *(f32x4*)yp = x0 * ALPHA + g0 * v0; *(f32x4*)(yp + 16) = x1 * ALPHA + g1 * v1; } };
struct EpiQkv1 { bf16* Q1; bf16* K1; bf16* VT1; float* outk; float* outv; const float* rtab;
    __device__ __forceinline__ void operator()(int, int, int, int m, int n, f32x4 v0, f32x4 v1) const {
        const int kvr = kvrow_of(m);
        if (n < 2560) {
            if (n >= 2048 && m < NPR) { float* p = outk + (long)m * 512 + (n - 2048); *(f32x4*)p = v0; *(f32x4*)(p + 16) = v1; }
            if (m >= NPR) { const int t = (m - NPR) & 1023; const int pos = ((n & 32) == 0) ? (t >> 6) : (t & 63); rope4(v0, v1, pos, n & 15, rtab); }
            bf16* p = (n < 2048) ? (Q1 + (long)m * 2048 + n) : (K1 + (long)kvr * 512 + (n - 2048));
            *(u32x2*)p = (u32x2){pk2(v0[0], v0[1]), pk2(v0[2], v0[3])}; *(u32x2*)(p + 16) = (u32x2){pk2(v1[0], v1[1]), pk2(v1[2], v1[3])};
        } else {
            const int c = n - 2560;
            if (m < NPR) { float* p = outv + (long)m * 512 + c; *(f32x4*)p = v0; *(f32x4*)(p + 16) = v1; }
#pragma unroll
            for (int i = 0; i < 4; ++i) { VT1[(long)(c + i) * KVR + kvr] = (bf16)f2bf(v0[i]); VT1[(long)(c + 16 + i) * KVR + kvr] = (bf16)f2bf(v1[i]); }
        } } };
struct EpiDft1 { bf16* YTp; bf16* YTs;
    __device__ __forceinline__ void operator()(int g, int, int, int j, int tok, f32x4 v0, f32x4 v1) const {
        const int h = j >> 9, c = j & 511;
#pragma unroll
        for (int q = 0; q < 2; ++q) { const int tk = tok + 16 * q; const f32x4 v = q ? v1 : v0; bf16* p;
            if (tk < NPR) { const int b = tk >> 8, t = tk & 255; p = YTp + ((long)(b * 2048 + g * 512 + c) * 512 + h * 256 + t); }
            else { const int s = tk - NPR, b = s >> 10, t = s & 1023; p = YTs + ((long)(b * 2048 + g * 512 + c) * 2048 + h * 1024 + t); }
            *(u32x2*)p = (u32x2){pk2(v[0], v[1]), pk2(v[2], v[3])}; } } };

__device__ __forceinline__ f32x4 ldg4(const float* base, unsigned boff) { return *(const GAS f32x4*)((const GAS char*)base + boff); }
__device__ __forceinline__ void stg4(float* base, unsigned boff, f32x4 v) { *(GAS f32x4*)((GAS char*)base + boff) = v; }
__device__ __forceinline__ u32x2 ldg2u(const void* base, unsigned boff) { return *(const GAS u32x2*)((const GAS char*)base + boff); }
__device__ __forceinline__ void stg2u(void* base, unsigned boff, u32x2 v) { *(GAS u32x2*)((GAS char*)base + boff) = v; }
template <class T> __device__ __forceinline__ T* opq(T* p) { asm volatile("" : "+s"(p)); return p; }
struct Frame {
    LAS unsigned char* lds;
    unsigned char* ws;
    int tid, lane, wave, bid, nblk, gw, ngw;
};

__device__ __forceinline__ void ln_row(const float* yrow, const float* g, const float* b, float* xrow, bf16* urow, const float* shift, const float* scale, float* orow, int lane) {
    f32x4 v[8]; float s = 0.f;
#pragma unroll
    for (int i = 0; i < 8; ++i) { v[i] = *(const f32x4*)(yrow + i * 256 + lane * 4); s += (v[i][0] + v[i][1]) + (v[i][2] + v[i][3]); }
    const float mean = wave_sum(s) * (1.f / D); float s2 = 0.f;
#pragma unroll
    for (int i = 0; i < 8; ++i) { v[i] = v[i] - mean; s2 += (v[i][0] * v[i][0] + v[i][1] * v[i][1]) + (v[i][2] * v[i][2] + v[i][3] * v[i][3]); }
    const float rstd = rsqrtf(wave_sum(s2) * (1.f / D) + LN_EPS);
#pragma unroll
    for (int i = 0; i < 8; ++i) { const int c = i * 256 + lane * 4;
        const f32x4 o = v[i] * rstd * *(const f32x4*)(g + c) + *(const f32x4*)(b + c);
        *(f32x4*)(xrow + c) = o;
        if (orow) *(f32x4*)(orow + c) = o;
        if (urow) { const f32x4 u = o * (*(const f32x4*)(scale + c) + 1.0f) + *(const f32x4*)(shift + c); *(u32x2*)(urow + c) = (u32x2){pk2(u[0], u[1]), pk2(u[2], u[3])}; } }
}

template <int NV, bool BAND>
__device__ __forceinline__ void softmax_row(float* row, int t, bool has_sink, float sink, int lane) {
    f32x4 v[NV]; float mx = -3.0e38f;
#pragma unroll
    for (int i = 0; i < NV; ++i) { v[i] = *(const f32x4*)(row + i * 256 + lane * 4);
#pragma unroll
        for (int e = 0; e < 4; ++e) { if (BAND) { const int s = i * 256 + lane * 4 + e; const int dlt = t - s; const bool ok = (s >= 1024) || (dlt <= 128 && dlt >= -128); if (!ok) v[i][e] = -3.0e38f; } mx = fmaxf(mx, v[i][e]); } }
    mx = wave_max(mx); if (has_sink) mx = fmaxf(mx, sink);
    float sum = 0.f;
#pragma unroll
    for (int i = 0; i < NV; ++i)
#pragma unroll
        for (int e = 0; e < 4; ++e) { const float p = (v[i][e] < -1.0e38f) ? 0.f : __expf(v[i][e] - mx); v[i][e] = p; sum += p; }
    sum = wave_sum(sum); if (has_sink) sum += __expf(sink - mx);
    const float inv = 1.f / sum;
    bf16* prow = (bf16*)row;
#pragma unroll
    for (int i = 0; i < NV; ++i) *(u32x2*)(prow + i * 256 + lane * 4) = (u32x2){pk2(v[i][0] * inv, v[i][1] * inv), pk2(v[i][2] * inv, v[i][3] * inv)};
}

__device__ __forceinline__ void transpose_item(const float* W, int K, int N, bf16* WT, int row_off, LAS float* scr, int item, int lane) {
    const int nblkn = N / 32, kb = item / nblkn, nb = item % nblkn, k0 = 64 * kb, n0 = 32 * nb;
#pragma unroll 8
    for (int i = 0; i < 32; ++i) { const int kk = 2 * i + (lane >> 5); scr[kk * 33 + (lane & 31)] = W[(size_t)(k0 + kk) * N + n0 + (lane & 31)]; }
    LDS_WAIT();
    const int c = lane & 7;
#pragma unroll
    for (int j = 0; j < 4; ++j) { const int n = (lane >> 3) + 8 * j; const LAS float* s = scr + (8 * c) * 33 + n;
        u32x4 o; o.x = pk2(s[0 * 33], s[1 * 33]); o.y = pk2(s[2 * 33], s[3 * 33]); o.z = pk2(s[4 * 33], s[5 * 33]); o.w = pk2(s[6 * 33], s[7 * 33]);
        *(u32x4*)(WT + (size_t)(row_off + n0 + n) * K + k0 + 8 * c) = o; }
    LDS_WAIT();
}

__device__ __forceinline__ int cflat(int l) {
    int a = 0, base = 0;
    if (l >= 16) { a = 1; base = 16; } if (l >= 24) { a = 2; base = 24; } if (l >= 29) { a = 3; base = 29; } if (l >= 33) { a = 4; base = 33; }
    if (l >= 36) { a = 5; base = 36; } if (l >= 38) { a = 6; base = 38; } if (l >= 40) { a = 7; base = 40; } if (l >= 42) { a = 8 + (l - 42); base = l; }
    return l < 50 ? a * 16 + (l - base) : 9999;
}
#if !MK_PER_PHASE
#define SYNC() xcd_barrier(bar)
#else
#define SYNC() do {} while (0)
#endif
#define PH_BEGIN unsigned char* ws = opq(ws_)
#define IP(i) opq(args.in[i])
#define MODS ((float*)(ws + WS_MODS))
#define ROPET ((float*)(ws + WS_MODS + 640 * 1024))
#define X ((float*)(ws + WS_X))
#define Y ((float*)(ws + WS_Y))
#define Ub ((bf16*)(ws + WS_U))
#define Ob ((bf16*)(ws + WS_O))
#define SCR (ws + WS_SCR)
#define IN(k) (lo <= (k) && (k) < hi)
#define ENDPH(k) do { if (hi > (k) + 1) SYNC(); } while (0)
template <int L>
__device__ __forceinline__ void layer_phases(const Args& args, const Frame& F, unsigned char* const ws_, const int lo, const int hi, const XcdBarrier& bar) {
    int ub;
        const int P = 2 + L * 16;
#define modL (MODS + L * 3 * 12288)
        if constexpr (L == 0) {
#define T0 ((float*)SCR)
#define QN ((bf16*)(ws + WS_QN))
#define CKV ((bf16*)(ws + WS_CKV))
#define Qb ((bf16*)(ws + WS_Q))
#define KC ((bf16*)(ws + WS_KC))
#define VT ((bf16*)(ws + WS_VT))
#define SCp ((float*)SCR)
#define SCs ((float*)(SCR + 64 * MiB))
            if (IN(P + 0)) { PH_BEGIN;
                ub = 0; GemmP g{Ub, (const bf16*)(ws + WS_W0T), D, D, 0, 0, 0, 0, 0, 0, MT, 1280, D, 1, 1, 1};
                pg8::gemm_phase(F.lds, g, EpiF32N{T0, 1088, 1088}, F.bid, F.nblk, ub);
                ENDPH(P + 0);
            }
            if (IN(P + 1)) { PH_BEGIN;
                const float* qg = IP(I_QNORM); const float* kg = IP(I_KVNORM);
                for (int m = F.gw; m < MT; m += F.ngw) {
                    const float* tr = T0 + (size_t)m * 1088; const int kvr = kvrow_of(m); const int c = F.lane * 8;
                    { f32x4 a = *(const f32x4*)(tr + c), b = *(const f32x4*)(tr + c + 4);
                      float ss = (a[0] * a[0] + a[1] * a[1]) + (a[2] * a[2] + a[3] * a[3]) + (b[0] * b[0] + b[1] * b[1]) + (b[2] * b[2] + b[3] * b[3]);
                      const float r = rsqrtf(wave_sum(ss) * (1.f / 512.f) + RMS_EPS);
                      a = a * r * *(const f32x4*)(qg + c); b = b * r * *(const f32x4*)(qg + c + 4);
                      *(u32x4*)(QN + (size_t)m * 512 + c) = (u32x4){pk2(a[0], a[1]), pk2(a[2], a[3]), pk2(b[0], b[1]), pk2(b[2], b[3])}; }
                    { f32x4 a = *(const f32x4*)(tr + 512 + c), b = *(const f32x4*)(tr + 512 + c + 4);
                      float ss = (a[0] * a[0] + a[1] * a[1]) + (a[2] * a[2] + a[3] * a[3]) + (b[0] * b[0] + b[1] * b[1]) + (b[2] * b[2] + b[3] * b[3]);
                      const float r = rsqrtf(wave_sum(ss) * (1.f / 512.f) + RMS_EPS);
                      a = a * r * *(const f32x4*)(kg + c); b = b * r * *(const f32x4*)(kg + c + 4);
                      *(u32x4*)(CKV + (size_t)kvr * 512 + c) = (u32x4){pk2(a[0], a[1]), pk2(a[2], a[3]), pk2(b[0], b[1]), pk2(b[2], b[3])};
                      if (m < NPR) { float* o = args.out + OUT_CKV + (size_t)m * 512 + c; *(f32x4*)o = a; *(f32x4*)(o + 4) = b; } }
                    { float x = tr[1024 + F.lane];
                      if (m < NPR) args.out[OUT_KR + (size_t)m * 64 + F.lane] = x;
                      else { const int t = (m - NPR) & 1023, e = F.lane, j = e & 15; const int pos = (e < 32) ? (t >> 6) : (t & 63);
                          const float cs = ROPET[pos * 16 + j], sn = ROPET[1024 + pos * 16 + j];
                          const float pr = __shfl_xor(x, 16); x = ((e & 16) == 0) ? (x * cs - pr * sn) : (pr * sn + x * cs); }
                      const bf16 xb = (bf16)f2bf(x);
#pragma unroll
                      for (int h = 0; h < 16; ++h) KC[((size_t)kvr * 16 + h) * 192 + 128 + F.lane] = xb; }
                }
                ENDPH(P + 1);
            }
            if (IN(P + 2)) { PH_BEGIN;
                ub = 0; GemmP g{QN, (const bf16*)(ws + WS_WUQT), 512, 512, 0, 0, 0, 0, 0, 0, MT, 3072, 512, 1, 1, 1};
                pg8::gemm_phase(F.lds, g, EpiQMla{Qb, ROPET}, F.bid, F.nblk, ub);
                GemmP g2{CKV, (const bf16*)(ws + WS_WUKT), 512, 512, 0, 0, 0, 0, 0, 0, KVR, 2048, 512, 1, 1, 1};
                pg8::gemm_phase(F.lds, g2, EpiKn{KC}, F.bid, F.nblk, ub);
                GemmP g3{(const bf16*)(ws + WS_WUVT), CKV, 512, 512, 0, 0, 0, 0, 0, 0, 2048, KVR, 512, 1, 1, 1};
                pg8::gemm_phase(F.lds, g3, EpiBf16{VT, KVR, 0, 0, 0, 1.f}, F.bid, F.nblk, ub);
                ENDPH(P + 2);
            }
            if (IN(P + 3)) { PH_BEGIN;
                ub = 0;
                AttnP as{Qb + (size_t)NPR * 3072, 3072, 1024L * 3072, KC + (size_t)NPR * 3072, 3072, 1280, 0, VT + NPR, KVR, Ob + (size_t)NPR * D, nullptr, MLA_SCALE * 1.4426950408889634f, 2, 16, 1024, 1280, 1280};
                flash_attn<192, 128, false, false>(F.lds, as, F.bid, F.nblk, ub);
                AttnP ap{Qb, 3072, 256L * 3072, KC, 3072, 256, 0, VT, KVR, Ob, nullptr, MLA_SCALE * 1.4426950408889634f, 16, 16, 256, 256, 256};
                flash_attn<192, 128, false, false>(F.lds, ap, F.bid, F.nblk, ub);
                ENDPH(P + 3);
            }
        } else if constexpr (L == 1) {
#undef SCs
#define SCs ((float*)(SCR + 128 * MiB))
#define Q1 ((bf16*)(ws + WS_Q))
#define K1 ((bf16*)(ws + WS_KC))
#define VT1 ((bf16*)(ws + WS_VT))
            if (IN(P + 0)) { PH_BEGIN;
                const int gt = F.bid * NTHR + F.tid, ngt = F.nblk * NTHR;
                { const float* c1 = IP(I_C1K);
                  for (int i = gt; i < 2 * 256 * 512; i += ngt) { const int b = i >> 17, r = i & 131071; K1[(size_t)(NPR + b * 1280 + 1024) * 512 + r] = (bf16)f2bf(c1[i]); } }
                { const float* c1 = IP(I_C1V);
                  for (int i = gt; i < 2 * 256 * 512; i += ngt) { const int b = i >> 17, s = (i >> 9) & 255, c = i & 511; VT1[(size_t)c * KVR + NPR + b * 1280 + 1024 + s] = (bf16)f2bf(c1[i]); } }
                ub = 0; GemmP g{Ub, (const bf16*)(ws + WS_WQKVT), D, D, 0, 0, 0, 0, 0, 0, MT, 3072, D, 1, 1, 1};
                pg8::gemm_phase(F.lds, g, EpiQkv1{Q1, K1, VT1, args.out + OUT_K1, args.out + OUT_V1, ROPET}, F.bid, F.nblk, ub);
                ENDPH(P + 0);
            }
            if (IN(P + 3)) { PH_BEGIN;
                ub = 0; const float* sink = IP(I_SINK);
                AttnP as{Q1 + (size_t)NPR * D, D, 1024L * D, K1 + (size_t)NPR * 512, 512, 1280, 2, VT1 + NPR, KVR, Ob + (size_t)NPR * D, sink, GQA_SCALE * 1.4426950408889634f, 2, 32, 1024, 1280, 1024};
                flash_attn<64, 64, true, true>(F.lds, as, F.bid, F.nblk, ub);
                AttnP ap{Q1, D, 256L * D, K1, 512, 256, 2, VT1, KVR, Ob, sink, GQA_SCALE * 1.4426950408889634f, 16, 32, 256, 256, 256};
                flash_attn<64, 64, false, true>(F.lds, ap, F.bid, F.nblk, ub);
                ENDPH(P + 3);
            }
        } else if constexpr (L == 2) {
#define YTp ((bf16*)SCR)
#define YTs ((bf16*)(SCR + 32 * MiB))
            if (IN(P + 0)) { PH_BEGIN;
                ub = 0; GemmP g{(const bf16*)(ws + WS_CS512), Ub, 512, D, 0, 0, 0, 512, 0, 0, 1024, MT, 512, 4, 1, 1};
                pg8::gemm_phase(F.lds, g, EpiDft1{YTp, YTs}, F.bid, F.nblk, ub);
                ENDPH(P + 0);
            }
            if (IN(P + 5)) { PH_BEGIN;
                ub = 0;
                GemmP gp{(const bf16*)(ws + WS_CT256), YTp, 512, 512, 0, 0, 0, 2048L * 512, 0, 0, 256, 2048, 512, 16, 1, 1};
                pg8::gemm_phase(F.lds, gp, EpiBf16{Ob, D, 256L * D, 0, 0, 0.0027621358640099515f}, F.bid, F.nblk, ub);
                GemmP gs{(const bf16*)(ws + WS_CT1024), YTs, 2048, 2048, 0, 0, 0, 2048L * 2048, 0, 0, 1024, 2048, 2048, 2, 1, 1};
                pg8::gemm_phase(F.lds, gs, EpiBf16{Ob + (size_t)NPR * D, D, 1024L * D, 0, 0, 0.0013810679320049757f}, F.bid, F.nblk, ub);
                ENDPH(P + 5);
            }
        } else {
#define BCH ((bf16*)SCR)
            if (IN(P + 0)) { PH_BEGIN;
                ub = 0; GemmP g{Ub, (const bf16*)(ws + WS_WINT), D, D, 0, 0, 0, 0, 0, 0, MT, 6144, D, 1, 1, 1};
                pg8::gemm_phase(F.lds, g, EpiBf16{BCH, 6144, 0, 0, 0, 1.f}, F.bid, F.nblk, ub);
                ENDPH(P + 0);
            }
            if (IN(P + 5)) { PH_BEGIN;
                const float* cw = IP(I_CONVW); const float* cb = IP(I_CONVB);
                for (int m = F.gw; m < MT; m += F.ngw) {
                    const int t = (m < NPR) ? (m & 255) : ((m - NPR) & 1023); const int T = (m < NPR) ? 256 : 1024;
                    const bool hasp = t > 0, hasn = t < T - 1;
#pragma unroll
                    for (int i = 0; i < 4; ++i) { const int c = i * 512 + F.lane * 8; const bf16* r0 = BCH + (size_t)m * 6144 + c;
                        const u32x4 bb = *(const u32x4*)r0, cc = *(const u32x4*)(r0 + 2048), hh = *(const u32x4*)(r0 + 4096);
                        u32x4 cp = {0u, 0u, 0u, 0u}, hp = cp, cn = cp, hn = cp;
                        if (hasp) { cp = *(const u32x4*)(r0 - 6144 + 2048); hp = *(const u32x4*)(r0 - 6144 + 4096); }
                        if (hasn) { cn = *(const u32x4*)(r0 + 6144 + 2048); hn = *(const u32x4*)(r0 + 6144 + 4096); }
                        unsigned o[4];
#pragma unroll
                        for (int q = 0; q < 4; ++q) { const int d = c + 2 * q;
                            const float z0l = bflo(cp[q]) * bflo(hp[q]), z0h = bfhi(cp[q]) * bfhi(hp[q]);
                            const float z1l = bflo(cc[q]) * bflo(hh[q]), z1h = bfhi(cc[q]) * bfhi(hh[q]);
                            const float z2l = bflo(cn[q]) * bflo(hn[q]), z2h = bfhi(cn[q]) * bfhi(hn[q]);
                            const float yl = bflo(bb[q]) * (cw[d] * z0l + cw[D + d] * z1l + cw[2 * D + d] * z2l + cb[d]);
                            const float yh = bfhi(bb[q]) * (cw[d + 1] * z0h + cw[D + d + 1] * z1h + cw[2 * D + d + 1] * z2h + cb[d + 1]);
                            o[q] = pk2(yl, yh); }
                        *(u32x4*)(Ob + (size_t)m * D + c) = (u32x4){o[0], o[1], o[2], o[3]}; }
                }
                ENDPH(P + 5);
            }
        }
        if (IN(P + 6)) { PH_BEGIN;
            const size_t wofs = (L == 0) ? WS_WOT0 : (L == 1) ? WS_WOT1 : (L == 2) ? WS_WFT : WS_WCOT;
            ub = 0; GemmP g{Ob, (const bf16*)(ws + wofs), D, D, 0, 0, 0, 0, 0, 0, MT, D, D, 1, 1, 1};
            pg8::gemm_phase(F.lds, g, EpiResid{Y, X, modL + 2 * D}, F.bid, F.nblk, ub);
            ENDPH(P + 6);
        }
        if (IN(P + 7)) { PH_BEGIN;
            const float* g1 = IP(I_LN1G) + L * D; const float* b1 = IP(I_LN1B) + L * D;
            for (int m = F.gw; m < MT; m += F.ngw) { const float* md = modL + cond_of(m) * 12288;
                ln_row(Y + (size_t)m * D, g1, b1, X + (size_t)m * D, Ub + (size_t)m * D, md + 3 * D, md + 4 * D, nullptr, F.lane); }
            ENDPH(P + 7);
        }
#define PS ((float*)(SCR + 24 * MiB))
#define PU4 ((unsigned char*)(ws + WS_PU))
#define PV4 ((unsigned char*)(ws + WS_PV))
#define SU4 ((bf16*)(ws + WS_PU + 16 * MiB))
#define SV4 ((bf16*)(ws + WS_PV + 16 * MiB))
#define TKI ((int*)(SCR + 80 * MiB))
#define TKG ((float*)(SCR + 84 * MiB))
        if (IN(P + 8)) { PH_BEGIN;
            ub = 0; GemmP g{Ub, (const bf16*)(ws + WS_WPQT) + (size_t)L * D * D, D, D, 0, 0, 0, 0, 0, 0, MT, D, D, 1, 1, 1};
            pg8::gemm_phase(F.lds, g, EpiF32{PS, D, 0, 0, 0, 1.f}, F.bid, F.nblk, ub);
            ENDPH(P + 8);
        }
        if (IN(P + 9)) { PH_BEGIN;
            LAS float* sv = (LAS float*)(F.lds + F.wave * 12288); LAS int* si = (LAS int*)(sv + 1024);
            const float* pu = IP(I_PEERU) + (size_t)L * 16384 * D; const float* pv = IP(I_PEERV) + (size_t)L * 16384 * D;
            int crow = F.gw;
            auto convert_rows = [&](int nrows) {
                for (int it = 0; it < nrows && crow < 32768; ++it, crow += F.ngw) {
                    const bool isv = crow >= 16384; const int e = crow & 16383;
                    const GAS float* src = (const GAS float*)((isv ? pv : pu) + (size_t)e * D) + F.lane * 4;
                    f32x4 v[8]; float mx = 0.f;
#pragma unroll
                    for (int j = 0; j < 8; ++j) { v[j] = *(const GAS f32x4*)(src + j * 256);
                        mx = fmaxf(mx, fmaxf(fmaxf(fabsf(v[j][0]), fabsf(v[j][1])), fmaxf(fabsf(v[j][2]), fabsf(v[j][3])))); }
                    const unsigned sb = f2bf(mx * (1.00390625f / 6.0f)); const float sq = __uint_as_float(sb << 16);
                    const float inv = sq > 0.f ? 1.0f / sq : 0.f;
                    u32x4 o;
#pragma unroll
                    for (int d = 0; d < 4; ++d) { unsigned w = 0u;
                        w = __builtin_amdgcn_cvt_scalef32_pk_fp4_f32(w, v[2 * d][0] * inv, v[2 * d][1] * inv, 1.0f, 0);
                        w = __builtin_amdgcn_cvt_scalef32_pk_fp4_f32(w, v[2 * d][2] * inv, v[2 * d][3] * inv, 1.0f, 1);
                        w = __builtin_amdgcn_cvt_scalef32_pk_fp4_f32(w, v[2 * d + 1][0] * inv, v[2 * d + 1][1] * inv, 1.0f, 2);
                        w = __builtin_amdgcn_cvt_scalef32_pk_fp4_f32(w, v[2 * d + 1][2] * inv, v[2 * d + 1][3] * inv, 1.0f, 3);
                        o[d] = w; }
                    *(GAS u32x4*)((GAS unsigned char*)((isv ? PV4 : PU4) + (size_t)e * 1024) + F.lane * 16) = o;
                    ((GAS bf16*)((isv ? SV4 : SU4) + (size_t)e * 64))[F.lane] = (bf16)sb;
                } };
            if (F.gw < MT / 4) {
                const int m0 = F.gw * 4;
                const float* psb = PS + (size_t)m0 * D;
                const unsigned lofs = (unsigned)F.lane * 512u;
                unsigned top[16];
#pragma unroll
                for (int k = 0; k < 16; ++k) top[k] = 0u;
                f32x4 cur[4], nxt[4];
#pragma unroll
                for (int i = 0; i < 4; ++i) cur[i] = ldg4(psb, lofs + 16u * i);
                for (int ch = 0; ch < 8; ++ch) {
                    if (ch < 7) {
#pragma unroll
                        for (int i = 0; i < 4; ++i) nxt[i] = ldg4(psb, lofs + (unsigned)((ch + 1) * 64 + 16 * i)); }
#pragma unroll
                    for (int i = 0; i < 4; ++i)
#pragma unroll
                        for (int e = 0; e < 4; ++e) { const unsigned u = __float_as_uint(cur[i][e]); const unsigned key = u ^ ((unsigned)((int)u >> 31) | 0x80000000u);
                            unsigned x = (key & ~127u) | (unsigned)(127 - (ch * 16 + i * 4 + e));
#pragma unroll
                            for (int k = 0; k < 16; ++k) { const unsigned hi = top[k] > x ? top[k] : x; x = top[k] > x ? x : top[k]; top[k] = hi; } }
#pragma unroll
                    for (int i = 0; i < 4; ++i) cur[i] = nxt[i];
                }
#pragma unroll
                for (int k = 0; k < 16; ++k) { const int idx = 127 - (int)(top[k] & 127u);
                    sv[F.lane * 16 + k] = *(const GAS float*)((const GAS char*)psb + (lofs + (unsigned)idx * 4u)); si[F.lane * 16 + k] = idx; }
                LDS_WAIT();
                if (F.lane < 32) {
                    const int tl = F.lane >> 3, h = F.lane & 7, la = (tl * 16 + 2 * h) * 16, lb = la + 16;
                    float va[16], vb[16];
#pragma unroll
                    for (int k = 0; k < 16; ++k) { va[k] = sv[la + k]; vb[k] = sv[lb + k]; }
                    unsigned tp[16];
#pragma unroll
                    for (int k = 0; k < 16; ++k) tp[k] = 0u;
#pragma unroll
                    for (int c = 0; c < 50; ++c) { const int fl = cflat(c); const float sum = va[fl >> 4] + vb[fl & 15];
                        const unsigned u = __float_as_uint(sum); const unsigned key = u ^ ((unsigned)((int)u >> 31) | 0x80000000u);
                        unsigned x = (key & ~63u) | (unsigned)(63 - c);
#pragma unroll
                        for (int k = 0; k < 16; ++k) { const unsigned hi = tp[k] > x ? tp[k] : x; x = tp[k] > x ? x : tp[k]; tp[k] = hi; } }
                    float sc[16]; int id[16]; float mx = -3.0e38f;
#pragma unroll
                    for (int k = 0; k < 16; ++k) { const int c = 63 - (int)(tp[k] & 63u); const int fl = cflat(c), a = fl >> 4, b = fl & 15;
                        sc[k] = sv[la + a] + sv[lb + b]; id[k] = si[la + a] * 128 + si[lb + b]; mx = fmaxf(mx, sc[k]); }
                    float sm = 0.f;
#pragma unroll
                    for (int k = 0; k < 16; ++k) { sc[k] = __expf(sc[k] - mx); sm += sc[k]; }
                    const float inv = 1.f / sm;
                    const unsigned ob = (unsigned)((m0 + tl) * 128 + h * 16) * 4u;
#pragma unroll
                    for (int k4 = 0; k4 < 4; ++k4) {
                        *(GAS f32x4*)((GAS char*)TKG + ob + 16u * k4) = (f32x4){sc[4 * k4] * inv, sc[4 * k4 + 1] * inv, sc[4 * k4 + 2] * inv, sc[4 * k4 + 3] * inv};
                        *(GAS u32x4*)((GAS char*)TKI + ob + 16u * k4) = (u32x4){(unsigned)id[4 * k4], (unsigned)id[4 * k4 + 1], (unsigned)id[4 * k4 + 2], (unsigned)id[4 * k4 + 3]}; }
                }
            }
            convert_rows(1 << 20);
            ENDPH(P + 9);
        }
        if (IN(P + 10)) { PH_BEGIN;
            const float* g2 = IP(I_LN2G) + L * D; const float* b2 = IP(I_LN2B) + L * D;
            const unsigned char* pu4 = PU4; const unsigned char* pv4 = PV4; const bf16* su4 = SU4; const bf16* sv4 = SV4;
            for (int m = F.gw; m < MT; m += F.ngw) {
                const int idA = ((const GAS int*)TKI)[(unsigned)(m * 128 + F.lane)], idB = ((const GAS int*)TKI)[(unsigned)(m * 128 + 64 + F.lane)];
                const float gtA = ((const GAS float*)TKG)[(unsigned)(m * 128 + F.lane)], gtB = ((const GAS float*)TKG)[(unsigned)(m * 128 + 64 + F.lane)];
                u32x2 xp[8];
#pragma unroll
                for (int j = 0; j < 8; ++j) xp[j] = ldg2u(Ub + (size_t)m * D, (unsigned)F.lane * 8u + (unsigned)(j * 512));
                struct RL { u32x4 w; unsigned short s; };
                auto ldrow = [&](RL& r, const unsigned char* tb, const bf16* sb, int e) {
                    const int ex = (e < 64) ? __builtin_amdgcn_readlane(idA, e & 63) : __builtin_amdgcn_readlane(idB, e & 63);
                    r.w = *(const GAS u32x4*)((const GAS char*)(tb + (size_t)ex * 1024) + (unsigned)F.lane * 16u); r.s = *(const GAS unsigned short*)((const GAS char*)(sb + (size_t)ex * 64) + (unsigned)F.lane * 2u); };
                float a0 = 0.f, a1 = 0.f, a2 = 0.f, a3 = 0.f;
                {
                    RL ring[16];
#pragma unroll
                    for (int r = 0; r < 16; ++r) ldrow(ring[r], pu4, su4, r);
                    __builtin_amdgcn_sched_barrier(0);
#pragma unroll
                    for (int c = 0; c < 4; ++c) {
                        float hp[32];
#pragma unroll
                        for (int i = 0; i < 32; ++i) {
                            const RL cur = ring[i & 15];
                            const int en = c * 32 + i + 16;
                            if (en < 128) ldrow(ring[i & 15], pu4, su4, en);
                            __builtin_amdgcn_sched_barrier(0);
                            float acc = 0.f;
#pragma unroll
                            for (int d = 0; d < 4; ++d) { const unsigned w = cur.w[d];
                                const f32x2 r0 = __builtin_amdgcn_cvt_scalef32_pk_f32_fp4(w, 1.0f, 0), r1 = __builtin_amdgcn_cvt_scalef32_pk_f32_fp4(w, 1.0f, 1), r2 = __builtin_amdgcn_cvt_scalef32_pk_f32_fp4(w, 1.0f, 2), r3 = __builtin_amdgcn_cvt_scalef32_pk_f32_fp4(w, 1.0f, 3);
                                acc += r0[0] * bflo(xp[2 * d][0]) + r0[1] * bfhi(xp[2 * d][0]) + r1[0] * bflo(xp[2 * d][1]) + r1[1] * bfhi(xp[2 * d][1]);
                                acc += r2[0] * bflo(xp[2 * d + 1][0]) + r2[1] * bfhi(xp[2 * d + 1][0]) + r3[0] * bflo(xp[2 * d + 1][1]) + r3[1] * bfhi(xp[2 * d + 1][1]); }
                            hp[i] = acc * __uint_as_float((unsigned)cur.s << 16);
                        }
#pragma unroll
                        for (int st = 0; st < 5; ++st) { const int o = 32 >> st, n = 16 >> st; const bool up = (F.lane & o) != 0;
#pragma unroll
                            for (int i = 0; i < n; ++i) { const float keep = up ? hp[i + n] : hp[i], send = up ? hp[i] : hp[i + n]; hp[i] = keep + __shfl_xor(send, o); } }
                        const float hh = hp[0] + __shfl_xor(hp[0], 1);
                        const float gsel = (c < 2) ? gtA : gtB;
                        const float gte = __shfl(gsel, (c * 32 + (F.lane >> 1)) & 63);
                        const float av = 0.5f * hh * (1.0f + erff(hh * 0.70710678118654752f)) * gte;
                        a0 = (c == 0) ? av : a0; a1 = (c == 1) ? av : a1; a2 = (c == 2) ? av : a2; a3 = (c == 3) ? av : a3;
                    }
                }
                f32x2 fb[8][2];
#pragma unroll
                for (int j = 0; j < 8; ++j) { fb[j][0] = (f32x2){0.f, 0.f}; fb[j][1] = (f32x2){0.f, 0.f}; }
                {
                    RL ring[16];
#pragma unroll
                    for (int r = 0; r < 16; ++r) ldrow(ring[r], pv4, sv4, r);
                    __builtin_amdgcn_sched_barrier(0);
#pragma unroll
                    for (int c = 0; c < 4; ++c) {
                        const float asel = (c == 0) ? a0 : (c == 1) ? a1 : (c == 2) ? a2 : a3;
#pragma unroll
                        for (int i = 0; i < 32; ++i) {
                            const RL cur = ring[i & 15];
                            const int en = c * 32 + i + 16;
                            if (en < 128) ldrow(ring[i & 15], pv4, sv4, en);
                            __builtin_amdgcn_sched_barrier(0);
                            const float ae = __builtin_bit_cast(float, __builtin_amdgcn_readlane(__builtin_bit_cast(int, asel), 2 * i));
                            const float as = ae * __uint_as_float((unsigned)cur.s << 16); const f32x2 as2 = {as, as};
#pragma unroll
                            for (int d = 0; d < 4; ++d) { const unsigned w = cur.w[d];
                                fb[2 * d][0] += as2 * __builtin_amdgcn_cvt_scalef32_pk_f32_fp4(w, 1.0f, 0); fb[2 * d][1] += as2 * __builtin_amdgcn_cvt_scalef32_pk_f32_fp4(w, 1.0f, 1);
                                fb[2 * d + 1][0] += as2 * __builtin_amdgcn_cvt_scalef32_pk_f32_fp4(w, 1.0f, 2); fb[2 * d + 1][1] += as2 * __builtin_amdgcn_cvt_scalef32_pk_f32_fp4(w, 1.0f, 3); }
                        }
                    }
                }
                float fa[8][4];
#pragma unroll
                for (int j = 0; j < 8; ++j) { fa[j][0] = fb[j][0][0]; fa[j][1] = fb[j][0][1]; fa[j][2] = fb[j][1][0]; fa[j][3] = fb[j][1][1]; }
                const int cnd = cond_of(m);
                const float* gt2 = modL + cnd * 12288 + 5 * D; float* xrow = X + (size_t)m * D;
                const unsigned lb = (unsigned)F.lane * 16u;
                float s = 0.f;
#pragma unroll
                for (int j = 0; j < 8; ++j) { const unsigned c = lb + (unsigned)(j * 1024);
                    const f32x4 x0 = ldg4(xrow, c), g0 = ldg4(gt2, c);
#pragma unroll
                    for (int e = 0; e < 4; ++e) { fa[j][e] = ALPHA * x0[e] + g0[e] * fa[j][e]; s += fa[j][e]; } }
                const float mean = wave_sum(s) * (1.f / D); float s2 = 0.f;
#pragma unroll
                for (int j = 0; j < 8; ++j)
#pragma unroll
                    for (int e = 0; e < 4; ++e) { fa[j][e] -= mean; s2 += fa[j][e] * fa[j][e]; }
                const float rstd = rsqrtf(wave_sum(s2) * (1.f / D) + LN_EPS);
                const float* mdn = MODS + ((L < 3 ? L + 1 : L) * 3 + cnd) * 12288;
                float* orow = args.out + OUT_Y + (size_t)m * D; bf16* urow = Ub + (size_t)m * D;
#pragma unroll
                for (int j = 0; j < 8; ++j) { const unsigned c = lb + (unsigned)(j * 1024);
                    const f32x4 f = {fa[j][0], fa[j][1], fa[j][2], fa[j][3]};
                    const f32x4 o = f * rstd * ldg4(g2, c) + ldg4(b2, c);
                    stg4(xrow, c, o);
                    if (L == 3) stg4(orow, c, o);
                    else { const f32x4 u = o * (ldg4(mdn + D, c) + 1.0f) + ldg4(mdn, c); stg2u(urow, (unsigned)F.lane * 8u + (unsigned)(j * 512), (u32x2){pk2(u[0], u[1]), pk2(u[2], u[3])}); } }
            }
            ENDPH(P + 10);
        }
}

__global__ void __launch_bounds__(NTHR, 2) fwd(Args args) {
    extern __shared__ __attribute__((aligned(16))) unsigned char lds_raw[];
    Frame F;
    F.lds = (LAS unsigned char*)lds_raw; F.ws = args.ws;
    F.tid = threadIdx.x; F.lane = F.tid & 63; F.wave = __builtin_amdgcn_readfirstlane(F.tid >> 6);
    F.bid = blockIdx.x; F.nblk = gridDim.x; F.gw = F.bid * NWAVE + F.wave; F.ngw = F.nblk * NWAVE;
    unsigned char* const ws_ = args.ws;
    const int lo = args.ph_lo, hi = args.ph_hi;
    volatile LAS unsigned* MISC = (volatile LAS unsigned*)(F.lds + LDS_MISC);
    if (F.tid < 16) MISC[F.tid] = 0u;
    __syncthreads();
    XcdBarrier bar; bar.bar = (unsigned*)(ws_ + WS_CTL) + 4096; bar.x = 0; bar.st = MISC + 8;
#if !MK_PER_PHASE
    bar = xcd_barrier_post((unsigned*)(ws_ + WS_CTL) + 4096, MISC + 8);
#endif
    int ub;

    if (IN(0)) { PH_BEGIN;
        LAS float* sc = (LAS float*)F.lds;
        LAS float* part = (LAS float*)(F.lds + 24576);
        for (int i = F.tid; i < 3 * D; i += NTHR) { const int j = i >> 11, k = i & 2047; const float c = (j == 0) ? IP(I_CCTX)[k] : IP(I_C)[(j - 1) * D + k]; sc[i] = c / (1.f + __expf(-c)); }
        __syncthreads();
        const float* adaw = IP(I_ADAW); const float* adab = IP(I_ADAB);
        for (int u = F.bid; u < 768; u += F.nblk) {
            const int layer = u / 192, n0 = (u % 192) * 64, kr = F.lane >> 4, cq = F.lane & 15;
            f32x4 a0 = {0.f, 0.f, 0.f, 0.f}, a1 = a0, a2 = a0;
            const float* wp = adaw + ((size_t)layer * D + F.wave * 256 + kr) * 12288 + n0 + cq * 4;
#pragma unroll 8
            for (int it = 0; it < 64; ++it) { const f32x4 w = *(const f32x4*)(wp + (size_t)it * 4 * 12288); const int k = F.wave * 256 + it * 4 + kr;
                a0 += w * sc[k]; a1 += w * sc[D + k]; a2 += w * sc[2 * D + k]; }
#pragma unroll
            for (int e = 0; e < 4; ++e) { a0[e] += __shfl_xor(a0[e], 16); a0[e] += __shfl_xor(a0[e], 32); a1[e] += __shfl_xor(a1[e], 16); a1[e] += __shfl_xor(a1[e], 32); a2[e] += __shfl_xor(a2[e], 16); a2[e] += __shfl_xor(a2[e], 32); }
            if (F.lane < 16) {
#pragma unroll
                for (int e = 0; e < 4; ++e) { part[(F.wave * 3 + 0) * 64 + cq * 4 + e] = a0[e]; part[(F.wave * 3 + 1) * 64 + cq * 4 + e] = a1[e]; part[(F.wave * 3 + 2) * 64 + cq * 4 + e] = a2[e]; } }
            __syncthreads();
            if (F.tid < 192) { const int j = F.tid >> 6, c = F.tid & 63; float s = adab[layer * 12288 + n0 + c];
#pragma unroll
                for (int w = 0; w < 8; ++w) s += part[(w * 3 + j) * 64 + c];
                MODS[(layer * 3 + j) * 12288 + n0 + c] = s; }
            __syncthreads();
        }
        {
            LAS float* scr = (LAS float*)(F.lds + F.wave * 8448);
            for (int it = F.gw; it < args.tj_total; it += F.ngw) {
                int j = 0;
#pragma unroll
                for (int q = 1; q < NTJOB; ++q) j = (it >= args.tj[q].first) ? q : j;
                const TJob& J = args.tj[j];
                transpose_item(J.W, J.K, J.N, (bf16*)(ws + J.dst), J.row_off, scr, it - J.first, F.lane);
            }
        }
        const int gt = F.bid * NTHR + F.tid, ngt = F.nblk * NTHR;
        { const float* wq = IP(I_WPQ); bf16* WQb = (bf16*)SCR;
          for (int i = gt; i < 4 * 2048 * 2048 / 8; i += ngt) { const f32x4 a = *(const GAS f32x4*)((const GAS float*)wq + (size_t)i * 8), b = *(const GAS f32x4*)((const GAS float*)wq + (size_t)i * 8 + 4);
              *(GAS u32x4*)((GAS bf16*)WQb + (size_t)i * 8) = (u32x4){pk2(a[0], a[1]), pk2(a[2], a[3]), pk2(b[0], b[1]), pk2(b[2], b[3])}; } }
        if (gt < 1024) { const int pos = gt >> 4, j = gt & 15; const float inv = exp2f(-(float)j * (13.287712379549449f / 16.0f)); float sn, cs; sincosf((float)pos * inv, &sn, &cs);
            ROPET[gt] = cs; ROPET[1024 + gt] = sn; }
        { const float* sk = IP(I_SUBK); bf16* SK = (bf16*)(ws + WS_SK);
          for (int i = gt; i < 4 * 16 * 128 * 128 / 4; i += ngt) { const f32x4 v = *(const f32x4*)(sk + (size_t)i * 4); *(u32x2*)(SK + (size_t)i * 4) = (u32x2){pk2(v[0], v[1]), pk2(v[2], v[3])}; } }
        { bf16* CS = (bf16*)(ws + WS_CS512);
          for (int i = gt; i < 1024 * 512; i += ngt) { const int j = i >> 9, c = i & 511, r = ((j & 511) * c) & 511; const float x = (float)r * (1.f / 256.f); CS[i] = (bf16)f2bf(j < 512 ? cospif(x) : sinpif(x)); } }
        { bf16* CT = (bf16*)(ws + WS_CT256);
          for (int i = gt; i < 256 * 512; i += ngt) { const int t = i >> 9, k = i & 511, r = (t * (k & 255)) & 255; const float x = (float)r * (1.f / 128.f); CT[i] = (bf16)f2bf(k < 256 ? cospif(x) : -sinpif(x)); } }
        { bf16* CT = (bf16*)(ws + WS_CT1024);
          for (int i = gt; i < 1024 * 2048; i += ngt) { const int t = i >> 11, k = i & 2047, r = (t * (k & 1023)) & 1023; const float x = (float)r * (1.f / 512.f); CT[i] = (bf16)f2bf(k < 1024 ? cospif(x) : -sinpif(x)); } }
        { const float* c0 = IP(I_C0CKV); bf16* ckvp = (bf16*)(ws + WS_CKV);
          for (int i = gt; i < 2 * 256 * 512; i += ngt) { const int b = i >> 17, r = i & 131071; ckvp[(size_t)(NPR + b * 1280 + 1024) * 512 + r] = (bf16)f2bf(c0[i]); } }
        { const float* c0 = IP(I_C0KR); bf16* kcp = (bf16*)(ws + WS_KC);
          for (int i = gt; i < 2 * 256 * 64 * 16; i += ngt) { const int h = i & 15, e = i >> 4, j = e & 63, s = (e >> 6) & 255, b = e >> 14;
              kcp[((size_t)(NPR + b * 1280 + 1024 + s) * 16 + h) * 192 + 128 + j] = (bf16)f2bf(c0[e]); } }
        ENDPH(0);
    }
    if (IN(1)) { PH_BEGIN;
        for (int m = F.gw; m < MT; m += F.ngw) {
            const float* xr = (m < NPR) ? IP(I_XP) + (size_t)m * D : IP(I_XS) + (size_t)(m - NPR) * D;
            const float* md = MODS + cond_of(m) * 12288;
#pragma unroll
            for (int i = 0; i < 8; ++i) { const int c = i * 256 + F.lane * 4; const f32x4 v = *(const f32x4*)(xr + c);
                *(f32x4*)(X + (size_t)m * D + c) = v;
                const f32x4 u = v * (*(const f32x4*)(md + D + c) + 1.0f) + *(const f32x4*)(md + c);
                *(u32x2*)(Ub + (size_t)m * D + c) = (u32x2){pk2(u[0], u[1]), pk2(u[2], u[3])}; }
        }
        {
            int ub = 0; GemmP g{(const bf16*)(ws + WS_SK), (const bf16*)SCR, 128, D, 16L * 16384, 16384, 0, (long)D * D, 128, 0, 128, D, 128, 4, 16, 1};
            sg_gemm(F.lds, g, EpiBf16{(bf16*)(ws + WS_WPQT), D, (long)D * D, 128L * D, 0, 1.f}, F.bid, F.nblk, ub);
        }
        ENDPH(1);
    }

    layer_phases<0>(args, F, ws_, lo, hi, bar);
    layer_phases<1>(args, F, ws_, lo, hi, bar);
    layer_phases<2>(args, F, ws_, lo, hi, bar);
    layer_phases<3>(args, F, ws_, lo, hi, bar);
}

static const int kPhases[] = {0, 1,
    2, 3, 4, 5, 8, 9, 10, 11, 12,
    18, 21, 24, 25, 26, 27, 28,
    34, 39, 40, 41, 42, 43, 44,
    50, 55, 56, 57, 58, 59, 60};

extern "C" void kernel_launch(void* const* d_in, const int* in_sizes, int n_in, void* d_out, int out_size, void* d_ws, size_t ws_size, hipStream_t stream) {
    static int grid = 0;
    if (grid == 0) {
        if (n_in != 34 || ws_size < WS_END) { fprintf(stderr, "kernel_launch: unexpected n_in %d / ws_size %zu\n", n_in, ws_size); grid = -1; return; }
        int dev = 0, cus = 0;
        if (hipGetDevice(&dev) != hipSuccess || hipDeviceGetAttribute(&cus, hipDeviceAttributeMultiprocessorCount, dev) != hipSuccess) { grid = -1; return; }
        if (hipFuncSetAttribute((const void*)fwd, hipFuncAttributeMaxDynamicSharedMemorySize, LDS_BYTES) != hipSuccess) { fprintf(stderr, "kernel_launch: hipFuncSetAttribute failed\n"); grid = -1; return; }
        int per_cu = 0;
        if (hipOccupancyMaxActiveBlocksPerMultiprocessor(&per_cu, (const void*)fwd, NTHR, LDS_BYTES) != hipSuccess || per_cu < 1) fprintf(stderr, "kernel_launch: occupancy query says %d\n", per_cu);
        (void)hipGetLastError();
        grid = cus;
    }
    if (grid < 0) return;
    (void)hipMemsetAsync((char*)d_ws + WS_CTL, 0, CTL_BYTES, stream);
    Args a{};
    for (int i = 0; i < 34; ++i) a.in[i] = (const float*)d_in[i];
    a.out = (float*)d_out; a.ws = (unsigned char*)d_ws;
    {
        struct J { int idx; size_t sub; size_t dst; int K, N, row_off; };
        const J js[NTJOB] = {
            {I_WDQ, 0, WS_W0T, 2048, 512, 0}, {I_WDKV, 0, WS_W0T, 2048, 576, 512}, {I_WUQ, 0, WS_WUQT, 512, 3072, 0}, {I_WUK, 0, WS_WUKT, 512, 2048, 0},
            {I_WUV, 0, WS_WUVT, 512, 2048, 0}, {I_WO0, 0, WS_WOT0, 2048, 2048, 0}, {I_WQKV, 0, WS_WQKVT, 2048, 3072, 0}, {I_WO1, 0, WS_WOT1, 2048, 2048, 0},
            {I_WF, 0, WS_WFT, 2048, 2048, 0}, {I_WIN, 0, WS_WINT, 2048, 6144, 0}, {I_WCO, 0, WS_WCOT, 2048, 2048, 0}};
        int first = 0;
        for (int j = 0; j < NTJOB; ++j) { a.tj[j].W = (const float*)d_in[js[j].idx] + js[j].sub; a.tj[j].dst = js[j].dst; a.tj[j].K = js[j].K; a.tj[j].N = js[j].N; a.tj[j].row_off = js[j].row_off; a.tj[j].first = first;
            first += (js[j].K / 64) * (js[j].N / 32); }
        a.tj_total = first;
    }
#if MK_PER_PHASE
    for (size_t i = 0; i < sizeof(kPhases) / sizeof(kPhases[0]); ++i) {
        a.ph_lo = kPhases[i]; a.ph_hi = kPhases[i] + 1;
        hipLaunchKernelGGL(fwd, dim3(grid), dim3(NTHR), LDS_BYTES, stream, a);
    }
#else
    a.ph_lo = 0; a.ph_hi = 1 << 20;
    hipLaunchKernelGGL(fwd, dim3(grid), dim3(NTHR), LDS_BYTES, stream, a);
#endif
    const hipError_t le = hipPeekAtLastError();
    if (le != hipSuccess) fprintf(stderr, "kernel_launch: launch failed: %s\n", hipGetErrorName(le));
}
```
